# Optimizing an MI355X kernel written in HIP

```python
import jax, jax.numpy as jnp
from jax import lax
import numpy as np

D_MODEL = 2048
BATCH = 4
SEQ = 2048
DEPTH = 4

GRID_W = 64
CTX_LEN = 256
N_MIXERS = 3
EPS = 1e-6
Q_BLOCK = 128
ROPE_THETA = 10000.0
NA_HEAD_DIM = 128
NA_HEADS = D_MODEL // NA_HEAD_DIM
WIN_H = 8
WIN_W = 16
MLA_HEADS = D_MODEL // 128
MLA_NOPE = 128
MLA_ROPE = 64
MLA_V = 128
MLA_Q_RANK = 512
MLA_KV_RANK = 512
CHUNK = 128
SG_WIDTH = D_MODEL
SG_GROUP_DIM = 128
SG_GROUPS = SG_WIDTH // SG_GROUP_DIM
D_FF = ((8 * D_MODEL // 3 + 255) // 256) * 256
CONV_W = 3

kernel_name = "hybrid_natten_mla_sgu_convffn_prefix_ctx"


def rmsnorm(z, g):
    zf = z.astype(jnp.float32)
    y = zf * lax.rsqrt(jnp.mean(zf * zf, axis=-1, keepdims=True) + EPS)
    return y.astype(z.dtype) * g


def layernorm(z, g, b):
    zf = z.astype(jnp.float32)
    mu = jnp.mean(zf, axis=-1, keepdims=True)
    var = jnp.mean(jnp.square(zf - mu), axis=-1, keepdims=True)
    return ((zf - mu) * lax.rsqrt(var + EPS)).astype(z.dtype) * g + b


def modulate(z, g, shift, scale):
    return rmsnorm(z, g) * (1 + scale) + shift


def merge_heads(o):
    B, H, N, dh = o.shape
    return o.transpose(0, 2, 1, 3).reshape(B, N, H * dh)


def dense_attention(q, k, v, scale):
    s = jnp.einsum('bhqd,bhkd->bhqk', q, k) * scale
    p = jax.nn.softmax(s.astype(jnp.float32), axis=-1).astype(v.dtype)
    return jnp.einsum('bhqk,bhkd->bhqd', p, v)


def apply_axial_rope(z):
    n, dim = z.shape[-2], z.shape[-1]
    half = dim // 2
    freqs = ROPE_THETA ** (-jnp.arange(0, half, 2, dtype=jnp.float32) / half)
    t = jnp.arange(n)
    rows = (t // GRID_W).astype(jnp.float32)
    cols = (t % GRID_W).astype(jnp.float32)

    def rot(u, ang):
        cs, sn = jnp.cos(ang).astype(u.dtype), jnp.sin(ang).astype(u.dtype)
        u1, u2 = jnp.split(u, 2, axis=-1)
        return jnp.concatenate([u1 * cs - u2 * sn, u1 * sn + u2 * cs], axis=-1)

    return jnp.concatenate([rot(z[..., :half], rows[:, None] * freqs),
                            rot(z[..., half:], cols[:, None] * freqs)], axis=-1)


def neighborhood_attention(h, hc, w_qkv, w_o, rpb, need_ctx_out):
    B, S, D = h.shape
    rows = S // GRID_W
    kh, kw = min(WIN_H, rows), WIN_W
    H, dh = NA_HEADS, NA_HEAD_DIM
    scale = dh ** -0.5

    def heads(z):
        n = z.shape[1]
        qkv = (z @ w_qkv).reshape(B, n, 3, H, dh).transpose(2, 0, 3, 1, 4)
        return qkv[0], qkv[1], qkv[2]

    q, k, v = heads(h)
    qc, kc, vc = heads(hc)
    q, k, v = (t.reshape(B, H, rows, GRID_W, dh) for t in (q, k, v))
    r_ar, w_ar = np.arange(rows), np.arange(GRID_W)
    row_idx = np.clip(r_ar - kh // 2, 0, rows - kh)[:, None] + np.arange(kh)
    col_idx = np.clip(w_ar - kw // 2, 0, GRID_W - kw)[:, None] + np.arange(kw)
    k_band = k[:, :, row_idx]
    v_band = v[:, :, row_idx]
    col_sel = jnp.asarray(np.eye(GRID_W)[col_idx], h.dtype)
    s_band = jnp.einsum('bhrqd,bhrakd->bhrqak', q, k_band)
    s_win = jnp.einsum('bhrqak,qjk->bhrqaj', s_band, col_sel)
    row_off = row_idx - r_ar[:, None] + WIN_H - 1
    col_off = col_idx - w_ar[:, None] + WIN_W - 1
    bias = rpb[:, row_off[:, None, :, None], col_off[None, :, None, :]]
    s_win = s_win * scale + bias
    s_ctx = jnp.einsum('bhrqd,bhcd->bhrqc', q, kc) * scale
    logits = jnp.concatenate([s_win.reshape(B, H, rows, GRID_W, kh * kw), s_ctx], axis=-1)
    p = jax.nn.softmax(logits.astype(jnp.float32), axis=-1).astype(v.dtype)
    p_win = p[..., :kh * kw].reshape(B, H, rows, GRID_W, kh, kw)
    p_band = jnp.einsum('bhrqaj,qjk->bhrqak', p_win, col_sel)
    o = (jnp.einsum('bhrqak,bhrakd->bhrqd', p_band, v_band)
         + jnp.einsum('bhrqc,bhcd->bhrqd', p[..., kh * kw:], vc))
    y = o.transpose(0, 2, 3, 1, 4).reshape(B, S, H * dh) @ w_o
    yc = merge_heads(dense_attention(qc, kc, vc, scale)) @ w_o if need_ctx_out else None
    return y, yc


def mla_attend(qn, qp, kn, kpe, v, scale):
    s = (jnp.einsum('bhqd,bhkd->bhqk', qn, kn) + jnp.einsum('bhqr,bkr->bhqk', qp, kpe)) * scale
    p = jax.nn.softmax(s.astype(jnp.float32), axis=-1).astype(v.dtype)
    return jnp.einsum('bhqk,bhkd->bhqd', p, v)


def latent_attention(h, hc, w_in, q_norm, kv_norm, w_uq, w_ukv, w_o, need_ctx_out):
    H = MLA_HEADS
    scale = (MLA_NOPE + MLA_ROPE) ** -0.5

    def project(z, rope):
        B, n, _ = z.shape
        cq, ckv, kpe = jnp.split(z @ w_in, [MLA_Q_RANK, MLA_Q_RANK + MLA_KV_RANK], axis=-1)
        q = (rmsnorm(cq, q_norm) @ w_uq).reshape(B, n, H, MLA_NOPE + MLA_ROPE).transpose(0, 2, 1, 3)
        kv = (rmsnorm(ckv, kv_norm) @ w_ukv).reshape(B, n, H, MLA_NOPE + MLA_V).transpose(0, 2, 1, 3)
        qn, qp = q[..., :MLA_NOPE], q[..., MLA_NOPE:]
        kn, v = kv[..., :MLA_NOPE], kv[..., MLA_NOPE:]
        if rope:
            qp, kpe = apply_axial_rope(qp), apply_axial_rope(kpe)
        return qn, qp, kn, kpe, v

    qn, qp, kn, kpe, v = project(h, True)
    qnc, qpc, knc, kpec, vc = project(hc, False)
    kn_all = jnp.concatenate([kn, knc], axis=2)
    kpe_all = jnp.concatenate([kpe, kpec], axis=1)
    v_all = jnp.concatenate([v, vc], axis=2)
    B, _, S, _ = qn.shape
    nb = S // Q_BLOCK

    def blocks(t):
        return t.reshape(B, H, nb, Q_BLOCK, t.shape[-1]).transpose(2, 0, 1, 3, 4)

    o = lax.map(lambda qs: mla_attend(qs[0], qs[1], kn_all, kpe_all, v_all, scale), (blocks(qn), blocks(qp)))
    o = o.transpose(1, 2, 0, 3, 4).reshape(B, H, S, MLA_V)
    y = merge_heads(o) @ w_o
    yc = merge_heads(mla_attend(qnc, qpc, knc, kpec, vc, scale)) @ w_o if need_ctx_out else None
    return y, yc


def spatial_gating(z, w_in, b_in, ln_g, ln_b, ws, bs, w_o):
    B, n, _ = z.shape
    u, v = jnp.split(jax.nn.gelu(z @ w_in + b_in, approximate=False), 2, axis=-1)
    v = layernorm(v, ln_g, ln_b).reshape(B, n // CHUNK, CHUNK, SG_GROUPS, SG_GROUP_DIM)
    mix = jnp.einsum('gpk,bnkgd->bnpgd', ws, v) + bs.T[:, :, None]
    return (u * mix.reshape(B, n, SG_WIDTH)) @ w_o


def conv_ffn(z, w_in, conv_w, conv_b, w_out):
    n = z.shape[1]
    u = z @ w_in
    pad = CONV_W // 2
    up = jnp.pad(u, ((0, 0), (pad, pad), (0, 0)))
    u = sum(up[:, t:t + n] * conv_w[t] for t in range(CONV_W)) + conv_b
    a, g = jnp.split(u, 2, axis=-1)
    return (a * jax.nn.silu(g)) @ w_out


def _normal(key, shape, scale):
    return jax.random.normal(key, shape, jnp.float32) * scale


def setup_inputs(seed: int = 0) -> dict:
    key = jax.random.key(seed)
    ks = iter(jax.random.split(key, 32))
    D = D_MODEL
    nA, nB, nC = (len(range(kind, DEPTH, N_MIXERS)) for kind in range(N_MIXERS))
    return {
        "x": _normal(next(ks), (BATCH, SEQ, D), 1.0),
        "c": _normal(next(ks), (BATCH, D), 1.0),
        "ctx": _normal(next(ks), (BATCH, CTX_LEN, D), 1.0),
        "c_ctx": _normal(next(ks), (D,), 1.0),
        "ada_w": _normal(next(ks), (DEPTH, D, 6 * D), 0.5 * D ** -0.5),
        "ada_b": _normal(next(ks), (DEPTH, 6 * D), 0.02),
        "norm_g": 1.0 + _normal(next(ks), (DEPTH, 2, D), 0.02),
        "final_g": 1.0 + _normal(next(ks), (D,), 0.02),
        "a_w_qkv": _normal(next(ks), (nA, D, 3 * NA_HEADS * NA_HEAD_DIM), D ** -0.5),
        "a_w_o": _normal(next(ks), (nA, NA_HEADS * NA_HEAD_DIM, D), (NA_HEADS * NA_HEAD_DIM) ** -0.5),
        "a_rpb": _normal(next(ks), (nA, NA_HEADS, 2 * WIN_H - 1, 2 * WIN_W - 1), 0.1),
        "b_w_in": _normal(next(ks), (nB, D, MLA_Q_RANK + MLA_KV_RANK + MLA_ROPE), D ** -0.5),
        "b_q_norm": 1.0 + _normal(next(ks), (nB, MLA_Q_RANK), 0.02),
        "b_kv_norm": 1.0 + _normal(next(ks), (nB, MLA_KV_RANK), 0.02),
        "b_w_uq": _normal(next(ks), (nB, MLA_Q_RANK, MLA_HEADS * (MLA_NOPE + MLA_ROPE)), MLA_Q_RANK ** -0.5),
        "b_w_ukv": _normal(next(ks), (nB, MLA_KV_RANK, MLA_HEADS * (MLA_NOPE + MLA_V)), MLA_KV_RANK ** -0.5),
        "b_w_o": _normal(next(ks), (nB, MLA_HEADS * MLA_V, D), (MLA_HEADS * MLA_V) ** -0.5),
        "c_w_in": _normal(next(ks), (nC, D, 2 * SG_WIDTH), D ** -0.5),
        "c_b_in": _normal(next(ks), (nC, 2 * SG_WIDTH), 0.02),
        "c_ln_g": 1.0 + _normal(next(ks), (nC, SG_WIDTH), 0.02),
        "c_ln_b": _normal(next(ks), (nC, SG_WIDTH), 0.02),
        "c_ws": _normal(next(ks), (nC, SG_GROUPS, CHUNK, CHUNK), CHUNK ** -0.5),
        "c_bs": 1.0 + _normal(next(ks), (nC, SG_GROUPS, CHUNK), 0.02),
        "c_w_o": _normal(next(ks), (nC, SG_WIDTH, D), SG_WIDTH ** -0.5),
        "f_w_in": _normal(next(ks), (DEPTH, D, 2 * D_FF), D ** -0.5),
        "f_conv_w": _normal(next(ks), (DEPTH, CONV_W, 2 * D_FF), CONV_W ** -0.5),
        "f_conv_b": _normal(next(ks), (DEPTH, 2 * D_FF), 0.02),
        "f_w_out": _normal(next(ks), (DEPTH, D_FF, D), D_FF ** -0.5),
    }


def reference(x, c, ctx, c_ctx, ada_w, ada_b, norm_g, final_g,
              a_w_qkv, a_w_o, a_rpb,
              b_w_in, b_q_norm, b_kv_norm, b_w_uq, b_w_ukv, b_w_o,
              c_w_in, c_b_in, c_ln_g, c_ln_b, c_ws, c_bs, c_w_o,
              f_w_in, f_conv_w, f_conv_b, f_w_out):
    s_lat = jax.nn.silu(c)
    s_ctx = jax.nn.silu(c_ctx)
    xc = ctx
    for i in range(DEPTH):
        kind, j = i % N_MIXERS, i // N_MIXERS
        last = i == DEPTH - 1
        m = [t[:, None, :] for t in jnp.split(s_lat @ ada_w[i] + ada_b[i], 6, axis=-1)]
        mc = jnp.split(s_ctx @ ada_w[i] + ada_b[i], 6, axis=-1)
        h = modulate(x, norm_g[i, 0], m[0], m[1])
        hc = modulate(xc, norm_g[i, 0], mc[0], mc[1]) if (not last or kind != 2) else None
        if kind == 0:
            y, yc = neighborhood_attention(h, hc, a_w_qkv[j], a_w_o[j], a_rpb[j], not last)
        elif kind == 1:
            y, yc = latent_attention(h, hc, b_w_in[j], b_q_norm[j], b_kv_norm[j], b_w_uq[j],
                                     b_w_ukv[j], b_w_o[j], not last)
        else:
            sg = (c_w_in[j], c_b_in[j], c_ln_g[j], c_ln_b[j], c_ws[j], c_bs[j], c_w_o[j])
            y = spatial_gating(h, *sg)
            yc = spatial_gating(hc, *sg) if not last else None
        x = x + m[2] * y
        h = modulate(x, norm_g[i, 1], m[3], m[4])
        x = x + m[5] * conv_ffn(h, f_w_in[i], f_conv_w[i], f_conv_b[i], f_w_out[i])
        if not last:
            xc = xc + mc[2] * yc
            hc = modulate(xc, norm_g[i, 1], mc[3], mc[4])
            xc = xc + mc[5] * conv_ffn(hc, f_w_in[i], f_conv_w[i], f_conv_b[i], f_w_out[i])
    return rmsnorm(x, final_g)
```

```cpp
#include <hip/hip_runtime.h>
#include <cstdio>
#include <cstdint>
namespace pg8 {
#define PG8_LAS __attribute__((address_space(3)))
typedef unsigned short bf16_t;
typedef short bf16x8 __attribute__((ext_vector_type(8)));
typedef float f32x4 __attribute__((ext_vector_type(4)));
typedef unsigned u32x4 __attribute__((ext_vector_type(4)));
constexpr int BM = 256, BK = 64, HALF = 128, HTB = HALF * BK * 2  , STAGE_BYTES = 8 * HTB, NXCD = 8, WGM = 8;

__host__ __device__ __forceinline__ int lds_byte(int r, int c) { const int st = (r >> 4) * 2 + (c >> 5), rr = r & 15, cc = c & 31, ob = rr * 64 + cc * 2; return st * 1024 + (ob ^ (((ob >> 9) & 1) << 5)); }
__host__ __device__ __forceinline__ void stage_rc(int b, int& R, int& C) { const int st = b / 1024, sb = b % 1024, swz = sb ^ (((sb >> 9) & 1) << 5); R = (st >> 1) * 16 + swz / 64; C = (st & 1) * 32 + (swz % 64) / 2; }
__host__ __device__ __forceinline__ int perm32(int rho) { const int n = rho >> 4, i = rho & 15; return 8 * (i >> 2) + 4 * n + (i & 3); }

struct Unit { int pm, pn; };
struct Gemm { const bf16_t* A; const bf16_t* Bt; int M, N, K; };

struct StaticOrder {
    int nM, nN, nwg, G, c;
    __host__ __device__ void init(int M, int N, int G_, int c_) { nM = M / BM; nN = N / BM; nwg = nM * nN; G = G_; c = c_; }
    __host__ __device__ bool next(int i, Unit& u) const {
        const long L = (long)i * G + c; if (L >= nwg) return false;
        int wgid = (int)L; { const int q = nwg / NXCD, r = nwg % NXCD, xcd = wgid % NXCD, off = wgid / NXCD; wgid = (xcd < r ? xcd * (q + 1) : r * (q + 1) + (xcd - r) * q) + off; }
        const int nig = WGM * nN, gid = wgid / nig, fm = gid * WGM, gsz = (nM - fm) < WGM ? (nM - fm) : WGM;
        u.pm = fm + ((wgid % nig) % gsz); u.pn = (wgid % nig) / gsz; return true;
    }
    __device__ __forceinline__ void a_ready(const Unit&) const {}
    __device__ __forceinline__ void done(const Unit&) const {}
};

__device__ __forceinline__ unsigned cvt_pk_bf16(float lo, float hi) { unsigned r; asm volatile("v_cvt_pk_bf16_f32 %0, %1, %2" : "=v"(r) : "v"(lo), "v"(hi)); return r; }
typedef float f32x2 __attribute__((ext_vector_type(2)));
__device__ __forceinline__ f32x2 gelu_pk(f32x2 v) {
    const f32x2 av = __builtin_elementwise_abs(v), d = av * 0.2316418882f + 1.0f;
    f32x2 t; t.x = __builtin_amdgcn_rcpf(d.x); t.y = __builtin_amdgcn_rcpf(d.y);
    f32x2 q = t * 0.5307027145f + (-0.7265760135f); q = q * t + 0.7107068705f; q = q * t + (-0.142248368f); q = q * t + 0.127414796f; q = q * t;
    const f32x2 s = (v * v) * (-0.72134752044f);
    f32x2 e; e.x = __builtin_amdgcn_exp2f(s.x); e.y = __builtin_amdgcn_exp2f(s.y);
    const f32x2 m = v * (q * e), r = v - m;
    f32x2 o; o.x = v.x < 0.f ? m.x : r.x; o.y = v.y < 0.f ? m.y : r.y; return o;
}

template <int ACT  > struct EpiBf16 {
    static constexpr bool PERM = true, AFTER_DRAIN = false; static_assert(ACT == 0 || ACT == 1, "EpiBf16: ACT is 0 (none) or 1 (gelu_pk)");
    bf16_t* O; int ldc; const float* bias; int split_cols; size_t split_stride; float scale0;
    __device__ __forceinline__ void operator()(const f32x4 (&acc)[2][2][4][2], const Unit& u, int wr, int wc, int fr, int fq) const {
        const int row0 = u.pm * BM + wr * 64 + fr; int colt = u.pn * BM; bf16_t* base = O;
        float sc = 1.f; if (split_cols) { const int t = colt / split_cols; base += (size_t)t * split_stride; colt -= t * split_cols; if (t == 0) sc = scale0; }
        const int col0 = colt + wc * 32 + 8 * fq, bcol0 = u.pn * BM + wc * 32 + 8 * fq;
        f32x4 bv[2][2];
#pragma unroll
        for (int bj = 0; bj < 2; ++bj)
#pragma unroll
            for (int n = 0; n < 2; ++n) bv[bj][n] = bias ? *(const f32x4*)(bias + bcol0 + bj * HALF + 4 * n) : (f32x4){0.f, 0.f, 0.f, 0.f};
#pragma unroll
        for (int ai = 0; ai < 2; ++ai)
#pragma unroll
            for (int m = 0; m < 4; ++m) { bf16_t* rowp = base + (size_t)(row0 + ai * HALF + m * 16) * ldc + col0;
#pragma unroll
                for (int bj = 0; bj < 2; ++bj) { f32x4 v0 = acc[ai][bj][m][0] + bv[bj][0], v1 = acc[ai][bj][m][1] + bv[bj][1];
                    if (ACT == 1) { f32x2 a = gelu_pk((f32x2){v0[0], v0[1]}), b = gelu_pk((f32x2){v0[2], v0[3]}), c = gelu_pk((f32x2){v1[0], v1[1]}), d = gelu_pk((f32x2){v1[2], v1[3]});
                        v0 = (f32x4){a.x, a.y, b.x, b.y}; v1 = (f32x4){c.x, c.y, d.x, d.y}; }
                    v0 = v0 * sc; v1 = v1 * sc; u32x4 w; w.x = cvt_pk_bf16(v0[0], v0[1]); w.y = cvt_pk_bf16(v0[2], v0[3]); w.z = cvt_pk_bf16(v1[0], v1[1]); w.w = cvt_pk_bf16(v1[2], v1[3]);
                    *(u32x4*)(rowp + bj * HALF) = w; } }
    }
};

struct PanelStats {
    unsigned* xbuf;
    unsigned* cnt;
    unsigned* tmo;
    int ntn; float eps;
    unsigned code;
    __device__ __forceinline__ bool run(const f32x4 (&v)[2][2][4][2], const Unit& u, int wr, int wc, int fr, int fq, PG8_LAS unsigned char* lds, int wid, int lane) const {
        typedef float f32x2v __attribute__((ext_vector_type(2)));
        PG8_LAS f32x2v* P = (PG8_LAS f32x2v*)lds;
        PG8_LAS f32x2v* S = (PG8_LAS f32x2v*)(lds + 8192);
        PG8_LAS unsigned* flag = (PG8_LAS unsigned*)(lds + 8192 + 2048);
#pragma unroll
        for (int ai = 0; ai < 2; ++ai)
#pragma unroll
            for (int m = 0; m < 4; ++m) {
                float s = 0.f;
#pragma unroll
                for (int bj = 0; bj < 2; ++bj)
#pragma unroll
                    for (int n = 0; n < 2; ++n) { const f32x4 x = v[ai][bj][m][n]; s += (x[0] + x[1]) + (x[2] + x[3]); }
                s += __shfl_xor(s, 16); s += __shfl_xor(s, 32);
                const float mw = s * (1.0f / 64.0f); float q = 0.f;
#pragma unroll
                for (int bj = 0; bj < 2; ++bj)
#pragma unroll
                    for (int n = 0; n < 2; ++n) { const f32x4 d = v[ai][bj][m][n] - mw; q += (d[0] * d[0] + d[1] * d[1]) + (d[2] * d[2] + d[3] * d[3]); }
                q += __shfl_xor(q, 16); q += __shfl_xor(q, 32);
                if (fq == 0) P[(ai * HALF + wr * 64 + m * 16 + fr) * 4 + wc] = (f32x2v){mw, q};
            }
        asm volatile("s_waitcnt lgkmcnt(0)" ::: "memory"); __builtin_amdgcn_s_barrier(); asm volatile("" ::: "memory");
#if defined(BROKEN_EXCHANGE_NO_WAIT)
#warning BROKEN CONTROL BUILD: the row-statistics exchange does not wait; results are wrong by design
        if (blockIdx.x >= 64) { const long long t0_ = clock64(); while (clock64() - t0_ < 60000) __builtin_amdgcn_s_sleep(8); }
#endif
        const int row = wid * 32 + (lane & 31);
        if (lane < 32) {
            const f32x2v a = P[row * 4 + 0], b = P[row * 4 + 1], c = P[row * 4 + 2], d = P[row * 4 + 3];
            const float mt = (a.x + b.x + c.x + d.x) * 0.25f;
            const float da = a.x - mt, db = b.x - mt, dc = c.x - mt, dd = d.x - mt;
            const float m2 = (a.y + b.y) + (c.y + d.y) + 64.0f * ((da * da + db * db) + (dc * dc + dd * dd));
            unsigned long long* slot = (unsigned long long*)xbuf + ((size_t)(u.pm * BM + row) * 4 + u.pn);
            __hip_atomic_store(slot, ((unsigned long long)__float_as_uint(m2) << 32) | __float_as_uint(mt), __ATOMIC_RELAXED, __HIP_MEMORY_SCOPE_AGENT);
        }
        asm volatile("s_waitcnt vmcnt(0)" ::: "memory");
        if (lane == 0) __hip_atomic_fetch_add(cnt + 64 * u.pm, 1u, __ATOMIC_RELAXED, __HIP_MEMORY_SCOPE_AGENT);
        if (wid == 0) {
            bool dead = false; const unsigned long long t0 = __builtin_amdgcn_s_memrealtime(); const unsigned want = 8u * (unsigned)ntn;
            for (;;) {
#if defined(BROKEN_EXCHANGE_NO_WAIT)
                break;
#endif
                if ((unsigned)__builtin_amdgcn_readfirstlane(__hip_atomic_load(cnt + 64 * u.pm, __ATOMIC_RELAXED, __HIP_MEMORY_SCOPE_AGENT)) >= want) break;
                if (__builtin_amdgcn_s_memrealtime() - t0 > 2000000ull) {
                    if (lane == 0) { unsigned expect = 0u; __hip_atomic_compare_exchange_strong(tmo + 1, &expect, code | (unsigned)(u.pm & 0xff), __ATOMIC_RELAXED, __ATOMIC_RELAXED, __HIP_MEMORY_SCOPE_AGENT);
                                     __hip_atomic_store(tmo, 1u, __ATOMIC_RELAXED, __HIP_MEMORY_SCOPE_AGENT); }
                    dead = true; break; }
                __builtin_amdgcn_s_sleep(2);
            }
            __builtin_amdgcn_fence(__ATOMIC_ACQUIRE, "agent");
            if (lane == 0) flag[0] = dead ? 1u : 0u;
        }
        asm volatile("s_waitcnt vmcnt(0) lgkmcnt(0)" ::: "memory"); __builtin_amdgcn_s_barrier(); asm volatile("" ::: "memory");
        const bool bad = flag[0] != 0u;
        if (lane < 32) {
            const unsigned long long* slot = (const unsigned long long*)xbuf + (size_t)(u.pm * BM + row) * 4; float mt[4], m2[4]; float ms = 0.f;
#pragma unroll
            for (int t = 0; t < 4; ++t) { if (t < ntn) { const unsigned long long w = __hip_atomic_load(slot + t, __ATOMIC_RELAXED, __HIP_MEMORY_SCOPE_AGENT); mt[t] = __uint_as_float((unsigned)w); m2[t] = __uint_as_float((unsigned)(w >> 32)); } else { mt[t] = 0.f; m2[t] = 0.f; } ms += mt[t]; }
            const float mean = ms / (float)ntn; float q = 0.f;
#pragma unroll
            for (int t = 0; t < 4; ++t) if (t < ntn) { const float dm = mt[t] - mean; q += m2[t] + 256.0f * dm * dm; }
            S[row] = (f32x2v){mean, 1.0f / sqrtf(q / (256.0f * (float)ntn) + eps)};
        }
        asm volatile("s_waitcnt lgkmcnt(0)" ::: "memory"); __builtin_amdgcn_s_barrier(); asm volatile("" ::: "memory");
        return bad;
    }
};
struct EpiLnRes {
    static constexpr bool PERM = false, AFTER_DRAIN = true;
    const float* base; float* out; int ldc; const float* bias; PanelStats st; unsigned poison;
    __device__ __forceinline__ void fused(f32x4 (&acc)[2][2][4][2], const Unit& u, int wr, int wc, int fr, int fq, PG8_LAS unsigned char* lds, int wid, int lane) const {
        typedef float f32x2v __attribute__((ext_vector_type(2)));
        const PG8_LAS f32x2v* S = (const PG8_LAS f32x2v*)(lds + 8192);
        const int col0 = u.pn * BM + wc * 32 + 4 * fq;
#pragma unroll
        for (int bj = 0; bj < 2; ++bj)
#pragma unroll
            for (int n = 0; n < 2; ++n) { const f32x4 bv = bias ? *(const f32x4*)(bias + col0 + bj * HALF + n * 16) : (f32x4){0.f, 0.f, 0.f, 0.f};
#pragma unroll
                for (int ai = 0; ai < 2; ++ai)
#pragma unroll
                    for (int m = 0; m < 4; ++m) acc[ai][bj][m][n] += bv; }
        f32x4 pre[4][2][2];
#pragma unroll
        for (int m = 0; m < 4; ++m) { const size_t off = (size_t)(u.pm * BM + wr * 64 + m * 16 + fr) * ldc + col0;
#pragma unroll
            for (int bj = 0; bj < 2; ++bj)
#pragma unroll
                for (int n = 0; n < 2; ++n) pre[m][bj][n] = *(const f32x4*)(base + off + bj * HALF + n * 16); }
        const bool bad = st.run(acc, u, wr, wc, fr, fq, lds, wid, lane) || poison != 0u;
        const float qnan = __builtin_nanf("");
#pragma unroll
        for (int ai = 0; ai < 2; ++ai)
#pragma unroll
            for (int m = 0; m < 4; ++m) { const int r = ai * HALF + wr * 64 + m * 16 + fr; const f32x2v sr = S[r]; const size_t off = (size_t)(u.pm * BM + r) * ldc + col0;
#pragma unroll
                for (int bj = 0; bj < 2; ++bj)
#pragma unroll
                    for (int n = 0; n < 2; ++n) { const f32x4 bs = ai == 0 ? pre[m][bj][n] : *(const f32x4*)(base + off + bj * HALF + n * 16); f32x4 o = bs + (acc[ai][bj][m][n] - sr.x) * sr.y;
                        if (bad) o = (f32x4){qnan, qnan, qnan, qnan}; *(f32x4*)(out + off + bj * HALF + n * 16) = o; }
                if (m & 1) asm volatile("" ::: "memory"); }
    }
};
struct EpiLnResLn {
    static constexpr bool PERM = false, AFTER_DRAIN = true;
    const float* base; float* out; bf16_t* xn; int ldc; const float* bias; PanelStats st1, st2; unsigned poison;
    __device__ __forceinline__ void fused(f32x4 (&acc)[2][2][4][2], const Unit& u, int wr, int wc, int fr, int fq, PG8_LAS unsigned char* lds, int wid, int lane) const {
        typedef float f32x2v __attribute__((ext_vector_type(2))); typedef unsigned u32x2v __attribute__((ext_vector_type(2)));
        const PG8_LAS f32x2v* S = (const PG8_LAS f32x2v*)(lds + 8192);
        const int col0 = u.pn * BM + wc * 32 + 4 * fq;
#pragma unroll
        for (int bj = 0; bj < 2; ++bj)
#pragma unroll
            for (int n = 0; n < 2; ++n) { const f32x4 bv = bias ? *(const f32x4*)(bias + col0 + bj * HALF + n * 16) : (f32x4){0.f, 0.f, 0.f, 0.f};
#pragma unroll
                for (int ai = 0; ai < 2; ++ai)
#pragma unroll
                    for (int m = 0; m < 4; ++m) acc[ai][bj][m][n] += bv; }
        bool bad = st1.run(acc, u, wr, wc, fr, fq, lds, wid, lane) || poison != 0u;
        const float qnan = __builtin_nanf("");
#pragma unroll
        for (int ai = 0; ai < 2; ++ai)
#pragma unroll
            for (int m = 0; m < 4; ++m) { const int r = ai * HALF + wr * 64 + m * 16 + fr; const f32x2v sr = S[r]; const size_t off = (size_t)(u.pm * BM + r) * ldc + col0;
#pragma unroll
                for (int bj = 0; bj < 2; ++bj)
#pragma unroll
                    for (int n = 0; n < 2; ++n) { const f32x4 bs = *(const f32x4*)(base + off + bj * HALF + n * 16); acc[ai][bj][m][n] = bs + (acc[ai][bj][m][n] - sr.x) * sr.y; }
                asm volatile("" : "+v"(acc[ai][0][m][0]), "+v"(acc[ai][0][m][1]), "+v"(acc[ai][1][m][0]), "+v"(acc[ai][1][m][1]));
                if (m & 1) asm volatile("" ::: "memory"); }
        const bool bad1 = bad;
        bad = st2.run(acc, u, wr, wc, fr, fq, lds, wid, lane) || bad;
#pragma unroll
        for (int ai = 0; ai < 2; ++ai)
#pragma unroll
            for (int m = 0; m < 4; ++m) { const int r = ai * HALF + wr * 64 + m * 16 + fr; const f32x2v sr = S[r]; const size_t off = (size_t)(u.pm * BM + r) * ldc + col0;
#pragma unroll
                for (int bj = 0; bj < 2; ++bj)
#pragma unroll
                    for (int n = 0; n < 2; ++n) { const f32x4 x1 = acc[ai][bj][m][n]; *(f32x4*)(out + off + bj * HALF + n * 16) = bad1 ? (f32x4){qnan, qnan, qnan, qnan} : x1;
                        const f32x4 o = (x1 - sr.x) * sr.y; u32x2v w; w.x = cvt_pk_bf16(o[0], o[1]); w.y = cvt_pk_bf16(o[2], o[3]);
                        if (bad) { w.x = 0x7fc07fc0u; w.y = 0x7fc07fc0u; } *(u32x2v*)(xn + off + bj * HALF + n * 16) = w; }
                asm volatile("" ::: "memory"); }
    }
};

template <class Epi, class Sched, bool ALIGN_EPI = false, bool SP2 = false>
__device__ __forceinline__ void gemm_phase(PG8_LAS unsigned char* lds, const Gemm g, const Sched& S, const Epi& E) {
    int tid_ = threadIdx.x; asm volatile("" : "+v"(tid_));
    const int tid = tid_, wid = __builtin_amdgcn_readfirstlane(tid >> 6), lane = tid & 63, wr = wid >> 2, wc = wid & 3, fr = lane & 15, fq = lane >> 4;
    const int K = g.K, nt = K / BK;
    unsigned voffA[2], voffB[2];
#pragma unroll
    for (int i = 0; i < 2; ++i) { int R, C; stage_rc(tid * 16 + i * 8192, R, C); const int Rb = Epi::PERM ? ((R & ~31) + perm32(R & 31)) : R;
        voffA[i] = (unsigned)(R * K + C) * 2u; voffB[i] = (unsigned)(Rb * K + C) * 2u; }
    const size_t kstep = (size_t)(BK * 2);
    const size_t hstep = (size_t)HALF * K * 2;
    const size_t tstep = 2 * hstep;
    const unsigned ldsw = (unsigned)wid * 1024u;
    const int aoff = lds_byte(wr * 64 + fr, fq * 8), boff = lds_byte(wc * 32 + fr, fq * 8);
#define PG8_SA(b, h) (((b) * 2 + (h)) * HTB)
#define PG8_SB(b, h) ((4 + (b) * 2 + (h)) * HTB)
#define PG8_STAGE(bufoff, gbase, voff) do { _Pragma("unroll") for (int _i = 0; _i < 2; ++_i) \
        __builtin_amdgcn_global_load_lds((const unsigned*)((const char*)(gbase) + (voff)[_i]), (PG8_LAS unsigned*)(lds + (bufoff) + ldsw + _i * 8192), 16, 0, 0); } while (0)
#define PG8_LDA(dst, b, h) do { _Pragma("unroll") for (int m = 0; m < 4; ++m) _Pragma("unroll") for (int k = 0; k < 2; ++k) dst[m][k] = *(const PG8_LAS bf16x8*)(lds + PG8_SA(b, h) + aoff + m * 2048 + k * 1024); } while (0)
#define PG8_LDB(dst, b, h) do { _Pragma("unroll") for (int n = 0; n < 2; ++n) _Pragma("unroll") for (int k = 0; k < 2; ++k) dst[n][k] = *(const PG8_LAS bf16x8*)(lds + PG8_SB(b, h) + boff + n * 2048 + k * 1024); } while (0)
#define PG8_MMA(ai, bj, At, Bt) do { __builtin_amdgcn_s_setprio(1); _Pragma("unroll") for (int m = 0; m < 4; ++m) _Pragma("unroll") for (int n = 0; n < 2; ++n) _Pragma("unroll") for (int k = 0; k < 2; ++k) \
        acc[ai][bj][m][n] = __builtin_amdgcn_mfma_f32_16x16x32_bf16(Bt[n][k], At[m][k], acc[ai][bj][m][n], 0, 0, 0); __builtin_amdgcn_s_setprio(0); } while (0)
#define PG8_WAIT_V(n) asm volatile("s_waitcnt vmcnt(" #n ")" ::: "memory")
#define PG8_WAIT_L(n) asm volatile("s_waitcnt lgkmcnt(" #n ")" ::: "memory")
#define PG8_BAR __builtin_amdgcn_s_barrier()
#define PG8_SCHED __builtin_amdgcn_sched_barrier(0)
    Unit cur, nxt; int ui = 0;
    if (!S.next(0, cur)) return;
    f32x4 acc[2][2][4][2];
#pragma unroll
    for (int a = 0; a < 2; ++a)
#pragma unroll
        for (int b = 0; b < 2; ++b)
#pragma unroll
            for (int m = 0; m < 4; ++m)
#pragma unroll
                for (int n = 0; n < 2; ++n) acc[a][b][m][n] = (f32x4){0.f, 0.f, 0.f, 0.f};
    bf16x8 At[4][2], B0[2][2], B1[2][2];
    const char* cA = (const char*)g.A + (size_t)cur.pm * tstep; const char* cB = (const char*)g.Bt + (size_t)cur.pn * tstep;
    S.a_ready(cur);
    if constexpr (SP2) {
        PG8_STAGE(PG8_SB(0, 0), cB, voffB); PG8_STAGE(PG8_SB(0, 1), cB + hstep, voffB); PG8_STAGE(PG8_SA(0, 0), cA, voffA); PG8_STAGE(PG8_SA(0, 1), cA + hstep, voffA);
        if (wr == 1) PG8_BAR;
        PG8_WAIT_V(2); PG8_BAR;
        PG8_STAGE(PG8_SB(1, 0), cB + kstep, voffB); PG8_STAGE(PG8_SA(1, 0), cA + kstep, voffA); PG8_STAGE(PG8_SB(1, 1), cB + hstep + kstep, voffB);
        PG8_WAIT_V(6); PG8_BAR;
    } else {
        PG8_STAGE(PG8_SB(0, 0), cB, voffB); PG8_STAGE(PG8_SA(0, 0), cA, voffA); PG8_STAGE(PG8_SB(0, 1), cB + hstep, voffB); PG8_STAGE(PG8_SA(0, 1), cA + hstep, voffA);
        if (wr == 1) PG8_BAR;
        PG8_WAIT_V(4); PG8_BAR;
        PG8_STAGE(PG8_SB(1, 0), cB + kstep, voffB); PG8_STAGE(PG8_SA(1, 0), cA + kstep, voffA); PG8_STAGE(PG8_SB(1, 1), cB + hstep + kstep, voffB);
        PG8_WAIT_V(6); PG8_BAR;
    }
    for (;;) {
        const bool has_next = S.next(ui + 1, nxt);
        const char* nA = has_next ? (const char*)g.A + (size_t)nxt.pm * tstep : cA; const char* nB = has_next ? (const char*)g.Bt + (size_t)nxt.pn * tstep : cB;
        for (int t = 0; t < nt; t += 2) {
            const bool last = (t == nt - 2);
            const char* a1 = cA + (size_t)(t + 1) * kstep;
            const char* a2 = last ? nA : cA + (size_t)(t + 2) * kstep; const char* b2 = last ? nB : cB + (size_t)(t + 2) * kstep;
            const char* a3 = a2 + kstep; const char* b3 = b2 + kstep;
            if (last && has_next) S.a_ready(nxt);
            if constexpr (SP2) {
            PG8_LDB(B0, 0, 0); PG8_LDB(B1, 0, 1); PG8_SCHED; PG8_LDA(At, 0, 0); PG8_STAGE(PG8_SA(1, 1), a1 + hstep, voffA);
            PG8_WAIT_V(8); PG8_WAIT_L(0); PG8_BAR; PG8_MMA(0, 0, At, B0); PG8_MMA(0, 1, At, B1); PG8_BAR; PG8_SCHED;
            PG8_LDA(At, 0, 1); PG8_STAGE(PG8_SB(0, 0), b2, voffB); PG8_STAGE(PG8_SB(0, 1), b2 + hstep, voffB); PG8_STAGE(PG8_SA(0, 0), a2, voffA);
            PG8_WAIT_V(8); PG8_WAIT_L(0); PG8_BAR; PG8_MMA(1, 0, At, B0); PG8_MMA(1, 1, At, B1); PG8_BAR; PG8_SCHED;
            PG8_LDB(B0, 1, 0); PG8_LDB(B1, 1, 1); PG8_SCHED; PG8_LDA(At, 1, 0); PG8_STAGE(PG8_SA(0, 1), a2 + hstep, voffA);
            PG8_WAIT_V(8); PG8_WAIT_L(0); PG8_BAR; PG8_MMA(0, 0, At, B0); PG8_MMA(0, 1, At, B1); PG8_BAR; PG8_SCHED;
            PG8_LDA(At, 1, 1); PG8_STAGE(PG8_SB(1, 0), b3, voffB); PG8_STAGE(PG8_SB(1, 1), b3 + hstep, voffB); PG8_STAGE(PG8_SA(1, 0), a3, voffA);
            PG8_WAIT_V(8); PG8_WAIT_L(0); PG8_BAR; PG8_MMA(1, 0, At, B0); PG8_MMA(1, 1, At, B1); PG8_BAR; PG8_SCHED;
            } else {
            PG8_LDB(B0, 0, 0); PG8_SCHED; PG8_LDA(At, 0, 0); PG8_STAGE(PG8_SA(1, 1), a1 + hstep, voffA);
            PG8_WAIT_L(8); PG8_BAR; PG8_WAIT_L(0); PG8_MMA(0, 0, At, B0); PG8_BAR; PG8_SCHED;
            PG8_LDB(B1, 0, 1); PG8_STAGE(PG8_SB(0, 0), b2, voffB);
            PG8_BAR; PG8_WAIT_L(0); PG8_MMA(0, 1, At, B1); PG8_BAR;
            PG8_LDA(At, 0, 1); PG8_STAGE(PG8_SA(0, 0), a2, voffA);
            PG8_BAR; PG8_WAIT_L(0); PG8_MMA(1, 0, At, B0); PG8_BAR; PG8_SCHED;
            PG8_STAGE(PG8_SB(0, 1), b2 + hstep, voffB);
            PG8_WAIT_V(6); PG8_BAR; PG8_MMA(1, 1, At, B1); PG8_BAR;
            PG8_LDB(B0, 1, 0); PG8_SCHED; PG8_LDA(At, 1, 0); PG8_STAGE(PG8_SA(0, 1), a2 + hstep, voffA);
            PG8_WAIT_L(8); PG8_BAR; PG8_WAIT_L(0); PG8_MMA(0, 0, At, B0); PG8_BAR; PG8_SCHED;
            PG8_LDB(B1, 1, 1); PG8_STAGE(PG8_SB(1, 0), b3, voffB);
            PG8_BAR; PG8_WAIT_L(0); PG8_MMA(0, 1, At, B1); PG8_BAR;
            PG8_LDA(At, 1, 1); PG8_STAGE(PG8_SA(1, 0), a3, voffA);
            PG8_BAR; PG8_WAIT_L(0); PG8_MMA(1, 0, At, B0); PG8_BAR; PG8_SCHED;
            PG8_STAGE(PG8_SB(1, 1), b3 + hstep, voffB);
            PG8_WAIT_V(6); PG8_BAR; PG8_MMA(1, 1, At, B1); PG8_BAR;
            }
        }
        if constexpr (ALIGN_EPI) { if (wr == 0) PG8_BAR; }
        if constexpr (!Epi::AFTER_DRAIN) { E(acc, cur, wr, wc, fr, fq); S.done(cur); }
        if (!has_next) break;
#pragma unroll
        for (int a = 0; a < 2; ++a)
#pragma unroll
            for (int b = 0; b < 2; ++b)
#pragma unroll
                for (int m = 0; m < 4; ++m)
#pragma unroll
                    for (int n = 0; n < 2; ++n) acc[a][b][m][n] = (f32x4){0.f, 0.f, 0.f, 0.f};
        cur = nxt; cA = nA; cB = nB; ++ui;
        if constexpr (ALIGN_EPI) { if (wr == 1) PG8_BAR; }
    }
    PG8_WAIT_V(0);
    if constexpr (!ALIGN_EPI) { if (wr == 0) PG8_BAR; }
    PG8_BAR;
    if constexpr (Epi::AFTER_DRAIN) { E.fused(acc, cur, wr, wc, fr, fq, lds, wid, lane); S.done(cur); }
#undef PG8_SA
#undef PG8_SB
#undef PG8_STAGE
#undef PG8_LDA
#undef PG8_LDB
#undef PG8_MMA
#undef PG8_WAIT_V
#undef PG8_WAIT_L
#undef PG8_BAR
#undef PG8_SCHED
}
}
namespace pg8 {
struct EpiRes {
    static constexpr bool PERM = false, AFTER_DRAIN = false;
    float* X; int ldc; const float* mods; int gate_off;
    __device__ __forceinline__ void operator()(const f32x4 (&acc)[2][2][4][2], const Unit& u, int wr, int wc, int fr, int fq) const {
        const int prow = u.pm * BM; const int bidx = prow < 8192 ? (prow >> 11) : 4;
        const float* gate = mods + bidx * 12288 + gate_off;
        const int col0 = u.pn * BM + wc * 32 + 4 * fq;
        f32x4 gv[2][2];
#pragma unroll
        for (int bj = 0; bj < 2; ++bj)
#pragma unroll
            for (int n = 0; n < 2; ++n) gv[bj][n] = *(const f32x4*)(gate + col0 + bj * HALF + n * 16);
#pragma unroll
        for (int ai = 0; ai < 2; ++ai)
#pragma unroll
            for (int m = 0; m < 4; ++m) { float* rowp = X + (size_t)(prow + ai * HALF + wr * 64 + m * 16 + fr) * ldc + col0;
#pragma unroll
                for (int bj = 0; bj < 2; ++bj)
#pragma unroll
                    for (int n = 0; n < 2; ++n) { f32x4* p = (f32x4*)(rowp + bj * HALF + n * 16); f32x4 v = *p; v = v + gv[bj][n] * acc[ai][bj][m][n]; *p = v; } }
    }
};
struct EpiF32 {
    static constexpr bool PERM = false, AFTER_DRAIN = false;
    float* O; int ldc;
    __device__ __forceinline__ void operator()(const f32x4 (&acc)[2][2][4][2], const Unit& u, int wr, int wc, int fr, int fq) const {
        const int col0 = u.pn * BM + wc * 32 + 4 * fq;
#pragma unroll
        for (int ai = 0; ai < 2; ++ai)
#pragma unroll
            for (int m = 0; m < 4; ++m) { float* rowp = O + (size_t)(u.pm * BM + ai * HALF + wr * 64 + m * 16 + fr) * ldc + col0;
#pragma unroll
                for (int bj = 0; bj < 2; ++bj)
#pragma unroll
                    for (int n = 0; n < 2; ++n) *(f32x4*)(rowp + bj * HALF + n * 16) = acc[ai][bj][m][n]; }
    }
};
}
#define GAS __attribute__((address_space(1)))
#define LAS __attribute__((address_space(3)))
typedef unsigned short bf16;
typedef unsigned v4u __attribute__((ext_vector_type(4)));
typedef float f32x4 __attribute__((ext_vector_type(4)));
typedef short bf16x8 __attribute__((ext_vector_type(8)));
typedef GAS unsigned gu32;
typedef GAS unsigned long long gu64;
#define RLX_AGENT __ATOMIC_RELAXED, __HIP_MEMORY_SCOPE_AGENT
#define LDS_WAIT() asm volatile("s_waitcnt lgkmcnt(0)" ::: "memory")
#define VM_WAIT() asm volatile("s_waitcnt vmcnt(0)" ::: "memory")
__device__ __forceinline__ unsigned long long rt() { return __builtin_amdgcn_s_memrealtime(); }
__device__ __forceinline__ unsigned f2bf(float f) { unsigned u = __builtin_bit_cast(unsigned, f); return (u + 0x7fffu + ((u >> 16) & 1u)) >> 16; }
__device__ __forceinline__ unsigned pk2(float lo, float hi) { return f2bf(lo) | (f2bf(hi) << 16); }

#define XB_TMO      128
#define XB_XCNT(j)  (256  + 64 * (j))
#define XB_XSUB(j)  (1280 + 64 * (j))
#define XB_XGEN(j)  (2304 + 64 * (j))
#define XB_TOP      3328
#define XB_TOPGEN   3392
#define XCD_BAR_WORDS 3456
#define XB_SPIN_CAP (1u << 18)

__device__ __forceinline__ unsigned xb_ld(unsigned* p)              { return __hip_atomic_load(p, __ATOMIC_RELAXED, __HIP_MEMORY_SCOPE_AGENT); }
__device__ __forceinline__ unsigned xb_add(unsigned* p, unsigned v) { return __hip_atomic_fetch_add(p, v, __ATOMIC_RELAXED, __HIP_MEMORY_SCOPE_AGENT); }
__device__ __forceinline__ unsigned xb_xcc_id() { return (unsigned)__builtin_amdgcn_s_getreg((3 << 11) | 20) & 0xFu; }
#define XB_SPIN(cond, bar) do { unsigned _sp = 0; while (cond) { __builtin_amdgcn_s_sleep(1); \
    if ((++_sp & 255u) == 0u) { if (xb_ld(&(bar)[XB_TMO])) break; if (_sp > XB_SPIN_CAP) { atomicAdd(&(bar)[XB_TMO], 1u); break; } } } } while (0)

struct XcdBarrier {
    unsigned* bar; unsigned x;
    volatile LAS unsigned* st;
};

__device__ __forceinline__ XcdBarrier xcd_barrier_post(unsigned* bar, volatile LAS unsigned* st) {
    XcdBarrier b; b.bar = bar; b.x = xb_xcc_id(); b.st = st;
    if (threadIdx.x == 0) (void)xb_add(&bar[XB_XCNT(b.x)], 1u);
    return b;
}
__device__ __forceinline__ void xcd_barrier_complete(unsigned* bar, unsigned x, unsigned& nloc, unsigned& nx) {
    const unsigned G = gridDim.x * gridDim.y * gridDim.z;
    unsigned sum, cnt, mine, sp = 0u;
    for (;;) {
        sum = 0u; cnt = 0u; mine = 0u;
#pragma unroll
        for (unsigned j = 0; j < 16; ++j) { const unsigned c = xb_ld(&bar[XB_XCNT(j)]); sum += c; cnt += (c > 0u) ? 1u : 0u; mine = (j == x) ? c : mine; }
        if (sum == G) break;
        __builtin_amdgcn_s_sleep(1);
        if ((++sp & 255u) == 0u) { if (xb_ld(&bar[XB_TMO])) break; if (sp > XB_SPIN_CAP) { atomicAdd(&bar[XB_TMO], 1u); break; } }
    }
    nloc = mine > 0u ? mine : 1u; nx = cnt > 0u ? cnt : 1u;
}

__device__ __forceinline__ void xcd_barrier(const XcdBarrier& b) {
    asm volatile("s_waitcnt vmcnt(0)" ::: "memory");
    __syncthreads();
    if (threadIdx.x == 0) {
        unsigned* bar = b.bar;
        __builtin_amdgcn_s_waitcnt(0);
        unsigned nloc = b.st[0], nx = b.st[1];
        if (nloc == 0u) { xcd_barrier_complete(bar, b.x, nloc, nx); b.st[0] = nloc; b.st[1] = nx; }
        const unsigned old = xb_add(&bar[XB_XSUB(b.x)], 1u);
        const unsigned gen = old / nloc;
        if (old + 1u == (gen + 1u) * nloc) {
            __builtin_amdgcn_fence(__ATOMIC_RELEASE, "agent");
            asm volatile("s_waitcnt vmcnt(0)" ::: "memory");
            const unsigned og = xb_add(&bar[XB_TOP], 1u);
            const unsigned tg = og / nx;
            if (og + 1u == (tg + 1u) * nx) xb_add(&bar[XB_TOPGEN], 1u);
            else XB_SPIN(xb_ld(&bar[XB_TOPGEN]) == tg, bar);
            __builtin_amdgcn_fence(__ATOMIC_ACQUIRE, "agent");
            xb_add(&bar[XB_XGEN(b.x)], 1u);
            asm volatile("s_waitcnt vmcnt(0)" ::: "memory");
        } else {
            XB_SPIN(xb_ld(&bar[XB_XGEN(b.x)]) == gen, bar);
            __builtin_amdgcn_fence(__ATOMIC_ACQUIRE, "agent");
            asm volatile("s_waitcnt vmcnt(0)" ::: "memory");
        }
    }
    __syncthreads();
}
namespace att {
#define ALAS __attribute__((address_space(3)))
using bf16x8 = __attribute__((ext_vector_type(8))) short;
using s16x4  = __attribute__((ext_vector_type(4))) short;
using f32x16 = __attribute__((ext_vector_type(16))) float;
using f32x4  = __attribute__((ext_vector_type(4))) float;
using u32x4  = __attribute__((ext_vector_type(4))) unsigned;
typedef unsigned short bf16_t;
#define SBAR() __builtin_amdgcn_sched_barrier(0)
__device__ __forceinline__ int crow(int r, int hi) { return (r & 3) + 8 * (r >> 2) + 4 * hi; }
__device__ __forceinline__ unsigned cvtpk(float lo, float hi) { unsigned r; asm volatile("v_cvt_pk_bf16_f32 %0, %1, %2" : "=v"(r) : "v"(lo), "v"(hi)); return r; }
__device__ __forceinline__ float bf2f(short s) { return __uint_as_float(((unsigned)(unsigned short)s) << 16); }
__device__ __forceinline__ int iclamp(int v, int lo, int hi) { return v < lo ? lo : (v > hi ? hi : v); }
template <int DQK> __device__ __forceinline__ int kswz(int row, int colB) { return row * (DQK * 2) + (colB ^ ((row & 7) << 4)); }
__device__ __forceinline__ int v_st(int k, int c) { const int kk = (k & ~0xC) | ((k & 4) << 1) | ((k & 8) >> 1); return ((kk >> 3) * 4 + (c >> 5)) * 512 + ((kk & 7) * 32 + (c & 31)) * 2; }
__device__ __forceinline__ int v_rd_base(int lane) { return ((lane & 3) << 3) | (((lane >> 2) & 3) << 6) | (((lane >> 4) & 1) << 5) | (((lane >> 5) & 1) << 8); }
constexpr int v_rd_off(int d0, int ks, int half) { return d0 * 512 + ks * 4096 + half * 2048; }
template <int OFF> __device__ __forceinline__ s16x4 tr_read(int vb) { s16x4 r; asm volatile("ds_read_b64_tr_b16 %0, %1 offset:%2" : "=&v"(r) : "v"(vb), "i"(OFF) : "memory"); return r; }
template <int D0> __device__ __forceinline__ void pv_one(f32x16& od, int vb, bf16x8 pa0, bf16x8 pa1, bf16x8 pa2, bf16x8 pa3) {
  const s16x4 l0 = tr_read<v_rd_off(D0, 0, 0)>(vb), h0 = tr_read<v_rd_off(D0, 0, 1)>(vb), l1 = tr_read<v_rd_off(D0, 1, 0)>(vb), h1 = tr_read<v_rd_off(D0, 1, 1)>(vb);
  const s16x4 l2 = tr_read<v_rd_off(D0, 2, 0)>(vb), h2 = tr_read<v_rd_off(D0, 2, 1)>(vb), l3 = tr_read<v_rd_off(D0, 3, 0)>(vb), h3 = tr_read<v_rd_off(D0, 3, 1)>(vb);
  asm volatile("s_waitcnt lgkmcnt(0)" ::: "memory"); SBAR();
#define ATT_PK(L, H) (bf16x8){L[0], L[1], L[2], L[3], H[0], H[1], H[2], H[3]}
  od = __builtin_amdgcn_mfma_f32_32x32x16_bf16(pa0, ATT_PK(l0, h0), od, 0, 0, 0);
  od = __builtin_amdgcn_mfma_f32_32x32x16_bf16(pa1, ATT_PK(l1, h1), od, 0, 0, 0);
  od = __builtin_amdgcn_mfma_f32_32x32x16_bf16(pa2, ATT_PK(l2, h2), od, 0, 0, 0);
  od = __builtin_amdgcn_mfma_f32_32x32x16_bf16(pa3, ATT_PK(l3, h3), od, 0, 0, 0);
#undef ATT_PK
}
__device__ __forceinline__ void pv_d0(f32x16* o, int vb, bf16x8 pa0, bf16x8 pa1, bf16x8 pa2, bf16x8 pa3) {
  pv_one<0>(o[0], vb, pa0, pa1, pa2, pa3); pv_one<1>(o[1], vb, pa0, pa1, pa2, pa3); pv_one<2>(o[2], vb, pa0, pa1, pa2, pa3); pv_one<3>(o[3], vb, pa0, pa1, pa2, pa3);
}
template <int DQK> __device__ __forceinline__ void qkt(f32x16& p0, f32x16& p1, const ALAS char* Ks, const bf16x8* qr, int r32, int hi) {
  p0 = f32x16{}; p1 = f32x16{};
#pragma unroll
  for (int d0 = 0; d0 < DQK / 16; ++d0) { const int cb = (d0 * 16 + hi * 8) * 2;
    const bf16x8 b0 = *(const ALAS bf16x8*)(Ks + kswz<DQK>(r32, cb));
    const bf16x8 b1 = *(const ALAS bf16x8*)(Ks + kswz<DQK>(32 + r32, cb));
    p0 = __builtin_amdgcn_mfma_f32_32x32x16_bf16(b0, qr[d0], p0, 0, 0, 0);
    p1 = __builtin_amdgcn_mfma_f32_32x32x16_bf16(b1, qr[d0], p1, 0, 0, 0);
    if ((d0 & 3) == 3) SBAR(); }
}

constexpr int SHM_V = 16384;
constexpr int L_V = 0, L_K = 32768, L_WS = L_K + 2 * 24576, L_RPB = L_WS + 2048, L_END = L_RPB + 2048;

struct RopeTab { float c[64 * 16]; float s[64 * 16]; };
constexpr double c_exp(double x) { double y = x / 1024.0, t = 1.0, sum = 1.0; for (int i = 1; i < 24; ++i) { t *= y / i; sum += t; } for (int i = 0; i < 10; ++i) sum *= sum; return sum; }
constexpr double c_sin(double x) { const double tp = 6.283185307179586476925286766559; long long k = (long long)(x / tp); x -= (double)k * tp; if (x > tp / 2) x -= tp;
  double t = x, sum = x; for (int i = 1; i < 16; ++i) { t *= -x * x / ((2.0 * i) * (2.0 * i + 1.0)); sum += t; } return sum; }
constexpr double c_cos(double x) { const double tp = 6.283185307179586476925286766559; long long k = (long long)(x / tp); x -= (double)k * tp; if (x > tp / 2) x -= tp;
  double t = 1.0, sum = 1.0; for (int i = 1; i < 16; ++i) { t *= -x * x / ((2.0 * i - 1.0) * (2.0 * i)); sum += t; } return sum; }
constexpr RopeTab make_rope() { RopeTab r{}; for (int j = 0; j < 16; ++j) { const double f = (double)(float)c_exp(-(double)j / 16.0 * 9.2103403719761836);
    for (int p = 0; p < 64; ++p) { const double a = (double)(float)((double)p * f); r.c[p * 16 + j] = (float)c_cos(a); r.s[p * 16 + j] = (float)c_sin(a); } } return r; }
__device__ const RopeTab g_rope = make_rope();

struct AttnP {
  const bf16_t* Q; int ldq, qhs;
  const bf16_t* K; int ldk, khs;
  const bf16_t* V; int ldv, vhs;
  const bf16_t* KPE;
  bf16_t* O;
  const float* rpb;
};

template <int MODE>
__device__ __forceinline__ void attn_unit(ALAS char* lds, const AttnP& P, int b, int h, int qb, bool ctxq) {
  constexpr int DQK = MODE ? 192 : 128, ND0 = DQK / 16, NKC = DQK / 64, SHM_K = 64 * DQK * 2;
  constexpr float SCALE = MODE ? 0.07216878364870322f : 0.08838834764831845f, C = SCALE * 1.4426950408889634f;
  int tid_ = threadIdx.x; asm volatile("" : "+v"(tid_));
  const int tid = tid_, wid = __builtin_amdgcn_readfirstlane(tid >> 6), lane = tid & 63, r32 = lane & 31, hi = lane >> 5;
  ALAS char* V_lds = lds + L_V; ALAS char* K_lds = lds + L_K;
  ALAS float* wsf = (ALAS float*)(lds + L_WS) + wid * 64; ALAS float* li_l = wsf; ALAS float* al_l = wsf + 32;
  ALAS float* rpbS = (ALAS float*)(lds + L_RPB);
  const int qtok0 = ctxq ? 8192 + b * 256 : b * 2048 + qb * 256;
  const int ctok0 = 8192 + b * 256, ltok0 = b * 2048;
  int NT, lo = 0;
  if (ctxq) NT = 4; else if (MODE == 1) NT = 36; else { lo = iclamp(4 * qb - 4, 0, 24); NT = 4 + (iclamp(4 * qb - 1, 0, 24) + 7 - lo + 1); }
#define TILE_TOK(t) (MODE == 1 ? (ctxq ? ctok0 + 64 * (t) : ((t) < 32 ? ltok0 + 64 * (t) : ctok0 + 64 * ((t) - 32))) : ((ctxq || (t) < 4) ? ctok0 + 64 * (t) : ltok0 + 64 * (lo + (t) - 4)))
  const int rq = 4 * qb + (wid >> 1), wq = 32 * (wid & 1) + r32, rs = iclamp(rq - 4, 0, 24), cs = iclamp(wq - 8, 0, 48);
  if (MODE == 0 && !ctxq) { for (int i = tid; i < 465; i += 512) rpbS[i] = P.rpb[h * 465 + i] * (1.0f / SCALE); }
  bf16x8 qr[ND0];
  { const bf16_t* Qp = P.Q + (size_t)(qtok0 + wid * 32 + r32) * P.ldq + h * P.qhs + hi * 8;
#pragma unroll
    for (int d0 = 0; d0 < ND0; ++d0) qr[d0] = *(const bf16x8*)(Qp + d0 * 16); }
  if constexpr (MODE == 1) {
    if (!ctxq) {
      const int prow = 4 * qb + (wid >> 1), pcol = 32 * (wid & 1) + r32;
#pragma unroll
      for (int hh = 0; hh < 2; ++hh) { const int pos = hh ? pcol : prow; const float* ct = g_rope.c + pos * 16 + 8 * hi; const float* st = g_rope.s + pos * 16 + 8 * hi;
        const f32x4 c0 = *(const f32x4*)ct, c1 = *(const f32x4*)(ct + 4), s0 = *(const f32x4*)st, s1 = *(const f32x4*)(st + 4);
        float cc[8], ss[8];
#pragma unroll
        for (int e = 0; e < 4; ++e) { cc[e] = c0[e]; cc[4 + e] = c1[e]; ss[e] = s0[e]; ss[4 + e] = s1[e]; }
        unsigned w1[4], w2[4];
#pragma unroll
        for (int e = 0; e < 8; e += 2) {
          const float a0 = bf2f(qr[8 + 2 * hh][e]), a1 = bf2f(qr[8 + 2 * hh][e + 1]), b0 = bf2f(qr[9 + 2 * hh][e]), b1 = bf2f(qr[9 + 2 * hh][e + 1]);
          w1[e >> 1] = cvtpk(a0 * cc[e] - b0 * ss[e], a1 * cc[e + 1] - b1 * ss[e + 1]); w2[e >> 1] = cvtpk(a0 * ss[e] + b0 * cc[e], a1 * ss[e + 1] + b1 * cc[e + 1]); }
        u32x4 x1 = {w1[0], w1[1], w1[2], w1[3]}, x2 = {w2[0], w2[1], w2[2], w2[3]};
        qr[8 + 2 * hh] = __builtin_bit_cast(bf16x8, x1); qr[9 + 2 * hh] = __builtin_bit_cast(bf16x8, x2); }
    }
  }
  const int sr = tid >> 4, sc = (tid & 15) * 8, vst0 = v_st(sr, sc), vst1 = v_st(32 + sr, sc);
  const bf16_t* Vb = P.V + h * P.vhs + sc;
  const bf16_t* kb[NKC]; int krow[NKC], kld[NKC], kdst[NKC];
#pragma unroll
  for (int i = 0; i < NKC; ++i) {
    if constexpr (MODE == 0) { krow[i] = sr + 32 * i; kb[i] = P.K + h * P.khs + sc; kld[i] = P.ldk; kdst[i] = kswz<DQK>(krow[i], sc * 2); }
    else { const int c = tid + 512 * i, row = c / 24, cc = c % 24; krow[i] = row; kdst[i] = kswz<DQK>(row, cc * 16);
      if (cc < 16) { kb[i] = P.K + h * P.khs + cc * 8; kld[i] = P.ldk; } else { kb[i] = P.KPE + (cc - 16) * 8; kld[i] = 64; } }
  }
  const int vb0 = (int)(uintptr_t)V_lds + v_rd_base(lane);
  bf16x8 sv0, sv1, sk[NKC];
#define ATT_SLOAD(tok) do { sv0 = *(const bf16x8*)(Vb + (size_t)((tok) + sr) * P.ldv); sv1 = *(const bf16x8*)(Vb + (size_t)((tok) + 32 + sr) * P.ldv); \
    _Pragma("unroll") for (int i_ = 0; i_ < NKC; ++i_) sk[i_] = *(const bf16x8*)(kb[i_] + (size_t)((tok) + krow[i_]) * kld[i_]); } while (0)
#define ATT_SWRITE(buf) do { *(ALAS bf16x8*)(V_lds + (buf) * SHM_V + vst0) = sv0; *(ALAS bf16x8*)(V_lds + (buf) * SHM_V + vst1) = sv1; \
    _Pragma("unroll") for (int i_ = 0; i_ < NKC; ++i_) *(ALAS bf16x8*)(K_lds + (buf) * SHM_K + kdst[i_]) = sk[i_]; } while (0)
  float m_reg = -1e30f, l_reg = 0.f; f32x16 o[4];
#pragma unroll
  for (int d = 0; d < 4; ++d) o[d] = f32x16{};
  { const int tok = TILE_TOK(0); ATT_SLOAD(tok); ATT_SWRITE(0); }
  __syncthreads();
  for (int t = 0; t < NT; ++t) {
    const int buf = t & 1;
    bool need = true; int kr = 0;
    if (MODE == 0 && !ctxq && t >= 4) { kr = lo + t - 4; need = (kr >= rs) && (kr < rs + 8); }
    if (need) {
      f32x16 p0, p1;
      qkt<DQK>(p0, p1, K_lds + buf * SHM_K, qr, r32, hi);
      if (MODE == 0 && !ctxq && t >= 4) {
        const int base = (kr - rq + 7) * 31 + 15 - wq;
#pragma unroll
        for (int r = 0; r < 16; ++r) { const int k0 = crow(r, hi), k1 = k0 + 32;
          const bool v0 = (k0 >= cs) && (k0 < cs + 16), v1 = (k1 >= cs) && (k1 < cs + 16);
          const float b0 = rpbS[v0 ? base + k0 : 0], b1 = rpbS[v1 ? base + k1 : 0];
          p0[r] = v0 ? p0[r] + b0 : -1e30f; p1[r] = v1 ? p1[r] + b1 : -1e30f; }
      }
      float pmax = p0[0];
#pragma unroll
      for (int r = 1; r < 16; ++r) pmax = fmaxf(pmax, p0[r]);
#pragma unroll
      for (int r = 0; r < 16; ++r) pmax = fmaxf(pmax, p1[r]);
      { auto rr = __builtin_amdgcn_permlane32_swap(__float_as_uint(pmax), __float_as_uint(pmax), false, false); pmax = fmaxf(__uint_as_float(rr[0]), __uint_as_float(rr[1])); }
      if (!__all(pmax <= m_reg)) {
        const float mn = fmaxf(m_reg, pmax), alpha = __builtin_amdgcn_exp2f((m_reg - mn) * C); m_reg = mn; l_reg *= alpha;
        if (hi == 0) al_l[r32] = alpha;
        asm volatile("s_waitcnt lgkmcnt(0)" ::: "memory");
#pragma unroll
        for (int r = 0; r < 16; ++r) { const float a = al_l[crow(r, hi)];
#pragma unroll
          for (int d = 0; d < 4; ++d) o[d][r] *= a; }
      }
      const float mnC = -m_reg * C;
#pragma unroll
      for (int r = 0; r < 16; ++r) { p0[r] = __builtin_amdgcn_exp2f(fmaf(p0[r], C, mnC)); p1[r] = __builtin_amdgcn_exp2f(fmaf(p1[r], C, mnC)); }
      float ps = 0.f;
#pragma unroll
      for (int r = 0; r < 16; ++r) ps += p0[r] + p1[r];
      { auto rr = __builtin_amdgcn_permlane32_swap(__float_as_uint(ps), __float_as_uint(ps), false, false); ps = __uint_as_float(rr[0]) + __uint_as_float(rr[1]); }
      l_reg += ps;
      bf16x8 pa0, pa1, pa2, pa3;
#define ATT_PK4(PP, BASE, OUT) do { unsigned a0 = cvtpk(PP[BASE + 0], PP[BASE + 1]), a1 = cvtpk(PP[BASE + 2], PP[BASE + 3]); \
    unsigned b0 = cvtpk(PP[BASE + 4], PP[BASE + 5]), b1 = cvtpk(PP[BASE + 6], PP[BASE + 7]); \
    auto r0 = __builtin_amdgcn_permlane32_swap(a0, b0, false, false); auto r1 = __builtin_amdgcn_permlane32_swap(a1, b1, false, false); \
    u32x4 w = {r0[0], r1[0], r0[1], r1[1]}; OUT = __builtin_bit_cast(bf16x8, w); } while (0)
      ATT_PK4(p0, 0, pa0); ATT_PK4(p0, 8, pa1); ATT_PK4(p1, 0, pa2); ATT_PK4(p1, 8, pa3);
#undef ATT_PK4
      SBAR();
      if (t + 1 < NT) { const int tok = TILE_TOK(t + 1); ATT_SLOAD(tok); }
      SBAR();
      pv_d0(o, vb0 + buf * SHM_V, pa0, pa1, pa2, pa3);
    } else {
      if (t + 1 < NT) { const int tok = TILE_TOK(t + 1); ATT_SLOAD(tok); }
    }
    if (t + 1 < NT) ATT_SWRITE(buf ^ 1);
    __syncthreads();
  }
  if (hi == 0) li_l[r32] = l_reg;
  asm volatile("s_waitcnt lgkmcnt(0)" ::: "memory");
  bf16_t* Ow = P.O + (size_t)(qtok0 + wid * 32) * 2048 + h * 128 + r32;
#pragma unroll
  for (int r = 0; r < 16; ++r) { const int orow = crow(r, hi); const float rl = __builtin_amdgcn_rcpf(li_l[orow]);
#pragma unroll
    for (int d0 = 0; d0 < 4; ++d0) Ow[(size_t)orow * 2048 + d0 * 32] = (bf16_t)(cvtpk(o[d0][r] * rl, 0.f) & 0xffffu); }
#undef TILE_TOK
#undef ATT_SLOAD
#undef ATT_SWRITE
}

__device__ __forceinline__ void sgu_mix_unit(ALAS char* lds, const bf16_t* UV, const float* stats, const float* ln_g, const float* ln_b, const bf16_t* WSB, const float* bs, bf16_t* O, int c, int g) {
  int tid_ = threadIdx.x; asm volatile("" : "+v"(tid_));
  const int tid = tid_, wid = __builtin_amdgcn_readfirstlane(tid >> 6), lane = tid & 63, r32 = lane & 31, hi = lane >> 5;
  const int sr = tid >> 4, sc = (tid & 15) * 8, tok0 = c * 128;
  float gc[8], bc[8];
  { const f32x4 g0 = *(const f32x4*)(ln_g + g * 128 + sc), g1 = *(const f32x4*)(ln_g + g * 128 + sc + 4), b0 = *(const f32x4*)(ln_b + g * 128 + sc), b1 = *(const f32x4*)(ln_b + g * 128 + sc + 4);
#pragma unroll
    for (int i = 0; i < 4; ++i) { gc[i] = g0[i]; gc[4 + i] = g1[i]; bc[i] = b0[i]; bc[4 + i] = b1[i]; } }
#pragma unroll
  for (int tl = 0; tl < 2; ++tl)
#pragma unroll
    for (int hf = 0; hf < 2; ++hf) { const int row = hf * 32 + sr, tok = tok0 + tl * 64 + row;
      const bf16x8 raw = *(const bf16x8*)(UV + (size_t)tok * 4096 + 2048 + g * 128 + sc);
      const float mu = stats[tok * 2], rstd = stats[tok * 2 + 1];
      unsigned w[4];
#pragma unroll
      for (int i = 0; i < 8; i += 2) { const float a = (bf2f(raw[i]) - mu) * rstd * gc[i] + bc[i], bq = (bf2f(raw[i + 1]) - mu) * rstd * gc[i + 1] + bc[i + 1]; w[i >> 1] = cvtpk(a, bq); }
      u32x4 ww = {w[0], w[1], w[2], w[3]};
      *(ALAS bf16x8*)(lds + tl * SHM_V + v_st(row, sc)) = __builtin_bit_cast(bf16x8, ww); }
  __syncthreads();
  const int wp = wid & 3, wd = wid >> 2;
  const bf16_t* Ap = WSB + ((size_t)g * 128 + 32 * wp + r32) * 128 + 8 * hi;
  f32x16 o0 = f32x16{}, o1 = f32x16{};
#pragma unroll
  for (int tl = 0; tl < 2; ++tl) {
    const bf16x8 pa0 = *(const bf16x8*)(Ap + tl * 64), pa1 = *(const bf16x8*)(Ap + tl * 64 + 16), pa2 = *(const bf16x8*)(Ap + tl * 64 + 32), pa3 = *(const bf16x8*)(Ap + tl * 64 + 48);
    const int vb = (int)(uintptr_t)(lds + tl * SHM_V) + v_rd_base(lane);
    if (wd == 0) { pv_one<0>(o0, vb, pa0, pa1, pa2, pa3); pv_one<1>(o1, vb, pa0, pa1, pa2, pa3); }
    else         { pv_one<2>(o0, vb, pa0, pa1, pa2, pa3); pv_one<3>(o1, vb, pa0, pa1, pa2, pa3); }
  }
#pragma unroll
  for (int r = 0; r < 16; ++r) { const int p = 32 * wp + crow(r, hi), tok = tok0 + p; const float bsv = bs[g * 128 + p];
    const size_t col = (size_t)g * 128 + 64 * wd + r32;
    const float u0 = bf2f((short)UV[(size_t)tok * 4096 + col]), u1 = bf2f((short)UV[(size_t)tok * 4096 + col + 32]);
    O[(size_t)tok * 2048 + col] = (bf16_t)(cvtpk(u0 * (o0[r] + bsv), 0.f) & 0xffffu);
    O[(size_t)tok * 2048 + col + 32] = (bf16_t)(cvtpk(u1 * (o1[r] + bsv), 0.f) & 0xffffu); }
  __syncthreads();
}
#undef SBAR
}
constexpr int DM = 2048, NBATCH = 4, SEQ = 2048, DEPTH = 4, CTXL = 256;
constexpr int ML = NBATCH * SEQ, MC = NBATCH * CTXL, MT = ML + MC;
constexpr int DFF = 5632, DFF2 = 2 * DFF;
constexpr int NHEAD = 16;
constexpr int MLA_IN = 1088, MLA_INP = 1280, MLA_QN = 3072, MLA_KVN = 4096;
constexpr int SGU_N = 4096;
constexpr float EPS = 1e-6f;
constexpr int MODS_ROW = 6 * DM, MODS_LAYER = 5 * MODS_ROW;

enum { I_X = 0, I_C, I_CTX, I_CCTX, I_ADAW, I_ADAB, I_NORMG, I_FINALG, I_AQKV, I_AWO, I_ARPB, I_BWIN, I_BQN, I_BKVN, I_BUQ, I_BUKV, I_BWO,
       I_CWIN, I_CBIN, I_CLNG, I_CLNB, I_CWS, I_CBS, I_CWO, I_FWIN, I_FCW, I_FCB, I_FWOUT, N_IN };

constexpr size_t al256(size_t x) { return (x + 255) & ~(size_t)255; }
constexpr size_t WS_CTL = 0, CTL_ZERO_BYTES = 2u << 20;
constexpr size_t WS_MODS = 1u << 20;
static_assert(WS_MODS + (size_t)DEPTH * MODS_LAYER * 4 <= CTL_ZERO_BYTES, "mods inside the zeroed region");
constexpr size_t WS_WT_QKV = CTL_ZERO_BYTES;
constexpr size_t WS_WT_AO  = WS_WT_QKV + al256((size_t)2 * 6144 * 2048 * 2);
constexpr size_t WS_WT_BIN = WS_WT_AO + al256((size_t)2 * 2048 * 2048 * 2);
constexpr size_t WS_WT_UQ  = WS_WT_BIN + al256((size_t)MLA_INP * 2048 * 2);
constexpr size_t WS_WT_UKV = WS_WT_UQ + al256((size_t)3072 * 512 * 2);
constexpr size_t WS_WT_BO  = WS_WT_UKV + al256((size_t)4096 * 512 * 2);
constexpr size_t WS_WT_CIN = WS_WT_BO + al256((size_t)2048 * 2048 * 2);
constexpr size_t WS_WT_CO  = WS_WT_CIN + al256((size_t)4096 * 2048 * 2);
constexpr size_t WS_WT_F1  = WS_WT_CO + al256((size_t)2048 * 2048 * 2);
constexpr size_t WS_WT_F2  = WS_WT_F1 + al256((size_t)4 * DFF2 * 2048 * 2);
constexpr size_t WS_WSB    = WS_WT_F2 + al256((size_t)4 * 2048 * DFF * 2);
constexpr size_t WS_X      = WS_WSB + al256((size_t)16 * 128 * 128 * 2);
constexpr size_t WS_H      = WS_X + al256((size_t)MT * DM * 4);
constexpr size_t WS_QKV    = WS_H + al256((size_t)MT * DM * 2);
constexpr size_t WS_KV     = WS_QKV + al256((size_t)MT * MLA_QN * 2);
constexpr size_t WS_CW     = WS_QKV + al256((size_t)MT * (MLA_QN + MLA_KVN) * 2);
constexpr size_t WS_CQN    = WS_CW + al256((size_t)MT * MLA_INP * 4);
constexpr size_t WS_CKVN   = WS_CQN + al256((size_t)MT * 512 * 2);
constexpr size_t WS_KPE    = WS_CKVN + al256((size_t)MT * 512 * 2);
constexpr size_t WS_STATS  = WS_KPE + al256((size_t)MT * 64 * 2);
constexpr size_t WS_O      = WS_STATS + al256((size_t)MT * 2 * 4);
constexpr size_t WS_U      = WS_O + al256((size_t)MT * DM * 2);
constexpr size_t WS_ACT    = WS_U + al256((size_t)MT * DFF2 * 2);
constexpr size_t WS_END    = WS_ACT + al256((size_t)MT * DFF * 2);
static_assert((size_t)MT * 6144 * 2 <= (size_t)MT * (MLA_QN + MLA_KVN) * 2, "NA QKV fits the shared region");
constexpr int CW_BAR = 4096;

constexpr int NWAVES = 8, NTHREADS = 512;
constexpr int RING_BYTES = 131072, LDSCTL_OFF = RING_BYTES, MISC_OFF = LDSCTL_OFF + 320, LDS_BYTES = 147456;
static_assert(att::L_END <= RING_BYTES && pg8::STAGE_BYTES <= RING_BYTES, "phase scratch fits");

constexpr int STEPS_PER_LAYER = 11, STEP_FINAL = 1 + DEPTH * STEPS_PER_LAYER, N_STEPS = STEP_FINAL + 1;
__host__ __device__ constexpr bool step_used(int kind, int s) { return kind == 0 ? (s != 3 && s != 4 && s != 5) : (kind == 2 ? (s != 4 && s != 5) : true); }

struct Args { const float* in[N_IN]; float* out; unsigned char* ws; int step_lo, step_hi; };
static_assert(sizeof(Args) == N_IN * 8 + 8 + 8 + 8, "Args has no padding");

struct Frame {
    LAS unsigned char* lds;
    int tid, lane, wave, G, gw, NGW;
};

__device__ __forceinline__ float wave_sum(float v) {
#pragma unroll
    for (int o = 1; o < 64; o <<= 1) v += __shfl_xor(v, o);
    return v;
}
__device__ __forceinline__ unsigned cvt_pk(float lo, float hi) { unsigned r; asm volatile("v_cvt_pk_bf16_f32 %0, %1, %2" : "=v"(r) : "v"(lo), "v"(hi)); return r; }
__device__ __forceinline__ float bf_lo(unsigned w) { return __uint_as_float(w << 16); }
__device__ __forceinline__ float bf_hi(unsigned w) { return __uint_as_float(w & 0xffff0000u); }

__device__ __forceinline__ void transpose_item(const float* W, int K, int N, bf16* WT, LAS float* scr, int item, int lane) {
    const int nblk = N / 32, kb = item / nblk, nb = item % nblk, k0 = 64 * kb, n0 = 32 * nb;
#pragma unroll 8
    for (int i = 0; i < 32; ++i) { const int kk = 2 * i + (lane >> 5); scr[kk * 33 + (lane & 31)] = W[(size_t)(k0 + kk) * N + n0 + (lane & 31)]; }
    LDS_WAIT(); asm volatile("" ::: "memory");
    const int c = lane & 7;
#pragma unroll
    for (int j = 0; j < 4; ++j) { const int n = (lane >> 3) + 8 * j; const LAS float* s = scr + (8 * c) * 33 + n;
        v4u o; o.x = cvt_pk(s[0 * 33], s[1 * 33]); o.y = cvt_pk(s[2 * 33], s[3 * 33]); o.z = cvt_pk(s[4 * 33], s[5 * 33]); o.w = cvt_pk(s[6 * 33], s[7 * 33]);
        *(v4u*)(WT + (size_t)(n0 + n) * K + k0 + 8 * c) = o; }
    LDS_WAIT(); asm volatile("" ::: "memory");
}
__device__ __forceinline__ void transpose_matrix(Frame& F, const float* W, int K, int N, bf16* WT, LAS float* scr, int& it) {
    const int nitems = (K / 64) * (N / 32);
    for (; it < nitems; it += F.NGW) transpose_item(W, K, N, WT, scr, it, F.lane);
    it -= nitems;
}

__device__ __forceinline__ void phase_prologue(Frame& F, const Args& a) {
    unsigned char* ws = a.ws;
    { LAS float* scr = (LAS float*)(F.lds + F.wave * 16384); int it = F.gw;
      for (int j = 0; j < 2; ++j) transpose_matrix(F, a.in[I_AQKV] + (size_t)j * 2048 * 6144, 2048, 6144, (bf16*)(ws + WS_WT_QKV) + (size_t)j * 6144 * 2048, scr, it);
      for (int j = 0; j < 2; ++j) transpose_matrix(F, a.in[I_AWO] + (size_t)j * 2048 * 2048, 2048, 2048, (bf16*)(ws + WS_WT_AO) + (size_t)j * 2048 * 2048, scr, it);
      transpose_matrix(F, a.in[I_BWIN], 2048, MLA_IN, (bf16*)(ws + WS_WT_BIN), scr, it);
      transpose_matrix(F, a.in[I_BUQ], 512, 3072, (bf16*)(ws + WS_WT_UQ), scr, it);
      transpose_matrix(F, a.in[I_BUKV], 512, 4096, (bf16*)(ws + WS_WT_UKV), scr, it);
      transpose_matrix(F, a.in[I_BWO], 2048, 2048, (bf16*)(ws + WS_WT_BO), scr, it);
      transpose_matrix(F, a.in[I_CWIN], 2048, 4096, (bf16*)(ws + WS_WT_CIN), scr, it);
      transpose_matrix(F, a.in[I_CWO], 2048, 2048, (bf16*)(ws + WS_WT_CO), scr, it);
      for (int l = 0; l < DEPTH; ++l) transpose_matrix(F, a.in[I_FWIN] + (size_t)l * 2048 * DFF2, 2048, DFF2, (bf16*)(ws + WS_WT_F1) + (size_t)l * DFF2 * 2048, scr, it);
      for (int l = 0; l < DEPTH; ++l) transpose_matrix(F, a.in[I_FWOUT] + (size_t)l * DFF * 2048, DFF, 2048, (bf16*)(ws + WS_WT_F2) + (size_t)l * 2048 * DFF, scr, it);
    }
    __syncthreads();
    { const int gt = F.gw * 64 + F.lane, NGT = F.NGW * 64;
      const float* wsf = a.in[I_CWS]; bf16* wsb = (bf16*)(ws + WS_WSB);
      for (int i = gt; i < 16 * 128 * 128 / 4; i += NGT) { const f32x4 v = *(const f32x4*)(wsf + (size_t)i * 4); uint2 o; o.x = cvt_pk(v.x, v.y); o.y = cvt_pk(v.z, v.w); *(uint2*)(wsb + (size_t)i * 4) = o; }
      float* X = (float*)(ws + WS_X);
      for (size_t i = gt; i < (size_t)ML * DM / 4; i += NGT) *(f32x4*)(X + i * 4) = *(const f32x4*)(a.in[I_X] + i * 4);
      for (size_t i = gt; i < (size_t)MC * DM / 4; i += NGT) *(f32x4*)(X + (size_t)ML * DM + i * 4) = *(const f32x4*)(a.in[I_CTX] + i * 4);
    }
    { LAS float* S = (LAS float*)F.lds;
      for (int i = F.tid; i < 5 * DM; i += NTHREADS) { const float v = i < 4 * DM ? a.in[I_C][i] : a.in[I_CCTX][i - 4 * DM]; S[i] = v / (1.f + __expf(-v)); }
      __syncthreads();
      float* mods = (float*)(ws + WS_MODS);
      constexpr int NCB = MODS_ROW / 256, NKC = DM / 128, NTASK = DEPTH * NCB * NKC;
      for (int tk = F.gw; tk < NTASK; tk += F.NGW) {
        const int kc = tk % NKC, cb = (tk / NKC) % NCB, l = tk / (NKC * NCB);
        const int n = cb * 256 + F.lane * 4, k0 = kc * 128;
        const float* wp = a.in[I_ADAW] + ((size_t)l * DM + k0) * MODS_ROW + n;
        f32x4 acc[5];
#pragma unroll
        for (int r = 0; r < 5; ++r) acc[r] = (f32x4){0.f, 0.f, 0.f, 0.f};
#pragma unroll 8
        for (int k = 0; k < 128; ++k) { const f32x4 w = *(const f32x4*)(wp + (size_t)k * MODS_ROW);
#pragma unroll
          for (int r = 0; r < 5; ++r) acc[r] = acc[r] + w * S[r * DM + k0 + k]; }
        if (kc == 0) { const f32x4 bv = *(const f32x4*)(a.in[I_ADAB] + (size_t)l * MODS_ROW + n);
#pragma unroll
          for (int r = 0; r < 5; ++r) acc[r] = acc[r] + bv; }
#pragma unroll
        for (int r = 0; r < 5; ++r) { float* mp = mods + ((size_t)l * 5 + r) * MODS_ROW + n;
          atomicAdd(mp + 0, acc[r].x); atomicAdd(mp + 1, acc[r].y); atomicAdd(mp + 2, acc[r].z); atomicAdd(mp + 3, acc[r].w); }
      }
      __syncthreads();
    }
}

__device__ __forceinline__ void phase_norm(Frame& F, const Args& a, int layer, int which, int nrows) {
    const float* X = (const float*)(a.ws + WS_X); bf16* H = (bf16*)(a.ws + WS_H);
    const float* g = a.in[I_NORMG] + ((size_t)layer * 2 + which) * DM;
    const float* md = (const float*)(a.ws + WS_MODS) + (size_t)layer * MODS_LAYER;
    for (int row = F.gw; row < nrows; row += F.NGW) {
        const int bidx = row < ML ? (row >> 11) : 4;
        const float* shift = md + (size_t)bidx * MODS_ROW + (which * 3 + 0) * DM; const float* scale = shift + DM;
        const float* xr = X + (size_t)row * DM + F.lane * 4;
        f32x4 v[8]; float ss = 0.f;
#pragma unroll
        for (int j = 0; j < 8; ++j) { v[j] = *(const f32x4*)(xr + 256 * j); ss += (v[j].x * v[j].x + v[j].y * v[j].y) + (v[j].z * v[j].z + v[j].w * v[j].w); }
        const float rstd = 1.f / sqrtf(wave_sum(ss) * (1.f / DM) + EPS);
        bf16* hr = H + (size_t)row * DM + F.lane * 4;
#pragma unroll
        for (int j = 0; j < 8; ++j) { const int c = 256 * j + F.lane * 4;
            const f32x4 gg = *(const f32x4*)(g + c), sc = *(const f32x4*)(scale + c), sh = *(const f32x4*)(shift + c);
            const f32x4 y = (v[j] * rstd) * gg; const f32x4 h = y * (sc + 1.f) + sh;
            uint2 o; o.x = cvt_pk(h.x, h.y); o.y = cvt_pk(h.z, h.w); *(uint2*)(hr + 256 * j) = o; }
    }
}
__device__ __forceinline__ void phase_final(Frame& F, const Args& a) {
    const float* X = (const float*)(a.ws + WS_X); const float* g = a.in[I_FINALG];
    for (int row = F.gw; row < ML; row += F.NGW) {
        const float* xr = X + (size_t)row * DM + F.lane * 4;
        f32x4 v[8]; float ss = 0.f;
#pragma unroll
        for (int j = 0; j < 8; ++j) { v[j] = *(const f32x4*)(xr + 256 * j); ss += (v[j].x * v[j].x + v[j].y * v[j].y) + (v[j].z * v[j].z + v[j].w * v[j].w); }
        const float rstd = 1.f / sqrtf(wave_sum(ss) * (1.f / DM) + EPS);
        float* orow = a.out + (size_t)row * DM + F.lane * 4;
#pragma unroll
        for (int j = 0; j < 8; ++j) { const f32x4 gg = *(const f32x4*)(g + 256 * j + F.lane * 4); *(f32x4*)(orow + 256 * j) = (v[j] * rstd) * gg; }
    }
}
__device__ __forceinline__ void phase_mla_norm(Frame& F, const Args& a) {
    const float* CW = (const float*)(a.ws + WS_CW); bf16* CQN = (bf16*)(a.ws + WS_CQN); bf16* CKVN = (bf16*)(a.ws + WS_CKVN); bf16* KPE = (bf16*)(a.ws + WS_KPE);
    const float* qn = a.in[I_BQN]; const float* kn = a.in[I_BKVN];
    for (int row = F.gw; row < MT; row += F.NGW) {
        const float* r = CW + (size_t)row * MLA_INP;
        const f32x4 q0 = *(const f32x4*)(r + F.lane * 8), q1 = *(const f32x4*)(r + F.lane * 8 + 4), k0 = *(const f32x4*)(r + 512 + F.lane * 8), k1 = *(const f32x4*)(r + 512 + F.lane * 8 + 4);
        const float pe = r[1024 + F.lane];
        float sq = (q0.x * q0.x + q0.y * q0.y) + (q0.z * q0.z + q0.w * q0.w) + (q1.x * q1.x + q1.y * q1.y) + (q1.z * q1.z + q1.w * q1.w);
        float sk = (k0.x * k0.x + k0.y * k0.y) + (k0.z * k0.z + k0.w * k0.w) + (k1.x * k1.x + k1.y * k1.y) + (k1.z * k1.z + k1.w * k1.w);
        const float rq = 1.f / sqrtf(wave_sum(sq) * (1.f / 512.f) + EPS), rk = 1.f / sqrtf(wave_sum(sk) * (1.f / 512.f) + EPS);
        const f32x4 gq0 = *(const f32x4*)(qn + F.lane * 8), gq1 = *(const f32x4*)(qn + F.lane * 8 + 4), gk0 = *(const f32x4*)(kn + F.lane * 8), gk1 = *(const f32x4*)(kn + F.lane * 8 + 4);
        const f32x4 a0 = (q0 * rq) * gq0, a1 = (q1 * rq) * gq1, b0 = (k0 * rk) * gk0, b1 = (k1 * rk) * gk1;
        v4u o; o.x = cvt_pk(a0.x, a0.y); o.y = cvt_pk(a0.z, a0.w); o.z = cvt_pk(a1.x, a1.y); o.w = cvt_pk(a1.z, a1.w);
        *(v4u*)(CQN + (size_t)row * 512 + F.lane * 8) = o;
        o.x = cvt_pk(b0.x, b0.y); o.y = cvt_pk(b0.z, b0.w); o.z = cvt_pk(b1.x, b1.y); o.w = cvt_pk(b1.z, b1.w);
        *(v4u*)(CKVN + (size_t)row * 512 + F.lane * 8) = o;
        float outv = pe;
        const float partner = __shfl_xor(pe, 16);
        if (row < ML) { const int t = row & (SEQ - 1), pos = (F.lane >> 5) ? (t & 63) : (t >> 6), j = F.lane & 15;
            const float cs = att::g_rope.c[pos * 16 + j], sn = att::g_rope.s[pos * 16 + j];
            outv = ((F.lane >> 4) & 1) ? (partner * sn + pe * cs) : (pe * cs - partner * sn); }
        KPE[(size_t)row * 64 + F.lane] = (bf16)(cvt_pk(outv, 0.f) & 0xffffu);
    }
}
__device__ __forceinline__ void phase_sgu_stats(Frame& F, const Args& a) {
    const bf16* UV = (const bf16*)(a.ws + WS_QKV); float* st = (float*)(a.ws + WS_STATS);
    for (int row = F.gw; row < MT; row += F.NGW) {
        const bf16* r = UV + (size_t)row * SGU_N + 2048 + F.lane * 8;
        float v[32]; float s = 0.f;
#pragma unroll
        for (int j = 0; j < 4; ++j) { const v4u w = *(const v4u*)(r + 512 * j);
            v[8 * j + 0] = bf_lo(w.x); v[8 * j + 1] = bf_hi(w.x); v[8 * j + 2] = bf_lo(w.y); v[8 * j + 3] = bf_hi(w.y); v[8 * j + 4] = bf_lo(w.z); v[8 * j + 5] = bf_hi(w.z); v[8 * j + 6] = bf_lo(w.w); v[8 * j + 7] = bf_hi(w.w); }
#pragma unroll
        for (int i = 0; i < 32; ++i) s += v[i];
        const float mean = wave_sum(s) * (1.f / 2048.f); float q = 0.f;
#pragma unroll
        for (int i = 0; i < 32; ++i) { const float d = v[i] - mean; q += d * d; }
        const float rstd = 1.f / sqrtf(wave_sum(q) * (1.f / 2048.f) + EPS);
        if (F.lane == 0) { st[row * 2] = mean; st[row * 2 + 1] = rstd; }
    }
}
__device__ __forceinline__ void phase_conv(Frame& F, const Args& a, int layer, int nrows) {
    const bf16* U = (const bf16*)(a.ws + WS_U); bf16* ACT = (bf16*)(a.ws + WS_ACT);
    const float* cw = a.in[I_FCW] + (size_t)layer * 3 * DFF2; const float* cb = a.in[I_FCB] + (size_t)layer * DFF2;
    const int nitems = (nrows / 16) * 11;
    for (int it = F.gw; it < nitems; it += F.NGW) {
        const int cbk = it % 11, t0 = (it / 11) * 16, j0 = cbk * 512 + F.lane * 8;
        float wa[3][8], wg[3][8], ba[8], bg[8];
#pragma unroll
        for (int k = 0; k < 3; ++k)
#pragma unroll
            for (int h = 0; h < 2; ++h) { const f32x4 x = *(const f32x4*)(cw + (size_t)k * DFF2 + j0 + 4 * h), y = *(const f32x4*)(cw + (size_t)k * DFF2 + DFF + j0 + 4 * h);
                wa[k][4 * h] = x.x; wa[k][4 * h + 1] = x.y; wa[k][4 * h + 2] = x.z; wa[k][4 * h + 3] = x.w; wg[k][4 * h] = y.x; wg[k][4 * h + 1] = y.y; wg[k][4 * h + 2] = y.z; wg[k][4 * h + 3] = y.w; }
#pragma unroll
        for (int h = 0; h < 2; ++h) { const f32x4 x = *(const f32x4*)(cb + j0 + 4 * h), y = *(const f32x4*)(cb + DFF + j0 + 4 * h);
            ba[4 * h] = x.x; ba[4 * h + 1] = x.y; ba[4 * h + 2] = x.z; ba[4 * h + 3] = x.w; bg[4 * h] = y.x; bg[4 * h + 1] = y.y; bg[4 * h + 2] = y.z; bg[4 * h + 3] = y.w; }
        const int n = t0 < ML ? SEQ : CTXL, pos0 = t0 < ML ? (t0 & (SEQ - 1)) : ((t0 - ML) & (CTXL - 1));
        const v4u zero = {0u, 0u, 0u, 0u};
        const bf16* up = U + (size_t)t0 * DFF2 + j0;
        v4u pa = zero, pg = zero;
        if (pos0 != 0) { pa = *(const v4u*)(up - DFF2); pg = *(const v4u*)(up - DFF2 + DFF); }
        v4u ca = *(const v4u*)(up), cg = *(const v4u*)(up + DFF);
#pragma unroll 4
        for (int i = 0; i < 16; ++i) {
            v4u na = zero, ng = zero;
            if (!(i == 15 && pos0 + 15 == n - 1)) { na = *(const v4u*)(up + (size_t)(i + 1) * DFF2); ng = *(const v4u*)(up + (size_t)(i + 1) * DFF2 + DFF); }
            const unsigned pav[4] = {pa.x, pa.y, pa.z, pa.w}, cav[4] = {ca.x, ca.y, ca.z, ca.w}, nav[4] = {na.x, na.y, na.z, na.w};
            const unsigned pgv[4] = {pg.x, pg.y, pg.z, pg.w}, cgv[4] = {cg.x, cg.y, cg.z, cg.w}, ngv[4] = {ng.x, ng.y, ng.z, ng.w};
            unsigned ow[4];
#pragma unroll
            for (int e = 0; e < 4; ++e) {
                const float a0 = wa[0][2 * e] * bf_lo(pav[e]) + wa[1][2 * e] * bf_lo(cav[e]) + wa[2][2 * e] * bf_lo(nav[e]) + ba[2 * e];
                const float a1 = wa[0][2 * e + 1] * bf_hi(pav[e]) + wa[1][2 * e + 1] * bf_hi(cav[e]) + wa[2][2 * e + 1] * bf_hi(nav[e]) + ba[2 * e + 1];
                const float g0 = wg[0][2 * e] * bf_lo(pgv[e]) + wg[1][2 * e] * bf_lo(cgv[e]) + wg[2][2 * e] * bf_lo(ngv[e]) + bg[2 * e];
                const float g1 = wg[0][2 * e + 1] * bf_hi(pgv[e]) + wg[1][2 * e + 1] * bf_hi(cgv[e]) + wg[2][2 * e + 1] * bf_hi(ngv[e]) + bg[2 * e + 1];
                const float s0 = g0 * __builtin_amdgcn_rcpf(1.f + __builtin_amdgcn_exp2f(-1.4426950408889634f * g0));
                const float s1 = g1 * __builtin_amdgcn_rcpf(1.f + __builtin_amdgcn_exp2f(-1.4426950408889634f * g1));
                ow[e] = cvt_pk(a0 * s0, a1 * s1); }
            v4u o = {ow[0], ow[1], ow[2], ow[3]};
            *(v4u*)(ACT + (size_t)(t0 + i) * DFF + j0) = o;
            pa = ca; pg = cg; ca = na; cg = ng;
        }
    }
}

__global__ void __launch_bounds__(NTHREADS, 2) fwd_kernel(Args args) {
    extern __shared__ __attribute__((aligned(16))) unsigned char lds_raw[];
#define MKFRAME() Frame F; { int t_ = threadIdx.x; asm volatile("" : "+v"(t_)); F.lds = (LAS unsigned char*)lds_raw; F.tid = t_; F.lane = t_ & 63; F.wave = __builtin_amdgcn_readfirstlane(t_ >> 6); \
      F.G = gridDim.x; F.gw = blockIdx.x * NWAVES + F.wave; F.NGW = F.G * NWAVES; }
    LAS unsigned char* const lds0 = (LAS unsigned char*)lds_raw; const int G = gridDim.x;
    volatile LAS unsigned* MISC = (volatile LAS unsigned*)(lds0 + MISC_OFF);
    for (int u = threadIdx.x; u < (LDS_BYTES - LDSCTL_OFF) / 4; u += NTHREADS) ((LAS unsigned*)(lds0 + LDSCTL_OFF))[u] = 0u;
    __syncthreads();
    const int lo = args.step_lo, hi = args.step_hi;
    unsigned char* ws = args.ws;
    XcdBarrier bar; bar.bar = (unsigned*)(ws + WS_CTL) + CW_BAR; bar.x = 0; bar.st = nullptr;
    const bool multi = (hi - lo) > 1;
    if (multi) bar = xcd_barrier_post((unsigned*)(ws + WS_CTL) + CW_BAR, MISC + 8);
#ifndef EN_MASK
#define EN_MASK 0x1ffff
#endif
#define EN(k) (((EN_MASK) >> (k)) & 1)
#define IN(k) (lo <= (k) && (k) < hi)
#define SEAM(k) do { if ((k) + 1 < hi) xcd_barrier(bar); } while (0)
    LAS unsigned char* ring = lds0;
    const float* mods_all = (const float*)(ws + WS_MODS);
    bf16* H = (bf16*)(ws + WS_H); bf16* QKV = (bf16*)(ws + WS_QKV); bf16* OB = (bf16*)(ws + WS_O); bf16* UB = (bf16*)(ws + WS_U); bf16* ACT = (bf16*)(ws + WS_ACT);
    float* X = (float*)(ws + WS_X);

    if (EN(0) && IN(0)) { MKFRAME(); phase_prologue(F, args); SEAM(0); }

    for (int layer = 0; layer < DEPTH; ++layer) {
        const int kind = layer % 3, jm = layer / 3, sb = 1 + layer * STEPS_PER_LAYER;
        const bool last = layer == DEPTH - 1;
        const int mrows = last ? ML : MT;
        const float* mods = mods_all + (size_t)layer * MODS_LAYER;
        if (EN(1) && IN(sb + 0)) { MKFRAME(); phase_norm(F, args, layer, 0, MT); SEAM(sb + 0); }
        if (kind == 0) {
            if (EN(2) && IN(sb + 1)) { pg8::Gemm g{H, (const bf16*)(ws + WS_WT_QKV) + (size_t)jm * 6144 * 2048, MT, 6144, 2048}; pg8::StaticOrder S; S.init(MT, 6144, G, (int)blockIdx.x);
                pg8::EpiBf16<0> E{QKV, 6144, nullptr, 0, 0, 1.f};
                pg8::gemm_phase<pg8::EpiBf16<0>, pg8::StaticOrder, true, true>(ring, g, S, E); SEAM(sb + 1); }
            if (EN(3) && IN(sb + 2)) { att::AttnP P{QKV, 6144, 128, QKV + 2048, 6144, 128, QKV + 4096, 6144, 128, nullptr, OB, args.in[I_ARPB] + (size_t)jm * 16 * 465};
                const int nun = last ? 512 : 576;
                for (int u = blockIdx.x; u < nun; u += G) { if (u < 512) att::attn_unit<0>((LAS char*)ring, P, u >> 7, (u >> 3) & 15, u & 7, false); else att::attn_unit<0>((LAS char*)ring, P, (u - 512) >> 4, (u - 512) & 15, 0, true); }
                SEAM(sb + 2); }
        } else if (kind == 1) {
            if (EN(4) && IN(sb + 1)) { pg8::Gemm g{H, (const bf16*)(ws + WS_WT_BIN), MT, MLA_INP, 2048}; pg8::StaticOrder S; S.init(MT, MLA_INP, G, (int)blockIdx.x);
                pg8::EpiF32 E{(float*)(ws + WS_CW), MLA_INP};
                pg8::gemm_phase<pg8::EpiF32, pg8::StaticOrder, true, true>(ring, g, S, E); SEAM(sb + 1); }
            if (EN(5) && IN(sb + 2)) { MKFRAME(); phase_mla_norm(F, args); SEAM(sb + 2); }
            if (EN(6) && IN(sb + 3)) {
                { pg8::Gemm g{(const bf16*)(ws + WS_CQN), (const bf16*)(ws + WS_WT_UQ), MT, MLA_QN, 512}; pg8::StaticOrder S; S.init(MT, MLA_QN, G, (int)blockIdx.x);
                  pg8::EpiBf16<0> E{QKV, MLA_QN, nullptr, 0, 0, 1.f};
                  pg8::gemm_phase<pg8::EpiBf16<0>, pg8::StaticOrder, true, true>(ring, g, S, E); }
                SEAM(sb + 3); }
            if (EN(16) && IN(sb + 4)) {
                { pg8::Gemm g{(const bf16*)(ws + WS_CKVN), (const bf16*)(ws + WS_WT_UKV), MT, MLA_KVN, 512}; pg8::StaticOrder S; S.init(MT, MLA_KVN, G, (int)blockIdx.x);
                  pg8::EpiBf16<0> E{(bf16*)(ws + WS_KV), MLA_KVN, nullptr, 0, 0, 1.f};
                  pg8::gemm_phase<pg8::EpiBf16<0>, pg8::StaticOrder, true, true>(ring, g, S, E); }
                SEAM(sb + 4); }
            if (EN(7) && IN(sb + 5)) { const bf16* KV = (const bf16*)(ws + WS_KV);
                att::AttnP P{QKV, MLA_QN, 192, KV, MLA_KVN, 256, KV + 128, MLA_KVN, 256, (const bf16*)(ws + WS_KPE), OB, nullptr};
                for (int u = blockIdx.x; u < 576; u += G) { if (u < 512) att::attn_unit<1>((LAS char*)ring, P, u >> 7, (u >> 3) & 15, u & 7, false); else att::attn_unit<1>((LAS char*)ring, P, (u - 512) >> 4, (u - 512) & 15, 0, true); }
                SEAM(sb + 5); }
        } else {
            if (EN(8) && IN(sb + 1)) { pg8::Gemm g{H, (const bf16*)(ws + WS_WT_CIN), MT, SGU_N, 2048}; pg8::StaticOrder S; S.init(MT, SGU_N, G, (int)blockIdx.x);
                pg8::EpiBf16<1> E{QKV, SGU_N, args.in[I_CBIN], 0, 0, 1.f};
                pg8::gemm_phase<pg8::EpiBf16<1>, pg8::StaticOrder, true, true>(ring, g, S, E); SEAM(sb + 1); }
            if (EN(9) && IN(sb + 2)) { MKFRAME(); phase_sgu_stats(F, args); SEAM(sb + 2); }
            if (EN(10) && IN(sb + 3)) { for (int u = blockIdx.x; u < 72 * 16; u += G)
                    att::sgu_mix_unit((LAS char*)ring, QKV, (const float*)(ws + WS_STATS), args.in[I_CLNG], args.in[I_CLNB], (const bf16*)(ws + WS_WSB), args.in[I_CBS], OB, u >> 4, u & 15);
                SEAM(sb + 3); }
        }
        if (EN(11) && IN(sb + 6)) { const bf16* wt = kind == 0 ? (const bf16*)(ws + WS_WT_AO) + (size_t)jm * 2048 * 2048 : (kind == 1 ? (const bf16*)(ws + WS_WT_BO) : (const bf16*)(ws + WS_WT_CO));
            pg8::Gemm g{OB, wt, mrows, DM, DM}; pg8::StaticOrder S; S.init(mrows, DM, G, (int)blockIdx.x);
            pg8::EpiRes E{X, DM, mods, 2 * DM};
            pg8::gemm_phase<pg8::EpiRes, pg8::StaticOrder, true, true>(ring, g, S, E); SEAM(sb + 6); }
        if (EN(1) && IN(sb + 7)) { MKFRAME(); phase_norm(F, args, layer, 1, mrows); SEAM(sb + 7); }
        if (EN(12) && IN(sb + 8)) { pg8::Gemm g{H, (const bf16*)(ws + WS_WT_F1) + (size_t)layer * DFF2 * 2048, mrows, DFF2, 2048}; pg8::StaticOrder S; S.init(mrows, DFF2, G, (int)blockIdx.x);
            pg8::EpiBf16<0> E{UB, DFF2, nullptr, 0, 0, 1.f};
            pg8::gemm_phase<pg8::EpiBf16<0>, pg8::StaticOrder, true, true>(ring, g, S, E); SEAM(sb + 8); }
        if (EN(13) && IN(sb + 9)) { MKFRAME(); phase_conv(F, args, layer, mrows); SEAM(sb + 9); }
        if (EN(14) && IN(sb + 10)) { pg8::Gemm g{ACT, (const bf16*)(ws + WS_WT_F2) + (size_t)layer * 2048 * DFF, mrows, DM, DFF}; pg8::StaticOrder S; S.init(mrows, DM, G, (int)blockIdx.x);
            pg8::EpiRes E{X, DM, mods, 5 * DM};
            pg8::gemm_phase<pg8::EpiRes, pg8::StaticOrder, true, true>(ring, g, S, E); SEAM(sb + 10); }
    }
    if (EN(15) && IN(STEP_FINAL)) { MKFRAME(); phase_final(F, args); }
#undef IN
#undef SEAM
}

#ifndef MK_ONE_LAUNCH
#define MK_ONE_LAUNCH 0
#endif
extern "C" void kernel_launch(void* const* d_in, const int* in_sizes, int n_in, void* d_out, int out_size, void* d_ws, size_t ws_size, hipStream_t stream) {
    static int grid = 0;
    if (grid == 0) {
        if (n_in != N_IN || out_size != ML * DM || ws_size < WS_END) { fprintf(stderr, "kernel_launch: unexpected shapes: n_in %d out %d ws %zu (need %zu)\n", n_in, out_size, ws_size, (size_t)WS_END); grid = -1; return; }
        int dev = 0, cus = 0, per_cu = 0;
        if (hipGetDevice(&dev) != hipSuccess || hipDeviceGetAttribute(&cus, hipDeviceAttributeMultiprocessorCount, dev) != hipSuccess) { grid = -1; return; }
        if (hipFuncSetAttribute((const void*)fwd_kernel, hipFuncAttributeMaxDynamicSharedMemorySize, LDS_BYTES) != hipSuccess) { fprintf(stderr, "kernel_launch: hipFuncSetAttribute failed\n"); grid = -1; return; }
        if (hipOccupancyMaxActiveBlocksPerMultiprocessor(&per_cu, (const void*)fwd_kernel, NTHREADS, LDS_BYTES) != hipSuccess || per_cu < 1) { fprintf(stderr, "kernel_launch: occupancy query says %d\n", per_cu); }
        (void)hipGetLastError();
        grid = cus;
    }
    if (grid < 0) return;
    if (hipMemsetAsync((char*)d_ws + WS_CTL, 0, CTL_ZERO_BYTES, stream) != hipSuccess) return;
    Args a{};
    for (int i = 0; i < N_IN; ++i) a.in[i] = (const float*)d_in[i];
    a.out = (float*)d_out; a.ws = (unsigned char*)d_ws;
#if MK_ONE_LAUNCH
    a.step_lo = 0; a.step_hi = N_STEPS;
    hipLaunchKernelGGL(fwd_kernel, dim3(grid), dim3(NTHREADS), LDS_BYTES, stream, a);
#else
    for (int s = 0; s < N_STEPS; ++s) {
        if (s >= 1 && s < STEP_FINAL) { const int layer = (s - 1) / STEPS_PER_LAYER, slot = (s - 1) % STEPS_PER_LAYER; if (!step_used(layer % 3, slot)) continue; }
        a.step_lo = s; a.step_hi = s + 1;
        hipLaunchKernelGGL(fwd_kernel, dim3(grid), dim3(NTHREADS), LDS_BYTES, stream, a);
    }
#endif
    const hipError_t le = hipPeekAtLastError();
    if (le != hipSuccess) fprintf(stderr, "kernel_launch: launch failed: %s\n", hipGetErrorName(le));
}
```

```cpp
#include <hip/hip_runtime.h>
#include <cstdio>
#include <cstdint>
namespace pg8 {
#define PG8_LAS __attribute__((address_space(3)))
typedef unsigned short bf16_t;
typedef short bf16x8 __attribute__((ext_vector_type(8)));
typedef float f32x4 __attribute__((ext_vector_type(4)));
typedef unsigned u32x4 __attribute__((ext_vector_type(4)));
constexpr int BM = 256, BK = 64, HALF = 128, HTB = HALF * BK * 2  , STAGE_BYTES = 8 * HTB, NXCD = 8, WGM = 8;

__host__ __device__ __forceinline__ int lds_byte(int r, int c) { const int st = (r >> 4) * 2 + (c >> 5), rr = r & 15, cc = c & 31, ob = rr * 64 + cc * 2; return st * 1024 + (ob ^ (((ob >> 9) & 1) << 5)); }
__host__ __device__ __forceinline__ void stage_rc(int b, int& R, int& C) { const int st = b / 1024, sb = b % 1024, swz = sb ^ (((sb >> 9) & 1) << 5); R = (st >> 1) * 16 + swz / 64; C = (st & 1) * 32 + (swz % 64) / 2; }
__host__ __device__ __forceinline__ int perm32(int rho) { const int n = rho >> 4, i = rho & 15; return 8 * (i >> 2) + 4 * n + (i & 3); }

struct Unit { int pm, pn, kt0, nt, slab; };
struct Gemm { const bf16_t* A; const bf16_t* Bt; int M, N, K; const bf16_t* A1; const bf16_t* Bt1; };

struct StaticOrder {
    int nM, nN, nwg, G, c;
    __host__ __device__ void init(int M, int N, int G_, int c_) { nM = M / BM; nN = N / BM; nwg = nM * nN; G = G_; c = c_; }
    __host__ __device__ __forceinline__ bool next(int i, Unit& u) const {
        const long L = (long)i * G + c; if (L >= nwg) return false;
        int wgid = (int)L; { const int q = nwg / NXCD, r = nwg % NXCD, xcd = wgid % NXCD, off = wgid / NXCD; wgid = (xcd < r ? xcd * (q + 1) : r * (q + 1) + (xcd - r) * q) + off; }
        const int nig = WGM * nN, gid = wgid / nig, fm = gid * WGM, gsz = (nM - fm) < WGM ? (nM - fm) : WGM;
        u.pm = fm + ((wgid % nig) % gsz); u.pn = (wgid % nig) / gsz; u.kt0 = 0; u.nt = 0; u.slab = -1; return true;
    }
    __host__ __device__ __forceinline__ bool by_index(long L, int& pm, int& pn) const {
        pm = 0; pn = 0; if (L >= nwg) return false;
        int wgid = (int)L; { const int q = nwg / NXCD, r = nwg % NXCD, xcd = wgid % NXCD, off = wgid / NXCD; wgid = (xcd < r ? xcd * (q + 1) : r * (q + 1) + (xcd - r) * q) + off; }
        const int nig = WGM * nN, gid = wgid / nig, fm = gid * WGM, gsz = (nM - fm) < WGM ? (nM - fm) : WGM;
        pm = fm + ((wgid % nig) % gsz); pn = (wgid % nig) / gsz; return true;
    }
    __device__ __forceinline__ bool get(int i, int& pm, int& pn, int& kt0, int& nt, int& slab) const { Unit u; u.pm = 0; u.pn = 0; const bool ok = next(i, u); pm = u.pm; pn = u.pn; kt0 = 0; nt = 0; slab = -1; return ok; }
    __device__ __forceinline__ void a_ready(const Unit&) const {}
    __device__ __forceinline__ void done(const Unit&) const {}
};

__device__ __forceinline__ unsigned cvt_pk_bf16(float lo, float hi) { unsigned r; asm volatile("v_cvt_pk_bf16_f32 %0, %1, %2" : "=v"(r) : "v"(lo), "v"(hi)); return r; }
typedef float f32x2 __attribute__((ext_vector_type(2)));
__device__ __forceinline__ f32x2 gelu_pk(f32x2 v) {
    const f32x2 av = __builtin_elementwise_abs(v), d = av * 0.2316418882f + 1.0f;
    f32x2 t; t.x = __builtin_amdgcn_rcpf(d.x); t.y = __builtin_amdgcn_rcpf(d.y);
    f32x2 q = t * 0.5307027145f + (-0.7265760135f); q = q * t + 0.7107068705f; q = q * t + (-0.142248368f); q = q * t + 0.127414796f; q = q * t;
    const f32x2 s = (v * v) * (-0.72134752044f);
    f32x2 e; e.x = __builtin_amdgcn_exp2f(s.x); e.y = __builtin_amdgcn_exp2f(s.y);
    const f32x2 m = v * (q * e), r = v - m;
    f32x2 o; o.x = v.x < 0.f ? m.x : r.x; o.y = v.y < 0.f ? m.y : r.y; return o;
}

template <int ACT  > struct EpiBf16 {
    static constexpr bool PERM = true, AFTER_DRAIN = false; static_assert(ACT == 0 || ACT == 1, "EpiBf16: ACT is 0 (none) or 1 (gelu_pk)");
    bf16_t* O; int ldc; const float* bias; int split_cols; size_t split_stride; float scale0;
    __device__ __forceinline__ void operator()(const f32x4 (&acc)[2][2][4][2], const Unit& u, int wr, int wc, int fr, int fq) const {
        const int row0 = u.pm * BM + wr * 64 + fr; int colt = u.pn * BM; bf16_t* base = O;
        float sc = 1.f; if (split_cols) { const int t = colt / split_cols; base += (size_t)t * split_stride; colt -= t * split_cols; if (t == 0) sc = scale0; }
        const int col0 = colt + wc * 32 + 8 * fq, bcol0 = u.pn * BM + wc * 32 + 8 * fq;
        f32x4 bv[2][2];
#pragma unroll
        for (int bj = 0; bj < 2; ++bj)
#pragma unroll
            for (int n = 0; n < 2; ++n) bv[bj][n] = bias ? *(const f32x4*)(bias + bcol0 + bj * HALF + 4 * n) : (f32x4){0.f, 0.f, 0.f, 0.f};
#pragma unroll
        for (int ai = 0; ai < 2; ++ai)
#pragma unroll
            for (int m = 0; m < 4; ++m) { bf16_t* rowp = base + (size_t)(row0 + ai * HALF + m * 16) * ldc + col0;
#pragma unroll
                for (int bj = 0; bj < 2; ++bj) { f32x4 v0 = acc[ai][bj][m][0] + bv[bj][0], v1 = acc[ai][bj][m][1] + bv[bj][1];
                    if (ACT == 1) { f32x2 a = gelu_pk((f32x2){v0[0], v0[1]}), b = gelu_pk((f32x2){v0[2], v0[3]}), c = gelu_pk((f32x2){v1[0], v1[1]}), d = gelu_pk((f32x2){v1[2], v1[3]});
                        v0 = (f32x4){a.x, a.y, b.x, b.y}; v1 = (f32x4){c.x, c.y, d.x, d.y}; }
                    v0 = v0 * sc; v1 = v1 * sc; u32x4 w; w.x = cvt_pk_bf16(v0[0], v0[1]); w.y = cvt_pk_bf16(v0[2], v0[3]); w.z = cvt_pk_bf16(v1[0], v1[1]); w.w = cvt_pk_bf16(v1[2], v1[3]);
                    *(u32x4*)(rowp + bj * HALF) = w; } }
    }
};

struct PanelStats {
    unsigned* xbuf;
    unsigned* cnt;
    unsigned* tmo;
    int ntn; float eps;
    unsigned code;
    __device__ __forceinline__ bool run(const f32x4 (&v)[2][2][4][2], const Unit& u, int wr, int wc, int fr, int fq, PG8_LAS unsigned char* lds, int wid, int lane) const {
        typedef float f32x2v __attribute__((ext_vector_type(2)));
        PG8_LAS f32x2v* P = (PG8_LAS f32x2v*)lds;
        PG8_LAS f32x2v* S = (PG8_LAS f32x2v*)(lds + 8192);
        PG8_LAS unsigned* flag = (PG8_LAS unsigned*)(lds + 8192 + 2048);
#pragma unroll
        for (int ai = 0; ai < 2; ++ai)
#pragma unroll
            for (int m = 0; m < 4; ++m) {
                float s = 0.f;
#pragma unroll
                for (int bj = 0; bj < 2; ++bj)
#pragma unroll
                    for (int n = 0; n < 2; ++n) { const f32x4 x = v[ai][bj][m][n]; s += (x[0] + x[1]) + (x[2] + x[3]); }
                s += __shfl_xor(s, 16); s += __shfl_xor(s, 32);
                const float mw = s * (1.0f / 64.0f); float q = 0.f;
#pragma unroll
                for (int bj = 0; bj < 2; ++bj)
#pragma unroll
                    for (int n = 0; n < 2; ++n) { const f32x4 d = v[ai][bj][m][n] - mw; q += (d[0] * d[0] + d[1] * d[1]) + (d[2] * d[2] + d[3] * d[3]); }
                q += __shfl_xor(q, 16); q += __shfl_xor(q, 32);
                if (fq == 0) P[(ai * HALF + wr * 64 + m * 16 + fr) * 4 + wc] = (f32x2v){mw, q};
            }
        asm volatile("s_waitcnt lgkmcnt(0)" ::: "memory"); __builtin_amdgcn_s_barrier(); asm volatile("" ::: "memory");
#if defined(BROKEN_EXCHANGE_NO_WAIT)
#warning BROKEN CONTROL BUILD: the row-statistics exchange does not wait; results are wrong by design
        if (blockIdx.x >= 64) { const long long t0_ = clock64(); while (clock64() - t0_ < 60000) __builtin_amdgcn_s_sleep(8); }
#endif
        const int row = wid * 32 + (lane & 31);
        if (lane < 32) {
            const f32x2v a = P[row * 4 + 0], b = P[row * 4 + 1], c = P[row * 4 + 2], d = P[row * 4 + 3];
            const float mt = (a.x + b.x + c.x + d.x) * 0.25f;
            const float da = a.x - mt, db = b.x - mt, dc = c.x - mt, dd = d.x - mt;
            const float m2 = (a.y + b.y) + (c.y + d.y) + 64.0f * ((da * da + db * db) + (dc * dc + dd * dd));
            unsigned long long* slot = (unsigned long long*)xbuf + ((size_t)(u.pm * BM + row) * 4 + u.pn);
            __hip_atomic_store(slot, ((unsigned long long)__float_as_uint(m2) << 32) | __float_as_uint(mt), __ATOMIC_RELAXED, __HIP_MEMORY_SCOPE_AGENT);
        }
        asm volatile("s_waitcnt vmcnt(0)" ::: "memory");
        if (lane == 0) __hip_atomic_fetch_add(cnt + 64 * u.pm, 1u, __ATOMIC_RELAXED, __HIP_MEMORY_SCOPE_AGENT);
        if (wid == 0) {
            bool dead = false; const unsigned long long t0 = __builtin_amdgcn_s_memrealtime(); const unsigned want = 8u * (unsigned)ntn;
            for (;;) {
#if defined(BROKEN_EXCHANGE_NO_WAIT)
                break;
#endif
                if ((unsigned)__builtin_amdgcn_readfirstlane(__hip_atomic_load(cnt + 64 * u.pm, __ATOMIC_RELAXED, __HIP_MEMORY_SCOPE_AGENT)) >= want) break;
                if (__builtin_amdgcn_s_memrealtime() - t0 > 2000000ull) {
                    if (lane == 0) { unsigned expect = 0u; __hip_atomic_compare_exchange_strong(tmo + 1, &expect, code | (unsigned)(u.pm & 0xff), __ATOMIC_RELAXED, __ATOMIC_RELAXED, __HIP_MEMORY_SCOPE_AGENT);
                                     __hip_atomic_store(tmo, 1u, __ATOMIC_RELAXED, __HIP_MEMORY_SCOPE_AGENT); }
                    dead = true; break; }
                __builtin_amdgcn_s_sleep(2);
            }
            __builtin_amdgcn_fence(__ATOMIC_ACQUIRE, "agent");
            if (lane == 0) flag[0] = dead ? 1u : 0u;
        }
        asm volatile("s_waitcnt vmcnt(0) lgkmcnt(0)" ::: "memory"); __builtin_amdgcn_s_barrier(); asm volatile("" ::: "memory");
        const bool bad = flag[0] != 0u;
        if (lane < 32) {
            const unsigned long long* slot = (const unsigned long long*)xbuf + (size_t)(u.pm * BM + row) * 4; float mt[4], m2[4]; float ms = 0.f;
#pragma unroll
            for (int t = 0; t < 4; ++t) { if (t < ntn) { const unsigned long long w = __hip_atomic_load(slot + t, __ATOMIC_RELAXED, __HIP_MEMORY_SCOPE_AGENT); mt[t] = __uint_as_float((unsigned)w); m2[t] = __uint_as_float((unsigned)(w >> 32)); } else { mt[t] = 0.f; m2[t] = 0.f; } ms += mt[t]; }
            const float mean = ms / (float)ntn; float q = 0.f;
#pragma unroll
            for (int t = 0; t < 4; ++t) if (t < ntn) { const float dm = mt[t] - mean; q += m2[t] + 256.0f * dm * dm; }
            S[row] = (f32x2v){mean, 1.0f / sqrtf(q / (256.0f * (float)ntn) + eps)};
        }
        asm volatile("s_waitcnt lgkmcnt(0)" ::: "memory"); __builtin_amdgcn_s_barrier(); asm volatile("" ::: "memory");
        return bad;
    }
};
struct EpiLnRes {
    static constexpr bool PERM = false, AFTER_DRAIN = true;
    const float* base; float* out; int ldc; const float* bias; PanelStats st; unsigned poison;
    __device__ __forceinline__ void fused(f32x4 (&acc)[2][2][4][2], const Unit& u, int wr, int wc, int fr, int fq, PG8_LAS unsigned char* lds, int wid, int lane) const {
        typedef float f32x2v __attribute__((ext_vector_type(2)));
        const PG8_LAS f32x2v* S = (const PG8_LAS f32x2v*)(lds + 8192);
        const int col0 = u.pn * BM + wc * 32 + 4 * fq;
#pragma unroll
        for (int bj = 0; bj < 2; ++bj)
#pragma unroll
            for (int n = 0; n < 2; ++n) { const f32x4 bv = bias ? *(const f32x4*)(bias + col0 + bj * HALF + n * 16) : (f32x4){0.f, 0.f, 0.f, 0.f};
#pragma unroll
                for (int ai = 0; ai < 2; ++ai)
#pragma unroll
                    for (int m = 0; m < 4; ++m) acc[ai][bj][m][n] += bv; }
        f32x4 pre[4][2][2];
#pragma unroll
        for (int m = 0; m < 4; ++m) { const size_t off = (size_t)(u.pm * BM + wr * 64 + m * 16 + fr) * ldc + col0;
#pragma unroll
            for (int bj = 0; bj < 2; ++bj)
#pragma unroll
                for (int n = 0; n < 2; ++n) pre[m][bj][n] = *(const f32x4*)(base + off + bj * HALF + n * 16); }
        const bool bad = st.run(acc, u, wr, wc, fr, fq, lds, wid, lane) || poison != 0u;
        const float qnan = __builtin_nanf("");
#pragma unroll
        for (int ai = 0; ai < 2; ++ai)
#pragma unroll
            for (int m = 0; m < 4; ++m) { const int r = ai * HALF + wr * 64 + m * 16 + fr; const f32x2v sr = S[r]; const size_t off = (size_t)(u.pm * BM + r) * ldc + col0;
#pragma unroll
                for (int bj = 0; bj < 2; ++bj)
#pragma unroll
                    for (int n = 0; n < 2; ++n) { const f32x4 bs = ai == 0 ? pre[m][bj][n] : *(const f32x4*)(base + off + bj * HALF + n * 16); f32x4 o = bs + (acc[ai][bj][m][n] - sr.x) * sr.y;
                        if (bad) o = (f32x4){qnan, qnan, qnan, qnan}; *(f32x4*)(out + off + bj * HALF + n * 16) = o; }
                if (m & 1) asm volatile("" ::: "memory"); }
    }
};
struct EpiLnResLn {
    static constexpr bool PERM = false, AFTER_DRAIN = true;
    const float* base; float* out; bf16_t* xn; int ldc; const float* bias; PanelStats st1, st2; unsigned poison;
    __device__ __forceinline__ void fused(f32x4 (&acc)[2][2][4][2], const Unit& u, int wr, int wc, int fr, int fq, PG8_LAS unsigned char* lds, int wid, int lane) const {
        typedef float f32x2v __attribute__((ext_vector_type(2))); typedef unsigned u32x2v __attribute__((ext_vector_type(2)));
        const PG8_LAS f32x2v* S = (const PG8_LAS f32x2v*)(lds + 8192);
        const int col0 = u.pn * BM + wc * 32 + 4 * fq;
#pragma unroll
        for (int bj = 0; bj < 2; ++bj)
#pragma unroll
            for (int n = 0; n < 2; ++n) { const f32x4 bv = bias ? *(const f32x4*)(bias + col0 + bj * HALF + n * 16) : (f32x4){0.f, 0.f, 0.f, 0.f};
#pragma unroll
                for (int ai = 0; ai < 2; ++ai)
#pragma unroll
                    for (int m = 0; m < 4; ++m) acc[ai][bj][m][n] += bv; }
        bool bad = st1.run(acc, u, wr, wc, fr, fq, lds, wid, lane) || poison != 0u;
        const float qnan = __builtin_nanf("");
#pragma unroll
        for (int ai = 0; ai < 2; ++ai)
#pragma unroll
            for (int m = 0; m < 4; ++m) { const int r = ai * HALF + wr * 64 + m * 16 + fr; const f32x2v sr = S[r]; const size_t off = (size_t)(u.pm * BM + r) * ldc + col0;
#pragma unroll
                for (int bj = 0; bj < 2; ++bj)
#pragma unroll
                    for (int n = 0; n < 2; ++n) { const f32x4 bs = *(const f32x4*)(base + off + bj * HALF + n * 16); acc[ai][bj][m][n] = bs + (acc[ai][bj][m][n] - sr.x) * sr.y; }
                asm volatile("" : "+v"(acc[ai][0][m][0]), "+v"(acc[ai][0][m][1]), "+v"(acc[ai][1][m][0]), "+v"(acc[ai][1][m][1]));
                if (m & 1) asm volatile("" ::: "memory"); }
        const bool bad1 = bad;
        bad = st2.run(acc, u, wr, wc, fr, fq, lds, wid, lane) || bad;
#pragma unroll
        for (int ai = 0; ai < 2; ++ai)
#pragma unroll
            for (int m = 0; m < 4; ++m) { const int r = ai * HALF + wr * 64 + m * 16 + fr; const f32x2v sr = S[r]; const size_t off = (size_t)(u.pm * BM + r) * ldc + col0;
#pragma unroll
                for (int bj = 0; bj < 2; ++bj)
#pragma unroll
                    for (int n = 0; n < 2; ++n) { const f32x4 x1 = acc[ai][bj][m][n]; *(f32x4*)(out + off + bj * HALF + n * 16) = bad1 ? (f32x4){qnan, qnan, qnan, qnan} : x1;
                        const f32x4 o = (x1 - sr.x) * sr.y; u32x2v w; w.x = cvt_pk_bf16(o[0], o[1]); w.y = cvt_pk_bf16(o[2], o[3]);
                        if (bad) { w.x = 0x7fc07fc0u; w.y = 0x7fc07fc0u; } *(u32x2v*)(xn + off + bj * HALF + n * 16) = w; }
                asm volatile("" ::: "memory"); }
    }
};

template <class E, class = void> struct PermA { static constexpr bool v = false; };
template <class E> struct PermA<E, decltype((void)E::PERMA)> { static constexpr bool v = E::PERMA; };
template <class Epi, class Sched, bool ALIGN_EPI = false, bool SP2 = false>
__device__ __forceinline__ void gemm_phase(PG8_LAS unsigned char* lds, const Gemm g, const Sched& S, const Epi& E) {
    int tid_ = threadIdx.x; asm volatile("" : "+v"(tid_));
    const int tid = tid_, wid = __builtin_amdgcn_readfirstlane(tid >> 6), lane = tid & 63, wr = wid >> 2, wc = wid & 3, fr = lane & 15, fq = lane >> 4;
    const int K = g.K, nt_full = K / BK;
    unsigned voffA[2], voffB[2];
#pragma unroll
    for (int i = 0; i < 2; ++i) { int R, C; stage_rc(tid * 16 + i * 8192, R, C); const int Rb = Epi::PERM ? ((R & ~31) + perm32(R & 31)) : R;
        const int Ra = PermA<Epi>::v ? ((R & ~63) + 4 * (R & 15) + ((R >> 4) & 3)) : R;
        voffA[i] = (unsigned)(Ra * K + C) * 2u; voffB[i] = (unsigned)(Rb * K + C) * 2u; }
    const size_t kstep = (size_t)(BK * 2);
    const size_t hstep = (size_t)HALF * K * 2;
    const size_t tstep = 2 * hstep;
    const unsigned ldsw = (unsigned)wid * 1024u;
    const int aoff = lds_byte(wr * 64 + fr, fq * 8), boff = lds_byte(wc * 32 + fr, fq * 8);
#define PG8_SA(b, h) (((b) * 2 + (h)) * HTB)
#define PG8_SB(b, h) ((4 + (b) * 2 + (h)) * HTB)
#define PG8_STAGE(bufoff, gbase, voff) do { _Pragma("unroll") for (int _i = 0; _i < 2; ++_i) \
        __builtin_amdgcn_global_load_lds((const unsigned*)((const char*)(gbase) + (voff)[_i]), (PG8_LAS unsigned*)(lds + (bufoff) + ldsw + _i * 8192), 16, 0, 0); } while (0)
#define PG8_LDA(dst, b, h) do { _Pragma("unroll") for (int m = 0; m < 4; ++m) _Pragma("unroll") for (int k = 0; k < 2; ++k) dst[m][k] = *(const PG8_LAS bf16x8*)(lds + PG8_SA(b, h) + aoff + m * 2048 + k * 1024); } while (0)
#define PG8_LDB(dst, b, h) do { _Pragma("unroll") for (int n = 0; n < 2; ++n) _Pragma("unroll") for (int k = 0; k < 2; ++k) dst[n][k] = *(const PG8_LAS bf16x8*)(lds + PG8_SB(b, h) + boff + n * 2048 + k * 1024); } while (0)
#define PG8_MMA(ai, bj, At, Bt) do { __builtin_amdgcn_s_setprio(1); _Pragma("unroll") for (int m = 0; m < 4; ++m) _Pragma("unroll") for (int n = 0; n < 2; ++n) _Pragma("unroll") for (int k = 0; k < 2; ++k) \
        acc[ai][bj][m][n] = __builtin_amdgcn_mfma_f32_16x16x32_bf16(Bt[n][k], At[m][k], acc[ai][bj][m][n], 0, 0, 0); __builtin_amdgcn_s_setprio(0); } while (0)
#define PG8_WAIT_V(n) asm volatile("s_waitcnt vmcnt(" #n ")" ::: "memory")
#define PG8_WAIT_L(n) asm volatile("s_waitcnt lgkmcnt(" #n ")" ::: "memory")
#define PG8_BAR __builtin_amdgcn_s_barrier()
#define PG8_SCHED __builtin_amdgcn_sched_barrier(0)
    Unit cur, nxt; int ui = 0;
    { int pm_, pn_, kt0_, nt_, slab_; if (!S.get(0, pm_, pn_, kt0_, nt_, slab_)) return; cur.pm = pm_; cur.pn = pn_; cur.kt0 = kt0_; cur.nt = nt_; cur.slab = slab_; }
    f32x4 acc[2][2][4][2];
#pragma unroll
    for (int a = 0; a < 2; ++a)
#pragma unroll
        for (int b = 0; b < 2; ++b)
#pragma unroll
            for (int m = 0; m < 4; ++m)
#pragma unroll
                for (int n = 0; n < 2; ++n) acc[a][b][m][n] = (f32x4){0.f, 0.f, 0.f, 0.f};
    bf16x8 At[4][2], B0[2][2], B1[2][2];
    const char* cA = (const char*)((g.A1 && cur.slab == 1) ? g.A1 : g.A) + (size_t)cur.pm * tstep + (size_t)cur.kt0 * kstep; const char* cB = (const char*)((g.A1 && cur.slab == 1) ? g.Bt1 : g.Bt) + (size_t)cur.pn * tstep + (size_t)cur.kt0 * kstep;
    S.a_ready(cur);
    if constexpr (SP2) {
        PG8_STAGE(PG8_SB(0, 0), cB, voffB); PG8_STAGE(PG8_SB(0, 1), cB + hstep, voffB); PG8_STAGE(PG8_SA(0, 0), cA, voffA); PG8_STAGE(PG8_SA(0, 1), cA + hstep, voffA);
        if (wr == 1) PG8_BAR;
        PG8_WAIT_V(2); PG8_BAR;
        PG8_STAGE(PG8_SB(1, 0), cB + kstep, voffB); PG8_STAGE(PG8_SA(1, 0), cA + kstep, voffA); PG8_STAGE(PG8_SB(1, 1), cB + hstep + kstep, voffB);
        PG8_WAIT_V(6); PG8_BAR;
    } else {
        PG8_STAGE(PG8_SB(0, 0), cB, voffB); PG8_STAGE(PG8_SA(0, 0), cA, voffA); PG8_STAGE(PG8_SB(0, 1), cB + hstep, voffB); PG8_STAGE(PG8_SA(0, 1), cA + hstep, voffA);
        if (wr == 1) PG8_BAR;
        PG8_WAIT_V(4); PG8_BAR;
        PG8_STAGE(PG8_SB(1, 0), cB + kstep, voffB); PG8_STAGE(PG8_SA(1, 0), cA + kstep, voffA); PG8_STAGE(PG8_SB(1, 1), cB + hstep + kstep, voffB);
        PG8_WAIT_V(6); PG8_BAR;
    }
    for (;;) {
        bool has_next; { int pm_, pn_, kt0_, nt_, slab_; has_next = S.get(ui + 1, pm_, pn_, kt0_, nt_, slab_); nxt.pm = pm_; nxt.pn = pn_; nxt.kt0 = kt0_; nxt.nt = nt_; nxt.slab = slab_; }
        const char* nA = has_next ? (const char*)((g.A1 && nxt.slab == 1) ? g.A1 : g.A) + (size_t)nxt.pm * tstep + (size_t)nxt.kt0 * kstep : cA; const char* nB = has_next ? (const char*)((g.A1 && nxt.slab == 1) ? g.Bt1 : g.Bt) + (size_t)nxt.pn * tstep + (size_t)nxt.kt0 * kstep : cB;
        const int nt = cur.nt ? cur.nt : nt_full;
        for (int t = 0; t < nt; t += 2) {
            const bool last = (t == nt - 2);
            const char* a1 = cA + (size_t)(t + 1) * kstep;
            const char* a2 = last ? nA : cA + (size_t)(t + 2) * kstep; const char* b2 = last ? nB : cB + (size_t)(t + 2) * kstep;
            const char* a3 = a2 + kstep; const char* b3 = b2 + kstep;
            if (last && has_next) S.a_ready(nxt);
            if constexpr (SP2) {
            PG8_LDB(B0, 0, 0); PG8_LDB(B1, 0, 1); PG8_SCHED; PG8_LDA(At, 0, 0); PG8_STAGE(PG8_SA(1, 1), a1 + hstep, voffA);
            PG8_WAIT_V(8); PG8_WAIT_L(0); PG8_BAR; PG8_MMA(0, 0, At, B0); PG8_MMA(0, 1, At, B1); PG8_BAR; PG8_SCHED;
            PG8_LDA(At, 0, 1); PG8_STAGE(PG8_SB(0, 0), b2, voffB); PG8_STAGE(PG8_SB(0, 1), b2 + hstep, voffB); PG8_STAGE(PG8_SA(0, 0), a2, voffA);
            PG8_WAIT_V(8); PG8_WAIT_L(0); PG8_BAR; PG8_MMA(1, 0, At, B0); PG8_MMA(1, 1, At, B1); PG8_BAR; PG8_SCHED;
            PG8_LDB(B0, 1, 0); PG8_LDB(B1, 1, 1); PG8_SCHED; PG8_LDA(At, 1, 0); PG8_STAGE(PG8_SA(0, 1), a2 + hstep, voffA);
            PG8_WAIT_V(8); PG8_WAIT_L(0); PG8_BAR; PG8_MMA(0, 0, At, B0); PG8_MMA(0, 1, At, B1); PG8_BAR; PG8_SCHED;
            PG8_LDA(At, 1, 1); PG8_STAGE(PG8_SB(1, 0), b3, voffB); PG8_STAGE(PG8_SB(1, 1), b3 + hstep, voffB); PG8_STAGE(PG8_SA(1, 0), a3, voffA);
            PG8_WAIT_V(8); PG8_WAIT_L(0); PG8_BAR; PG8_MMA(1, 0, At, B0); PG8_MMA(1, 1, At, B1); PG8_BAR; PG8_SCHED;
            } else {
            PG8_LDB(B0, 0, 0); PG8_SCHED; PG8_LDA(At, 0, 0); PG8_STAGE(PG8_SA(1, 1), a1 + hstep, voffA);
            PG8_WAIT_L(8); PG8_BAR; PG8_WAIT_L(0); PG8_MMA(0, 0, At, B0); PG8_BAR; PG8_SCHED;
            PG8_LDB(B1, 0, 1); PG8_STAGE(PG8_SB(0, 0), b2, voffB);
            PG8_BAR; PG8_WAIT_L(0); PG8_MMA(0, 1, At, B1); PG8_BAR;
            PG8_LDA(At, 0, 1); PG8_STAGE(PG8_SA(0, 0), a2, voffA);
            PG8_BAR; PG8_WAIT_L(0); PG8_MMA(1, 0, At, B0); PG8_BAR; PG8_SCHED;
            PG8_STAGE(PG8_SB(0, 1), b2 + hstep, voffB);
            PG8_WAIT_V(6); PG8_BAR; PG8_MMA(1, 1, At, B1); PG8_BAR;
            PG8_LDB(B0, 1, 0); PG8_SCHED; PG8_LDA(At, 1, 0); PG8_STAGE(PG8_SA(0, 1), a2 + hstep, voffA);
            PG8_WAIT_L(8); PG8_BAR; PG8_WAIT_L(0); PG8_MMA(0, 0, At, B0); PG8_BAR; PG8_SCHED;
            PG8_LDB(B1, 1, 1); PG8_STAGE(PG8_SB(1, 0), b3, voffB);
            PG8_BAR; PG8_WAIT_L(0); PG8_MMA(0, 1, At, B1); PG8_BAR;
            PG8_LDA(At, 1, 1); PG8_STAGE(PG8_SA(1, 0), a3, voffA);
            PG8_BAR; PG8_WAIT_L(0); PG8_MMA(1, 0, At, B0); PG8_BAR; PG8_SCHED;
            PG8_STAGE(PG8_SB(1, 1), b3 + hstep, voffB);
            PG8_WAIT_V(6); PG8_BAR; PG8_MMA(1, 1, At, B1); PG8_BAR;
            }
        }
        if constexpr (ALIGN_EPI) { if (wr == 0) PG8_BAR; }
        if constexpr (!Epi::AFTER_DRAIN) { E(acc, cur, wr, wc, fr, fq); S.done(cur); }
        if (!has_next) break;
#pragma unroll
        for (int a = 0; a < 2; ++a)
#pragma unroll
            for (int b = 0; b < 2; ++b)
#pragma unroll
                for (int m = 0; m < 4; ++m)
#pragma unroll
                    for (int n = 0; n < 2; ++n) acc[a][b][m][n] = (f32x4){0.f, 0.f, 0.f, 0.f};
        cur = nxt; cA = nA; cB = nB; ++ui;
        if constexpr (ALIGN_EPI) { if (wr == 1) PG8_BAR; }
    }
    PG8_WAIT_V(0);
    if constexpr (!ALIGN_EPI) { if (wr == 0) PG8_BAR; }
    PG8_BAR;
    if constexpr (Epi::AFTER_DRAIN) { E.fused(acc, cur, wr, wc, fr, fq, lds, wid, lane); S.done(cur); }
#undef PG8_SA
#undef PG8_SB
#undef PG8_STAGE
#undef PG8_LDA
#undef PG8_LDB
#undef PG8_MMA
#undef PG8_WAIT_V
#undef PG8_WAIT_L
#undef PG8_BAR
#undef PG8_SCHED
}
}
namespace pg8 {
struct EpiRes {
    static constexpr bool PERM = false, AFTER_DRAIN = false;
    float* X; int ldc; const float* mods; int gate_off;
    float* slab;
    __device__ __forceinline__ void operator()(const f32x4 (&acc)[2][2][4][2], const Unit& u, int wr, int wc, int fr, int fq) const {
        const int prow = u.pm * BM; const int col0 = u.pn * BM + wc * 32 + 4 * fq;
        if (u.slab >= 0) {
            float* base = slab + ((size_t)u.slab * 1024 + (prow - 8192)) * ldc + col0;
#pragma unroll
            for (int ai = 0; ai < 2; ++ai)
#pragma unroll
                for (int m = 0; m < 4; ++m) { float* rowp = base + (size_t)(ai * HALF + wr * 64 + m * 16 + fr) * ldc;
#pragma unroll
                    for (int bj = 0; bj < 2; ++bj)
#pragma unroll
                        for (int n = 0; n < 2; ++n) *(f32x4*)(rowp + bj * HALF + n * 16) = acc[ai][bj][m][n]; }
            return;
        }
        const int bidx = prow < 8192 ? (prow >> 11) : 4;
        const float* gate = mods + bidx * 12288 + gate_off;
        f32x4 gv[2][2];
#pragma unroll
        for (int bj = 0; bj < 2; ++bj)
#pragma unroll
            for (int n = 0; n < 2; ++n) gv[bj][n] = *(const f32x4*)(gate + col0 + bj * HALF + n * 16);
#pragma unroll
        for (int ai = 0; ai < 2; ++ai)
#pragma unroll
            for (int m = 0; m < 4; ++m) { float* rowp = X + (size_t)(prow + ai * HALF + wr * 64 + m * 16 + fr) * ldc + col0;
#pragma unroll
                for (int bj = 0; bj < 2; ++bj)
#pragma unroll
                    for (int n = 0; n < 2; ++n) { f32x4* p = (f32x4*)(rowp + bj * HALF + n * 16); f32x4 v = *p; v = v + gv[bj][n] * acc[ai][bj][m][n]; *p = v; } }
    }
};
struct ResOrder {
    StaticOrder lat; int G, c, nlat, nchunk, nN, q8, r8;
    __device__ __forceinline__ void init(int Mrows, int N, int K, int G_, int c_) { lat.init(8192, N, G_, c_); G = G_; c = c_; nN = N / BM; nlat = 32 * nN; nchunk = Mrows > 8192 ? 4 * nN * 8 : 0;
        const int pairs = K / (2 * BK); q8 = pairs / 8; r8 = pairs % 8; }
    __device__ __forceinline__ bool get(int i, int& pm, int& pn, int& kt0, int& nt, int& slab) const {
        const int L = i * G + c; pm = 0; pn = 0; kt0 = 0; nt = 0; slab = -1;
        if (L < nlat) { Unit t; t.pm = 0; t.pn = 0; const bool ok = lat.next(L / G, t); pm = t.pm; pn = t.pn; return ok; }
        const int e = L - nlat; if (e >= nchunk) return false;
        const int q = e >> 3, sidx = e & 7;
        pm = 32 + q / nN; pn = q % nN; slab = sidx; nt = 2 * (q8 + (sidx < r8 ? 1 : 0)); kt0 = 2 * (sidx * q8 + (sidx < r8 ? sidx : r8)); return true;
    }
    __device__ __forceinline__ void a_ready(const Unit&) const {}
    __device__ __forceinline__ void done(const Unit&) const {}
};
struct EpiF32 {
    static constexpr bool PERM = false, AFTER_DRAIN = false;
    float* O; int ldc;
    __device__ __forceinline__ void operator()(const f32x4 (&acc)[2][2][4][2], const Unit& u, int wr, int wc, int fr, int fq) const {
        const int col0 = u.pn * BM + wc * 32 + 4 * fq;
#pragma unroll
        for (int ai = 0; ai < 2; ++ai)
#pragma unroll
            for (int m = 0; m < 4; ++m) { float* rowp = O + (size_t)(u.pm * BM + ai * HALF + wr * 64 + m * 16 + fr) * ldc + col0;
#pragma unroll
                for (int bj = 0; bj < 2; ++bj)
#pragma unroll
                    for (int n = 0; n < 2; ++n) *(f32x4*)(rowp + bj * HALF + n * 16) = acc[ai][bj][m][n]; }
    }
};
typedef _Float16 h16x2 __attribute__((ext_vector_type(2)));
__device__ __forceinline__ unsigned pack_h2(float a, float b) { const h16x2 v = {(_Float16)a, (_Float16)b}; return __builtin_bit_cast(unsigned, v); }
__device__ __forceinline__ float h2_lo(unsigned u) { return (float)__builtin_bit_cast(h16x2, u)[0]; }
__device__ __forceinline__ float h2_hi(unsigned u) { return (float)__builtin_bit_cast(h16x2, u)[1]; }
constexpr int QG_ROWSS = 1, QG_MODS = 18, QG_BIAS2 = 17, QG_SGST = 6, QG_MLSS = 4;
template <int SH> __device__ __forceinline__ float qgrid(float v) { return rintf(v * (float)(1 << SH)) * (1.0f / (float)(1 << SH)); }
__device__ __forceinline__ float epi_shfl_xor(float v, int mask, int lane) { return __builtin_bit_cast(float, __builtin_amdgcn_ds_bpermute((lane ^ mask) << 2, __builtin_bit_cast(int, v))); }
template <int ACT> struct EpiNormBf16 {
    static constexpr bool PERM = true, AFTER_DRAIN = false;
    bf16_t* O; int ldc; const float* bias; const float* rowss; const float* bias2; int ldb;
    __device__ __forceinline__ void operator()(const f32x4 (&acc)[2][2][4][2], const Unit& u, int wr, int wc, int fr, int fq) const {
        const int prow = u.pm * BM, row0 = prow + wr * 64 + fr, col0 = u.pn * BM + wc * 32 + 8 * fq, bidx = prow < 8192 ? (prow >> 11) : 4;
        f32x4 bv[2][2];
#pragma unroll
        for (int bj = 0; bj < 2; ++bj)
#pragma unroll
            for (int n = 0; n < 2; ++n) { bv[bj][n] = *(const f32x4*)(bias2 + (size_t)bidx * ldb + col0 + bj * HALF + 4 * n); if (bias) bv[bj][n] = bv[bj][n] + *(const f32x4*)(bias + col0 + bj * HALF + 4 * n); }
#pragma unroll
        for (int ai = 0; ai < 2; ++ai)
#pragma unroll
            for (int m = 0; m < 4; ++m) { const int row = row0 + ai * HALF + m * 16; bf16_t* rowp = O + (size_t)row * ldc + col0;
                const float rs = 1.0f / sqrtf(rowss[row] * (1.0f / 2048.0f) + 1e-6f);
#pragma unroll
                for (int bj = 0; bj < 2; ++bj) { f32x4 v0 = acc[ai][bj][m][0] * rs + bv[bj][0], v1 = acc[ai][bj][m][1] * rs + bv[bj][1];
                    if (ACT == 1) { f32x2 a = gelu_pk((f32x2){v0[0], v0[1]}), b = gelu_pk((f32x2){v0[2], v0[3]}), c = gelu_pk((f32x2){v1[0], v1[1]}), d = gelu_pk((f32x2){v1[2], v1[3]});
                        v0 = (f32x4){a.x, a.y, b.x, b.y}; v1 = (f32x4){c.x, c.y, d.x, d.y}; }
                    u32x4 w; w.x = cvt_pk_bf16(v0[0], v0[1]); w.y = cvt_pk_bf16(v0[2], v0[3]); w.z = cvt_pk_bf16(v1[0], v1[1]); w.w = cvt_pk_bf16(v1[2], v1[3]);
                    *(u32x4*)(rowp + bj * HALF) = w; } }
    }
};
struct EpiNormF32 {
    static constexpr bool PERM = false, AFTER_DRAIN = false;
    float* O; int ldc; const float* rowss; const float* bias2; int ldb;
    __device__ __forceinline__ void operator()(const f32x4 (&acc)[2][2][4][2], const Unit& u, int wr, int wc, int fr, int fq) const {
        const int prow = u.pm * BM, col0 = u.pn * BM + wc * 32 + 4 * fq, bidx = prow < 8192 ? (prow >> 11) : 4;
        f32x4 bv[2][2];
#pragma unroll
        for (int bj = 0; bj < 2; ++bj)
#pragma unroll
            for (int n = 0; n < 2; ++n) bv[bj][n] = *(const f32x4*)(bias2 + (size_t)bidx * ldb + col0 + bj * HALF + n * 16);
#pragma unroll
        for (int ai = 0; ai < 2; ++ai)
#pragma unroll
            for (int m = 0; m < 4; ++m) { const int row = prow + ai * HALF + wr * 64 + m * 16 + fr; float* rowp = O + (size_t)row * ldc + col0;
                const float rs = 1.0f / sqrtf(rowss[row] * (1.0f / 2048.0f) + 1e-6f);
#pragma unroll
                for (int bj = 0; bj < 2; ++bj)
#pragma unroll
                    for (int n = 0; n < 2; ++n) *(f32x4*)(rowp + bj * HALF + n * 16) = acc[ai][bj][m][n] * rs + bv[bj][n]; }
    }
};
struct EpiResN {
    static constexpr bool PERM = false, AFTER_DRAIN = false;
    bf16_t* X; int ldc; const float* mods; int gate_off; bf16_t* slab;
    bf16_t* A2; const float* gnext; const float* scale_next; float* rowss_next;
    static __device__ __forceinline__ u32x4 regroup(const f32x4 h0, const f32x4 h1) {
        unsigned px = cvt_pk_bf16(h0[0], h0[1]), py = cvt_pk_bf16(h0[2], h0[3]), qx = cvt_pk_bf16(h1[0], h1[1]), qy = cvt_pk_bf16(h1[2], h1[3]);
        { auto r = __builtin_amdgcn_permlane32_swap(px, qx, false, false); px = r[0]; qx = r[1]; } { auto r = __builtin_amdgcn_permlane16_swap(px, qx, false, false); px = r[0]; qx = r[1]; }
        { auto r = __builtin_amdgcn_permlane32_swap(py, qy, false, false); py = r[0]; qy = r[1]; } { auto r = __builtin_amdgcn_permlane16_swap(py, qy, false, false); py = r[0]; qy = r[1]; }
        u32x4 w; w.x = px; w.y = py; w.z = qx; w.w = qy; return w; }
    static __device__ __forceinline__ u32x4 regroup_h(const f32x4 h0, const f32x4 h1) {
        unsigned px = pack_h2(h0[0], h0[1]), py = pack_h2(h0[2], h0[3]), qx = pack_h2(h1[0], h1[1]), qy = pack_h2(h1[2], h1[3]);
        { auto r = __builtin_amdgcn_permlane32_swap(px, qx, false, false); px = r[0]; qx = r[1]; } { auto r = __builtin_amdgcn_permlane16_swap(px, qx, false, false); px = r[0]; qx = r[1]; }
        { auto r = __builtin_amdgcn_permlane32_swap(py, qy, false, false); py = r[0]; qy = r[1]; } { auto r = __builtin_amdgcn_permlane16_swap(py, qy, false, false); py = r[0]; qy = r[1]; }
        u32x4 w; w.x = px; w.y = py; w.z = qx; w.w = qy; return w; }
    static __device__ __forceinline__ void ungroup(const u32x4 w, f32x4& h0, f32x4& h1) {
        unsigned px = w.x, py = w.y, qx = w.z, qy = w.w;
        { auto r = __builtin_amdgcn_permlane16_swap(px, qx, false, false); px = r[0]; qx = r[1]; } { auto r = __builtin_amdgcn_permlane32_swap(px, qx, false, false); px = r[0]; qx = r[1]; }
        { auto r = __builtin_amdgcn_permlane16_swap(py, qy, false, false); py = r[0]; qy = r[1]; } { auto r = __builtin_amdgcn_permlane32_swap(py, qy, false, false); py = r[0]; qy = r[1]; }
        h0 = (f32x4){h2_lo(px), h2_hi(px), h2_lo(py), h2_hi(py)};
        h1 = (f32x4){h2_lo(qx), h2_hi(qx), h2_lo(qy), h2_hi(qy)}; }
    __device__ __forceinline__ void operator()(const f32x4 (&acc_)[2][2][4][2], const Unit& u, int wr, int wc, int fr, int fq) const {
        f32x4 (&U)[2][2][4][2] = const_cast<f32x4 (&)[2][2][4][2]>(acc_);
        constexpr unsigned LDC = 2048;
        int pm_ = u.pm, pn_ = u.pn; asm volatile("" : "+s"(pm_), "+s"(pn_));
        const int prow = pm_ * BM; const int col0 = pn_ * BM + wc * 32 + 4 * fq, colb = pn_ * BM + wc * 32 + 8 * fq;
        const unsigned rl = (unsigned)(wr * 64 + fr);
        const unsigned ob = (rl * LDC + (unsigned)colb) * 2u;
        if (u.slab < 0) {
        const int bidx = prow < 8192 ? (prow >> 11) : 4;
        const float* gate = mods + bidx * 12288 + gate_off;
        f32x4 gv[2][2];
#pragma unroll
        for (int bj = 0; bj < 2; ++bj)
#pragma unroll
            for (int n = 0; n < 2; ++n) gv[bj][n] = *(const f32x4*)(gate + col0 + bj * HALF + 16 * n);
        const int lane = fq * 16 + fr;
        char* Xp = (char*)(X + (size_t)prow * LDC);
        { u32x4 ta[2], tb[2];
#define RESN_LD(T, ai, m) do { _Pragma("unroll") for (int bj = 0; bj < 2; ++bj) T[bj] = *(const u32x4*)(Xp + (ob + (unsigned)(((ai) * HALF + (m) * 16) * LDC + bj * HALF) * 2u)); } while (0)
#define RESN_FMA(T, ai, m) do { asm volatile("" ::: "memory"); _Pragma("unroll") for (int bj = 0; bj < 2; ++bj) { f32x4 x0_, x1_; ungroup(T[bj], x0_, x1_); \
            U[ai][bj][m][0] = x0_ + gv[bj][0] * U[ai][bj][m][0]; U[ai][bj][m][1] = x1_ + gv[bj][1] * U[ai][bj][m][1]; \
            asm volatile("" : "+v"(U[ai][bj][m][0]), "+v"(U[ai][bj][m][1])); } \
            asm volatile("" ::: "memory"); } while (0)
          RESN_LD(ta, 0, 0); RESN_LD(tb, 0, 1); RESN_FMA(ta, 0, 0); RESN_LD(ta, 0, 2); RESN_FMA(tb, 0, 1); RESN_LD(tb, 0, 3); RESN_FMA(ta, 0, 2); RESN_LD(ta, 1, 0); RESN_FMA(tb, 0, 3);
          RESN_LD(tb, 1, 1); RESN_FMA(ta, 1, 0); RESN_LD(ta, 1, 2); RESN_FMA(tb, 1, 1); RESN_LD(tb, 1, 3); RESN_FMA(ta, 1, 2);
          f32x4 gs[2][2];
#pragma unroll
          for (int bj = 0; bj < 2; ++bj)
#pragma unroll
            for (int n = 0; n < 2; ++n) { const int c = col0 + bj * HALF + 16 * n;
                gs[bj][n] = A2 ? *(const f32x4*)(gnext + c) * (*(const f32x4*)(scale_next + bidx * 12288 + c) + 1.0f) : (f32x4){0.f, 0.f, 0.f, 0.f}; }
          RESN_FMA(tb, 1, 3);
#undef RESN_LD
#undef RESN_FMA
        char* Ap = (char*)(A2 + (size_t)prow * LDC);
        unsigned ob2 = ob; asm volatile("" : "+v"(ob2));
#pragma unroll
        for (int ai = 0; ai < 2; ++ai)
#pragma unroll
            for (int m = 0; m < 4; ++m) { float ss = 0.f;
#pragma unroll
                for (int bj = 0; bj < 2; ++bj) { const unsigned o_ = ob2 + (unsigned)((ai * HALF + m * 16) * LDC + bj * HALF) * 2u;
#pragma unroll
                    for (int n = 0; n < 2; ++n) { const f32x4 v = U[ai][bj][m][n]; ss += (v[0] * v[0] + v[1] * v[1]) + (v[2] * v[2] + v[3] * v[3]); }
                    *(u32x4*)(Xp + o_) = regroup_h(U[ai][bj][m][0], U[ai][bj][m][1]);
                    if (A2) *(u32x4*)(Ap + o_) = regroup(U[ai][bj][m][0] * gs[bj][0], U[ai][bj][m][1] * gs[bj][1]); }
                if (A2) { ss += epi_shfl_xor(ss, 16, lane); ss += epi_shfl_xor(ss, 32, lane); if (fq == 0) atomicAdd(rowss_next + prow + (int)rl + ai * HALF + m * 16, qgrid<QG_ROWSS>(ss)); } }
        }
        return;
        }
        {
            char* base = (char*)(slab + ((size_t)u.slab * 1024 + (prow - 8192)) * LDC);
#pragma unroll
            for (int ai = 0; ai < 2; ++ai)
#pragma unroll
                for (int m = 0; m < 4; ++m)
#pragma unroll
                    for (int bj = 0; bj < 2; ++bj) *(u32x4*)(base + (ob + (unsigned)((ai * HALF + m * 16) * LDC + bj * HALF) * 2u)) = regroup(U[ai][bj][m][0], U[ai][bj][m][1]);
        }
    }
};
struct EpiSguIn {
    static constexpr bool PERM = true, AFTER_DRAIN = false;
    bf16_t* O; int ldc; const float* bias; const float* rowss; const float* bias2; int ldb; float* stat; int vcol0;
    __device__ __forceinline__ void operator()(const f32x4 (&acc)[2][2][4][2], const Unit& u, int wr, int wc, int fr, int fq) const {
        const int prow = u.pm * BM, row0 = prow + wr * 64 + fr, col0 = u.pn * BM + wc * 32 + 8 * fq, bidx = prow < 8192 ? (prow >> 11) : 4, lane = fq * 16 + fr;
        const bool vhalf = u.pn * BM >= vcol0;
        f32x4 bv[2][2];
#pragma unroll
        for (int bj = 0; bj < 2; ++bj)
#pragma unroll
            for (int n = 0; n < 2; ++n) bv[bj][n] = *(const f32x4*)(bias2 + (size_t)bidx * ldb + col0 + bj * HALF + 4 * n) + *(const f32x4*)(bias + col0 + bj * HALF + 4 * n);
#pragma unroll
        for (int ai = 0; ai < 2; ++ai)
#pragma unroll
            for (int m = 0; m < 4; ++m) { const int row = row0 + ai * HALF + m * 16; bf16_t* rowp = O + (size_t)row * ldc + col0;
                const float rs = 1.0f / sqrtf(rowss[row] * (1.0f / 2048.0f) + 1e-6f); float s1 = 0.f, s2 = 0.f;
#pragma unroll
                for (int bj = 0; bj < 2; ++bj) { f32x4 v0 = acc[ai][bj][m][0] * rs + bv[bj][0], v1 = acc[ai][bj][m][1] * rs + bv[bj][1];
                    { f32x2 a = gelu_pk((f32x2){v0[0], v0[1]}), b = gelu_pk((f32x2){v0[2], v0[3]}), c = gelu_pk((f32x2){v1[0], v1[1]}), d = gelu_pk((f32x2){v1[2], v1[3]});
                      v0 = (f32x4){a.x, a.y, b.x, b.y}; v1 = (f32x4){c.x, c.y, d.x, d.y}; }
                    s1 += (v0[0] + v0[1]) + (v0[2] + v0[3]) + (v1[0] + v1[1]) + (v1[2] + v1[3]);
                    s2 += (v0[0] * v0[0] + v0[1] * v0[1]) + (v0[2] * v0[2] + v0[3] * v0[3]) + (v1[0] * v1[0] + v1[1] * v1[1]) + (v1[2] * v1[2] + v1[3] * v1[3]);
                    u32x4 w; w.x = cvt_pk_bf16(v0[0], v0[1]); w.y = cvt_pk_bf16(v0[2], v0[3]); w.z = cvt_pk_bf16(v1[0], v1[1]); w.w = cvt_pk_bf16(v1[2], v1[3]);
                    *(u32x4*)(rowp + bj * HALF) = w; }
                if (vhalf) { s1 += epi_shfl_xor(s1, 16, lane); s1 += epi_shfl_xor(s1, 32, lane); s2 += epi_shfl_xor(s2, 16, lane); s2 += epi_shfl_xor(s2, 32, lane);
                    if (fq == 0) { atomicAdd(stat + 2 * row, qgrid<QG_SGST>(s1)); atomicAdd(stat + 2 * row + 1, qgrid<QG_SGST>(s2)); } } }
    }
};
struct EpiMlaIn {
    static constexpr bool PERM = false, AFTER_DRAIN = false;
    const float* rowss; const float* bias2; int ldb; const float* qn; const float* kvn; bf16_t* CQN; bf16_t* CKVN; bf16_t* KPE; float* sq; float* skv; const float* rope_c; const float* rope_s;
    __device__ __forceinline__ void operator()(const f32x4 (&acc)[2][2][4][2], const Unit& u, int wr, int wc, int fr, int fq) const {
        if (u.pn > 4) return;
        const int prow = u.pm * BM, col0 = u.pn * BM + wc * 32 + 4 * fq, bidx = prow < 8192 ? (prow >> 11) : 4, lane = fq * 16 + fr;
        if (u.pn < 4) {
            const bool isq = u.pn < 2; const int cb = isq ? col0 : col0 - 512; const float* gn = isq ? qn : kvn; bf16_t* dst = isq ? CQN : CKVN; float* ssd = isq ? sq : skv;
            f32x4 bv[2][2], gg[2][2];
#pragma unroll
            for (int bj = 0; bj < 2; ++bj)
#pragma unroll
                for (int n = 0; n < 2; ++n) { bv[bj][n] = *(const f32x4*)(bias2 + (size_t)bidx * ldb + col0 + bj * HALF + n * 16); gg[bj][n] = *(const f32x4*)(gn + cb + bj * HALF + n * 16); }
#pragma unroll
            for (int ai = 0; ai < 2; ++ai)
#pragma unroll
                for (int m = 0; m < 4; ++m) { const int row = prow + ai * HALF + wr * 64 + m * 16 + fr; const float rs = 1.0f / sqrtf(rowss[row] * (1.0f / 2048.0f) + 1e-6f); float ss = 0.f;
#pragma unroll
                    for (int bj = 0; bj < 2; ++bj)
#pragma unroll
                        for (int n = 0; n < 2; ++n) { const f32x4 v = acc[ai][bj][m][n] * rs + bv[bj][n]; ss += (v[0] * v[0] + v[1] * v[1]) + (v[2] * v[2] + v[3] * v[3]); const f32x4 h = v * gg[bj][n];
                            uint2 w; w.x = cvt_pk_bf16(h[0], h[1]); w.y = cvt_pk_bf16(h[2], h[3]); *(uint2*)(dst + (size_t)row * 512 + cb + bj * HALF + n * 16) = w; }
                    ss += epi_shfl_xor(ss, 16, lane); ss += epi_shfl_xor(ss, 32, lane); if (fq == 0) atomicAdd(ssd + row, qgrid<QG_MLSS>(4.0f * ss)); }
            return;
        }
        if (wc >= 2) return;
        const f32x4 b0 = *(const f32x4*)(bias2 + (size_t)bidx * ldb + col0), b1 = *(const f32x4*)(bias2 + (size_t)bidx * ldb + col0 + 16);
#pragma unroll
        for (int ai = 0; ai < 2; ++ai)
#pragma unroll
            for (int m = 0; m < 4; ++m) { const int row = prow + ai * HALF + wr * 64 + m * 16 + fr; const float rs = 1.0f / sqrtf(rowss[row] * (1.0f / 2048.0f) + 1e-6f);
                f32x4 u1 = acc[ai][0][m][0] * rs + b0, u2 = acc[ai][0][m][1] * rs + b1;
                if (row < 8192) { const int t = row & 2047, pos = wc ? (t & 63) : (t >> 6);
                    const f32x4 cs = *(const f32x4*)(rope_c + pos * 16 + 4 * fq), sn = *(const f32x4*)(rope_s + pos * 16 + 4 * fq);
                    const f32x4 o1 = u1 * cs - u2 * sn, o2 = u1 * sn + u2 * cs; u1 = o1; u2 = o2; }
                bf16_t* kp = KPE + (size_t)row * 64 + wc * 32 + 4 * fq;
                uint2 w; w.x = cvt_pk_bf16(u1[0], u1[1]); w.y = cvt_pk_bf16(u1[2], u1[3]); *(uint2*)kp = w;
                w.x = cvt_pk_bf16(u2[0], u2[1]); w.y = cvt_pk_bf16(u2[2], u2[3]); *(uint2*)(kp + 16) = w; }
    }
};
struct EpiConvF1 {
    static constexpr bool PERM = true, PERMA = true, AFTER_DRAIN = false;
    bf16_t* ACT; const float* rowss; const float* bias2; const float* cw; const float* cb; bf16_t* UE;
    template <int CTRL> static __device__ __forceinline__ f32x4 dpp4(const f32x4 v) { f32x4 r;
#pragma unroll
        for (int e = 0; e < 4; ++e) { const float t = v[e]; r[e] = __builtin_bit_cast(float, __builtin_amdgcn_mov_dpp(__builtin_bit_cast(int, t), CTRL, 0xf, 0xf, false)); }
        return r; }
    __device__ __forceinline__ void operator()(const f32x4 (&acc_)[2][2][4][2], const Unit& u, int wr, int wc, int fr, int fq) const {
        f32x4 (&U)[2][2][4][2] = const_cast<f32x4 (&)[2][2][4][2]>(acc_);
        const int prow = u.pm * BM, bidx = prow < 8192 ? (prow >> 11) : 4; int ja = u.pn * 128 + wc * 32 + 8 * fq;
        int r0 = prow + wr * 64 + 4 * fr;
        f32x4 bv[2][2], ss[2], wa[2][3], wg[2][3], ba[2], bg[2];
#pragma unroll
        for (int bj = 0; bj < 2; ++bj)
#pragma unroll
            for (int n = 0; n < 2; ++n) bv[bj][n] = *(const f32x4*)(bias2 + (size_t)bidx * 11264 + bj * 5632 + ja + 4 * n);
#pragma unroll
        for (int ai = 0; ai < 2; ++ai) ss[ai] = *(const f32x4*)(rowss + r0 + ai * HALF);
#pragma unroll
        for (int n = 0; n < 2; ++n) {
#pragma unroll
            for (int k = 0; k < 3; ++k) { wa[n][k] = *(const f32x4*)(cw + (size_t)k * 11264 + ja + 4 * n); wg[n][k] = *(const f32x4*)(cw + (size_t)k * 11264 + 5632 + ja + 4 * n); }
            ba[n] = *(const f32x4*)(cb + ja + 4 * n); bg[n] = *(const f32x4*)(cb + 5632 + ja + 4 * n); }
#pragma unroll
        for (int ai = 0; ai < 2; ++ai) {
#pragma unroll
            for (int m = 0; m < 4; ++m) { const float rs = __builtin_amdgcn_rsqf(ss[ai][m] * (1.0f / 2048.0f) + 1e-6f);
#pragma unroll
                for (int bj = 0; bj < 2; ++bj)
#pragma unroll
                    for (int n = 0; n < 2; ++n) U[ai][bj][m][n] = U[ai][bj][m][n] * rs + bv[bj][n]; } }
        if (fr == 0 || fr == 15) { const bool hi = fr == 15;
#pragma unroll
            for (int ai = 0; ai < 2; ++ai) { const int blk = (prow >> 6) + 2 * ai + wr;
#pragma unroll
                for (int mm = 0; mm < 2; ++mm) { bf16_t* p = UE + ((size_t)blk * 4 + (hi ? 2 + mm : mm)) * 11264 + ja;
#pragma unroll
                    for (int bj = 0; bj < 2; ++bj) { const f32x4 v0 = hi ? U[ai][bj][2 + mm][0] : U[ai][bj][mm][0], v1 = hi ? U[ai][bj][2 + mm][1] : U[ai][bj][mm][1];
                        u32x4 w; w.x = cvt_pk_bf16(v0[0], v0[1]); w.y = cvt_pk_bf16(v0[2], v0[3]); w.z = cvt_pk_bf16(v1[0], v1[1]); w.w = cvt_pk_bf16(v1[2], v1[3]);
                        *(u32x4*)(p + bj * 5632) = w; } } } }
        float nl2e = -1.4426950408889634f; asm volatile("" : "+v"(nl2e));
#pragma unroll
        for (int ai = 0; ai < 2; ++ai) {
#pragma unroll
            for (int m = 0; m < 4; ++m) { u32x4 w;
#pragma unroll
                for (int n = 0; n < 2; ++n) {
                    const f32x4 pa = m > 0 ? U[ai][0][m > 0 ? m - 1 : 0][n] : dpp4<0x121>(U[ai][0][3][n]), pg = m > 0 ? U[ai][1][m > 0 ? m - 1 : 0][n] : dpp4<0x121>(U[ai][1][3][n]);
                    const f32x4 na = m < 3 ? U[ai][0][m < 3 ? m + 1 : 3][n] : dpp4<0x12F>(U[ai][0][0][n]), ng = m < 3 ? U[ai][1][m < 3 ? m + 1 : 3][n] : dpp4<0x12F>(U[ai][1][0][n]);
                    const f32x4 a = __builtin_elementwise_fma(wa[n][2], na, __builtin_elementwise_fma(wa[n][1], U[ai][0][m][n], __builtin_elementwise_fma(wa[n][0], pa, ba[n])));
                    const f32x4 g = __builtin_elementwise_fma(wg[n][2], ng, __builtin_elementwise_fma(wg[n][1], U[ai][1][m][n], __builtin_elementwise_fma(wg[n][0], pg, bg[n])));
                    const f32x4 x = g * nl2e; f32x4 d;
#pragma unroll
                    for (int e = 0; e < 4; ++e) d[e] = __builtin_amdgcn_exp2f(x[e]);
                    d = d + 1.f;
#pragma unroll
                    for (int e = 0; e < 4; ++e) d[e] = __builtin_amdgcn_rcpf(d[e]);
                    const f32x4 o = a * (g * d);
                    if (n == 0) { w.x = cvt_pk_bf16(o[0], o[1]); w.y = cvt_pk_bf16(o[2], o[3]); } else { w.z = cvt_pk_bf16(o[0], o[1]); w.w = cvt_pk_bf16(o[2], o[3]); } }
                const bool edge = (m == 0 && fr == 0) || (m == 3 && fr == 15);
                if (!edge) *(u32x4*)(ACT + (size_t)(r0 + ai * HALF + m) * 5632 + ja) = w; } }
    }
};
struct DualOrder {
    StaticOrder s0, s1; int G, c;
    __device__ __forceinline__ void init(int M, int N0, int N1, int G_, int c_) { s0.init(M, N0, G_, c_); s1.init(M, N1, G_, c_); G = G_; c = c_; }
    __device__ __forceinline__ bool get(int i, int& pm, int& pn, int& kt0, int& nt, int& slab) const {
        const long L = (long)i * G + c; kt0 = 0; nt = 0;
        if (L < s0.nwg) { slab = 0; return s0.by_index(L, pm, pn); }
        slab = 1; return s1.by_index(L - s0.nwg, pm, pn);
    }
    __device__ __forceinline__ void a_ready(const Unit&) const {}
    __device__ __forceinline__ void done(const Unit&) const {}
};
struct EpiMlaUp {
    static constexpr bool PERM = true, AFTER_DRAIN = false;
    bf16_t* O0; int ldc0; const float* rss0; bf16_t* O1; int ldc1; const float* rss1;
    __device__ __forceinline__ void operator()(const f32x4 (&acc)[2][2][4][2], const Unit& u, int wr, int wc, int fr, int fq) const {
        bf16_t* O = u.slab ? O1 : O0; const int ldc = u.slab ? ldc1 : ldc0; const float* rss = u.slab ? rss1 : rss0;
        const int row0 = u.pm * BM + wr * 64 + fr, col0 = u.pn * BM + wc * 32 + 8 * fq;
#pragma unroll
        for (int ai = 0; ai < 2; ++ai)
#pragma unroll
            for (int m = 0; m < 4; ++m) { const int row = row0 + ai * HALF + m * 16; bf16_t* rowp = O + (size_t)row * ldc + col0;
                const float rs = 1.0f / sqrtf(rss[row] * (1.0f / 2048.0f) + 1e-6f);
#pragma unroll
                for (int bj = 0; bj < 2; ++bj) { const f32x4 v0 = acc[ai][bj][m][0] * rs, v1 = acc[ai][bj][m][1] * rs;
                    u32x4 w; w.x = cvt_pk_bf16(v0[0], v0[1]); w.y = cvt_pk_bf16(v0[2], v0[3]); w.z = cvt_pk_bf16(v1[0], v1[1]); w.w = cvt_pk_bf16(v1[2], v1[3]);
                    *(u32x4*)(rowp + bj * HALF) = w; } }
    }
};
}
#define GAS __attribute__((address_space(1)))
#define LAS __attribute__((address_space(3)))
typedef unsigned short bf16;
typedef unsigned v4u __attribute__((ext_vector_type(4)));
typedef float f32x4 __attribute__((ext_vector_type(4)));
typedef short bf16x8 __attribute__((ext_vector_type(8)));
typedef GAS unsigned gu32;
typedef GAS unsigned long long gu64;
#define RLX_AGENT __ATOMIC_RELAXED, __HIP_MEMORY_SCOPE_AGENT
#define LDS_WAIT() asm volatile("s_waitcnt lgkmcnt(0)" ::: "memory")
#define VM_WAIT() asm volatile("s_waitcnt vmcnt(0)" ::: "memory")
__device__ __forceinline__ unsigned long long rt() { return __builtin_amdgcn_s_memrealtime(); }
__device__ __forceinline__ unsigned f2bf(float f) { unsigned u = __builtin_bit_cast(unsigned, f); return (u + 0x7fffu + ((u >> 16) & 1u)) >> 16; }
__device__ __forceinline__ unsigned pk2(float lo, float hi) { return f2bf(lo) | (f2bf(hi) << 16); }

#define XB_TMO      128
#define XB_XCNT(j)  (256  + 64 * (j))
#define XB_XSUB(j)  (1280 + 64 * (j))
#define XB_XGEN(j)  (2304 + 64 * (j))
#define XB_TOP      3328
#define XB_TOPGEN   3392
#define XCD_BAR_WORDS 3456
#define XB_SPIN_CAP (1u << 18)

__device__ __forceinline__ unsigned xb_ld(unsigned* p)              { return __hip_atomic_load(p, __ATOMIC_RELAXED, __HIP_MEMORY_SCOPE_AGENT); }
__device__ __forceinline__ unsigned xb_add(unsigned* p, unsigned v) { return __hip_atomic_fetch_add(p, v, __ATOMIC_RELAXED, __HIP_MEMORY_SCOPE_AGENT); }
__device__ __forceinline__ unsigned xb_xcc_id() { return (unsigned)__builtin_amdgcn_s_getreg((3 << 11) | 20) & 0xFu; }
#define XB_SPIN(cond, bar) do { unsigned _sp = 0; while (cond) { __builtin_amdgcn_s_sleep(1); \
    if ((++_sp & 255u) == 0u) { if (xb_ld(&(bar)[XB_TMO])) break; if (_sp > XB_SPIN_CAP) { atomicAdd(&(bar)[XB_TMO], 1u); break; } } } } while (0)

struct XcdBarrier {
    unsigned* bar; unsigned x;
    volatile LAS unsigned* st;
};

__device__ __forceinline__ XcdBarrier xcd_barrier_post(unsigned* bar, volatile LAS unsigned* st) {
    XcdBarrier b; b.bar = bar; b.x = xb_xcc_id(); b.st = st;
    if (threadIdx.x == 0) (void)xb_add(&bar[XB_XCNT(b.x)], 1u);
    return b;
}
__device__ __forceinline__ void xcd_barrier_complete(unsigned* bar, unsigned x, unsigned& nloc, unsigned& nx) {
    const unsigned G = gridDim.x * gridDim.y * gridDim.z;
    unsigned sum, cnt, mine, sp = 0u;
    for (;;) {
        sum = 0u; cnt = 0u; mine = 0u;
#pragma unroll
        for (unsigned j = 0; j < 16; ++j) { const unsigned c = xb_ld(&bar[XB_XCNT(j)]); sum += c; cnt += (c > 0u) ? 1u : 0u; mine = (j == x) ? c : mine; }
        if (sum == G) break;
        __builtin_amdgcn_s_sleep(1);
        if ((++sp & 255u) == 0u) { if (xb_ld(&bar[XB_TMO])) break; if (sp > XB_SPIN_CAP) { atomicAdd(&bar[XB_TMO], 1u); break; } }
    }
    nloc = mine > 0u ? mine : 1u; nx = cnt > 0u ? cnt : 1u;
}

__device__ __forceinline__ void xcd_barrier(const XcdBarrier& b) {
    asm volatile("s_waitcnt vmcnt(0)" ::: "memory");
    __syncthreads();
    if (threadIdx.x == 0) {
        unsigned* bar = b.bar;
        __builtin_amdgcn_s_waitcnt(0);
        unsigned nloc = b.st[0], nx = b.st[1];
        if (nloc == 0u) { xcd_barrier_complete(bar, b.x, nloc, nx); b.st[0] = nloc; b.st[1] = nx; }
        const unsigned old = xb_add(&bar[XB_XSUB(b.x)], 1u);
        const unsigned gen = old / nloc;
        if (old + 1u == (gen + 1u) * nloc) {
            __builtin_amdgcn_fence(__ATOMIC_RELEASE, "agent");
            asm volatile("s_waitcnt vmcnt(0)" ::: "memory");
            const unsigned og = xb_add(&bar[XB_TOP], 1u);
            const unsigned tg = og / nx;
            if (og + 1u == (tg + 1u) * nx) xb_add(&bar[XB_TOPGEN], 1u);
            else XB_SPIN(xb_ld(&bar[XB_TOPGEN]) == tg, bar);
            __builtin_amdgcn_fence(__ATOMIC_ACQUIRE, "agent");
            xb_add(&bar[XB_XGEN(b.x)], 1u);
            asm volatile("s_waitcnt vmcnt(0)" ::: "memory");
        } else {
            XB_SPIN(xb_ld(&bar[XB_XGEN(b.x)]) == gen, bar);
            __builtin_amdgcn_fence(__ATOMIC_ACQUIRE, "agent");
            asm volatile("s_waitcnt vmcnt(0)" ::: "memory");
        }
    }
    __syncthreads();
}
namespace att {
#define ALAS __attribute__((address_space(3)))
using bf16x8 = __attribute__((ext_vector_type(8))) short;
using s16x4  = __attribute__((ext_vector_type(4))) short;
using f32x16 = __attribute__((ext_vector_type(16))) float;
using f32x4  = __attribute__((ext_vector_type(4))) float;
using u32x4  = __attribute__((ext_vector_type(4))) unsigned;
typedef unsigned short bf16_t;
#define SBAR() __builtin_amdgcn_sched_barrier(0)
__device__ __forceinline__ int crow(int r, int hi) { return (r & 3) + 8 * (r >> 2) + 4 * hi; }
__device__ __forceinline__ unsigned cvtpk(float lo, float hi) { unsigned r; asm volatile("v_cvt_pk_bf16_f32 %0, %1, %2" : "=v"(r) : "v"(lo), "v"(hi)); return r; }
__device__ __forceinline__ float bf2f(short s) { return __uint_as_float(((unsigned)(unsigned short)s) << 16); }
__device__ __forceinline__ int iclamp(int v, int lo, int hi) { return v < lo ? lo : (v > hi ? hi : v); }
__device__ __forceinline__ int swz_g3(int row) { return ((row >> 1) & 1) | (((row >> 3) & 1) << 1) | (((row >> 4) & 1) << 2); }
template <int DQK> __device__ __forceinline__ int kswz(int row, int colB) {
  const int chunk = colB >> 4, within = colB & 15; int c2;
  if (DQK == 128) c2 = chunk ^ (row & 15);
  else c2 = chunk < 16 ? (chunk ^ ((row & 15) ^ ((row & 1) << 3))) : (16 + ((chunk - 16) ^ swz_g3(row)));
  return row * (DQK * 2) + (c2 << 4) + within; }
__device__ __forceinline__ int v_st(int k, int c) { const int kk = (k & ~0xC) | ((k & 4) << 1) | ((k & 8) >> 1); return ((kk >> 3) * 4 + (c >> 5)) * 512 + ((kk & 7) * 32 + (c & 31)) * 2; }
__device__ __forceinline__ int v_rd_base(int lane) { return ((lane & 3) << 3) | (((lane >> 2) & 3) << 6) | (((lane >> 4) & 1) << 5) | (((lane >> 5) & 1) << 8); }
constexpr int v_rd_off(int d0, int ks, int half) { return d0 * 512 + ks * 4096 + half * 2048; }
template <int OFF> __device__ __forceinline__ s16x4 tr_read(int vb) { s16x4 r; asm volatile("ds_read_b64_tr_b16 %0, %1 offset:%2" : "=&v"(r) : "v"(vb), "i"(OFF) : "memory"); return r; }
struct VFrag { s16x4 l0, h0, l1, h1, l2, h2, l3, h3; };
template <int D0> __device__ __forceinline__ void v_issue(VFrag& f, int vb) {
  f.l0 = tr_read<v_rd_off(D0, 0, 0)>(vb); f.h0 = tr_read<v_rd_off(D0, 0, 1)>(vb); f.l1 = tr_read<v_rd_off(D0, 1, 0)>(vb); f.h1 = tr_read<v_rd_off(D0, 1, 1)>(vb);
  f.l2 = tr_read<v_rd_off(D0, 2, 0)>(vb); f.h2 = tr_read<v_rd_off(D0, 2, 1)>(vb); f.l3 = tr_read<v_rd_off(D0, 3, 0)>(vb); f.h3 = tr_read<v_rd_off(D0, 3, 1)>(vb);
}
__device__ __forceinline__ void v_mma(f32x16& od, const VFrag& f, bf16x8 pa0, bf16x8 pa1, bf16x8 pa2, bf16x8 pa3) {
#define ATT_PK(L, H) (bf16x8){L[0], L[1], L[2], L[3], H[0], H[1], H[2], H[3]}
  od = __builtin_amdgcn_mfma_f32_32x32x16_bf16(pa0, ATT_PK(f.l0, f.h0), od, 0, 0, 0);
  od = __builtin_amdgcn_mfma_f32_32x32x16_bf16(pa1, ATT_PK(f.l1, f.h1), od, 0, 0, 0);
  od = __builtin_amdgcn_mfma_f32_32x32x16_bf16(pa2, ATT_PK(f.l2, f.h2), od, 0, 0, 0);
  od = __builtin_amdgcn_mfma_f32_32x32x16_bf16(pa3, ATT_PK(f.l3, f.h3), od, 0, 0, 0);
#undef ATT_PK
}
template <int D0> __device__ __forceinline__ void pv_one(f32x16& od, int vb, bf16x8 pa0, bf16x8 pa1, bf16x8 pa2, bf16x8 pa3) {
  VFrag f; v_issue<D0>(f, vb); asm volatile("s_waitcnt lgkmcnt(0)" ::: "memory"); SBAR(); v_mma(od, f, pa0, pa1, pa2, pa3);
}
__device__ __forceinline__ void pv_d0(f32x16* o, int vb, bf16x8 pa0, bf16x8 pa1, bf16x8 pa2, bf16x8 pa3) {
  VFrag fa, fb;
  v_issue<0>(fa, vb); v_issue<1>(fb, vb);
  asm volatile("s_waitcnt lgkmcnt(8)" ::: "memory"); SBAR(); v_mma(o[0], fa, pa0, pa1, pa2, pa3); SBAR();
  v_issue<2>(fa, vb);
  asm volatile("s_waitcnt lgkmcnt(8)" ::: "memory"); SBAR(); v_mma(o[1], fb, pa0, pa1, pa2, pa3); SBAR();
  v_issue<3>(fb, vb);
  asm volatile("s_waitcnt lgkmcnt(8)" ::: "memory"); SBAR(); v_mma(o[2], fa, pa0, pa1, pa2, pa3); SBAR();
  asm volatile("s_waitcnt lgkmcnt(0)" ::: "memory"); SBAR(); v_mma(o[3], fb, pa0, pa1, pa2, pa3);
}
template <int DQK> __device__ __forceinline__ void qkt(f32x16& p0, f32x16& p1, const ALAS char* Ks, const bf16x8* qr, const ALAS char* qls, int r32, int hi) {
  p0 = f32x16{}; p1 = f32x16{};
  if constexpr (DQK != 128) {
#pragma unroll
    for (int d0 = 0; d0 < DQK / 16; ++d0) { const int cb = (d0 * 16 + hi * 8) * 2;
      const bf16x8 b0 = *(const ALAS bf16x8*)(Ks + kswz<DQK>(r32, cb));
      const bf16x8 b1 = *(const ALAS bf16x8*)(Ks + kswz<DQK>(32 + r32, cb));
      bf16x8 q;
      if (d0 < 8) q = qr[d0 < 8 ? d0 : 0]; else q = *(const ALAS bf16x8*)(qls + (((2 * (d0 - 8) + hi) ^ swz_g3(r32)) << 4));
      p0 = __builtin_amdgcn_mfma_f32_32x32x16_bf16(b0, q, p0, 0, 0, 0);
      p1 = __builtin_amdgcn_mfma_f32_32x32x16_bf16(b1, q, p1, 0, 0, 0);
      if ((d0 & 3) == 3) SBAR(); }
    return;
  }
  constexpr int NG = DQK / 32;
  bf16x8 kb[2][4], qq[2][2];
#define QKT_LOAD(G, B) do { _Pragma("unroll") for (int e_ = 0; e_ < 2; ++e_) { const int d0_ = 2 * (G) + e_, cb_ = (d0_ * 16 + hi * 8) * 2; \
      kb[B][2 * e_] = *(const ALAS bf16x8*)(Ks + kswz<DQK>(r32, cb_)); kb[B][2 * e_ + 1] = *(const ALAS bf16x8*)(Ks + kswz<DQK>(32 + r32, cb_)); \
      if (d0_ >= 8) qq[B][e_] = *(const ALAS bf16x8*)(qls + (((2 * (d0_ - 8) + hi) ^ swz_g3(r32)) << 4)); } } while (0)
  QKT_LOAD(0, 0);
#pragma unroll
  for (int g = 0; g < NG; ++g) {
    if (g + 1 < NG) { if ((g + 1) & 1) QKT_LOAD(g + 1, 1); else QKT_LOAD(g + 1, 0); }
    SBAR();
#pragma unroll
    for (int e = 0; e < 2; ++e) { const int d0 = 2 * g + e; const bf16x8 q = d0 < 8 ? qr[d0 < 8 ? d0 : 0] : qq[g & 1][e];
      p0 = __builtin_amdgcn_mfma_f32_32x32x16_bf16(kb[g & 1][2 * e], q, p0, 0, 0, 0);
      p1 = __builtin_amdgcn_mfma_f32_32x32x16_bf16(kb[g & 1][2 * e + 1], q, p1, 0, 0, 0); }
    SBAR();
  }
#undef QKT_LOAD
}

constexpr int SHM_V = 16384;
constexpr int L_V = 0, L_K = 32768, L_WS = L_K + 2 * 24576, L_RPB = L_WS + 2048, L_QR = L_RPB + 2048, L_END = L_QR + 32768;

struct RopeTab { float c[64 * 16]; float s[64 * 16]; };
constexpr double c_exp(double x) { double y = x / 1024.0, t = 1.0, sum = 1.0; for (int i = 1; i < 24; ++i) { t *= y / i; sum += t; } for (int i = 0; i < 10; ++i) sum *= sum; return sum; }
constexpr double c_sin(double x) { const double tp = 6.283185307179586476925286766559; long long k = (long long)(x / tp); x -= (double)k * tp; if (x > tp / 2) x -= tp;
  double t = x, sum = x; for (int i = 1; i < 16; ++i) { t *= -x * x / ((2.0 * i) * (2.0 * i + 1.0)); sum += t; } return sum; }
constexpr double c_cos(double x) { const double tp = 6.283185307179586476925286766559; long long k = (long long)(x / tp); x -= (double)k * tp; if (x > tp / 2) x -= tp;
  double t = 1.0, sum = 1.0; for (int i = 1; i < 16; ++i) { t *= -x * x / ((2.0 * i - 1.0) * (2.0 * i)); sum += t; } return sum; }
constexpr RopeTab make_rope() { RopeTab r{}; for (int j = 0; j < 16; ++j) { const double f = (double)(float)c_exp(-(double)j / 16.0 * 9.2103403719761836);
    for (int p = 0; p < 64; ++p) { const double a = (double)(float)((double)p * f); r.c[p * 16 + j] = (float)c_cos(a); r.s[p * 16 + j] = (float)c_sin(a); } } return r; }
__device__ const RopeTab g_rope = make_rope();

struct AttnP {
  const bf16_t* Q;
  const bf16_t* K;
  const bf16_t* V;
  const bf16_t* KPE;
  bf16_t* O;
  const float* rpb;
};

template <int MODE> struct SmC { static constexpr float SCALE = MODE ? 0.07216878364870322f : 0.08838834764831845f, C = SCALE * 1.4426950408889634f, THRS = 8.0f / SCALE; };
template <int MODE> __device__ __forceinline__ void partialSM(f32x16& p0, f32x16& p1, float& m_reg, float& mn, float& alpha) {
  constexpr float C = SmC<MODE>::C;
  float pmax = p0[0];
#pragma unroll
  for (int r = 1; r < 16; ++r) pmax = fmaxf(pmax, p0[r]);
#pragma unroll
  for (int r = 0; r < 16; ++r) pmax = fmaxf(pmax, p1[r]);
  { auto rr = __builtin_amdgcn_permlane32_swap(__float_as_uint(pmax), __float_as_uint(pmax), false, false); pmax = fmaxf(__uint_as_float(rr[0]), __uint_as_float(rr[1])); }
  if (__builtin_expect(__all(pmax - m_reg <= SmC<MODE>::THRS), 1)) { mn = m_reg; alpha = 1.f; }
  else { mn = fmaxf(m_reg, pmax); alpha = __builtin_amdgcn_exp2f((m_reg - mn) * C); m_reg = mn; }
  const float mnC = -mn * C;
#pragma unroll
  for (int r = 0; r < 16; ++r) p0[r] = fmaf(p0[r], C, mnC);
#pragma unroll
  for (int r = 0; r < 16; ++r) p1[r] = fmaf(p1[r], C, mnC);
#pragma unroll
  for (int r = 0; r < 16; ++r) p0[r] = __builtin_amdgcn_exp2f(p0[r]);
}
__device__ __forceinline__ void finishSM(f32x16& p0, f32x16& p1, float alpha, float& l_reg, bf16x8& pa0, bf16x8& pa1, bf16x8& pa2, bf16x8& pa3) {
#pragma unroll
  for (int r = 0; r < 16; ++r) p1[r] = __builtin_amdgcn_exp2f(p1[r]);
  float ps = 0.f;
#pragma unroll
  for (int r = 0; r < 16; ++r) ps += p0[r];
#pragma unroll
  for (int r = 0; r < 16; ++r) ps += p1[r];
  { auto rr = __builtin_amdgcn_permlane32_swap(__float_as_uint(ps), __float_as_uint(ps), false, false); ps = __uint_as_float(rr[0]) + __uint_as_float(rr[1]); }
  l_reg = l_reg * alpha + ps;
#define ATT_PK4(PP, BASE, OUT) do { unsigned a0 = cvtpk(PP[BASE + 0], PP[BASE + 1]), a1 = cvtpk(PP[BASE + 2], PP[BASE + 3]); \
    unsigned b0 = cvtpk(PP[BASE + 4], PP[BASE + 5]), b1 = cvtpk(PP[BASE + 6], PP[BASE + 7]); \
    auto r0 = __builtin_amdgcn_permlane32_swap(a0, b0, false, false); auto r1 = __builtin_amdgcn_permlane32_swap(a1, b1, false, false); \
    u32x4 w = {r0[0], r1[0], r0[1], r1[1]}; OUT = __builtin_bit_cast(bf16x8, w); } while (0)
  ATT_PK4(p0, 0, pa0); ATT_PK4(p0, 8, pa1); ATT_PK4(p1, 0, pa2); ATT_PK4(p1, 8, pa3);
#undef ATT_PK4
}
__device__ __forceinline__ void na_mask(f32x16& p0, f32x16& p1, const ALAS float* rpbS, int base, int cs, int hi) {
#pragma unroll
  for (int r = 0; r < 16; ++r) { const int k0 = crow(r, hi), k1 = k0 + 32;
    const bool v0 = (k0 >= cs) && (k0 < cs + 16), v1 = (k1 >= cs) && (k1 < cs + 16);
    const float b0 = rpbS[v0 ? base + k0 : 0], b1 = rpbS[v1 ? base + k1 : 0];
    p0[r] = v0 ? p0[r] + b0 : -1e30f; p1[r] = v1 ? p1[r] + b1 : -1e30f; }
}

template <int MODE>
__device__ __forceinline__ void attn_unit(ALAS char* lds, const AttnP& P, int b, int h, int qb, bool ctxq) {
  constexpr int DQK = MODE ? 192 : 128, ND0 = DQK / 16, NKC = DQK / 64, SHM_K = 64 * DQK * 2;
  constexpr float SCALE = SmC<MODE>::SCALE;
  constexpr int LDQ = MODE ? 3072 : 6144, QHS = MODE ? 192 : 128, LDK = MODE ? 4096 : 6144, KHS = MODE ? 256 : 128, LDV = LDK, VHS = KHS;
  int tid_ = threadIdx.x; asm volatile("" : "+v"(tid_));
  const int tid = tid_, wid = __builtin_amdgcn_readfirstlane(tid >> 6), lane = tid & 63, r32 = lane & 31, hi = lane >> 5;
  ALAS char* V_lds = lds + L_V; ALAS char* K_lds = lds + L_K;
  ALAS float* wsf = (ALAS float*)(lds + L_WS) + wid * 64; ALAS float* li_l = wsf; ALAS float* al_l = wsf + 32;
  ALAS float* rpbS = (ALAS float*)(lds + L_RPB);
  const int qtok0 = ctxq ? 8192 + b * 256 : b * 2048 + qb * 256;
  const int ctok0 = 8192 + b * 256, ltok0 = b * 2048;
  int NT, lo = 0;
  if (ctxq) NT = 4; else if (MODE == 1) NT = 36; else { lo = iclamp(4 * qb - 4, 0, 24); NT = 4 + (iclamp(4 * qb - 1, 0, 24) + 7 - lo + 1); NT += NT & 1; }
  const bool band = (MODE == 0) && !ctxq;
#define TILE_TOK(t) (MODE == 1 ? (ctxq ? ctok0 + 64 * (t) : ((t) < 32 ? ltok0 + 64 * (t) : ctok0 + 64 * ((t) - 32))) : ((ctxq || (t) < 4) ? ctok0 + 64 * (t) : ltok0 + 64 * iclamp(lo + (t) - 4, 0, 31)))
  const int rq = 4 * qb + (wid >> 1), wq = 32 * (wid & 1) + r32, rs = iclamp(rq - 4, 0, 24), cs = iclamp(wq - 8, 0, 48);
#define NEED(t) (!(band && (t) >= 4) || ((lo + (t) - 4 >= rs) && (lo + (t) - 4 < rs + 8)))
  if (band) { for (int i = tid; i < 465; i += 512) rpbS[i] = P.rpb[h * 465 + i] * (1.0f / SCALE); }
  bf16x8 qr[8];
  const bf16_t* Qp = P.Q + (size_t)(qtok0 + wid * 32 + r32) * LDQ + h * QHS + hi * 8;
#pragma unroll
  for (int d0 = 0; d0 < 8; ++d0) qr[d0] = *(const bf16x8*)(Qp + d0 * 16);
  ALAS char* qls = lds + L_QR + (wid * 32 + r32) * 128;
  if constexpr (MODE == 1) {
    bf16x8 qe[4];
#pragma unroll
    for (int d = 0; d < 4; ++d) qe[d] = *(const bf16x8*)(Qp + (8 + d) * 16);
    if (!ctxq) {
      const int prow = 4 * qb + (wid >> 1), pcol = 32 * (wid & 1) + r32;
#pragma unroll
      for (int hh = 0; hh < 2; ++hh) { const int pos = hh ? pcol : prow; const float* ct = g_rope.c + pos * 16 + 8 * hi; const float* st = g_rope.s + pos * 16 + 8 * hi;
        const f32x4 c0 = *(const f32x4*)ct, c1 = *(const f32x4*)(ct + 4), s0 = *(const f32x4*)st, s1 = *(const f32x4*)(st + 4);
        float cc[8], ss[8];
#pragma unroll
        for (int e = 0; e < 4; ++e) { cc[e] = c0[e]; cc[4 + e] = c1[e]; ss[e] = s0[e]; ss[4 + e] = s1[e]; }
        unsigned w1[4], w2[4];
#pragma unroll
        for (int e = 0; e < 8; e += 2) {
          const float a0 = bf2f(qe[2 * hh][e]), a1 = bf2f(qe[2 * hh][e + 1]), b0 = bf2f(qe[2 * hh + 1][e]), b1 = bf2f(qe[2 * hh + 1][e + 1]);
          w1[e >> 1] = cvtpk(a0 * cc[e] - b0 * ss[e], a1 * cc[e + 1] - b1 * ss[e + 1]); w2[e >> 1] = cvtpk(a0 * ss[e] + b0 * cc[e], a1 * ss[e + 1] + b1 * cc[e + 1]); }
        u32x4 x1 = {w1[0], w1[1], w1[2], w1[3]}, x2 = {w2[0], w2[1], w2[2], w2[3]};
        qe[2 * hh] = __builtin_bit_cast(bf16x8, x1); qe[2 * hh + 1] = __builtin_bit_cast(bf16x8, x2); }
    }
#pragma unroll
    for (int d = 0; d < 4; ++d) *(ALAS bf16x8*)(qls + (((2 * d + hi) ^ swz_g3(r32)) << 4)) = qe[d];
  }
  constexpr int NKP = DQK / 64;
  int koff[NKP], voff[2]; bool kpe_[NKP];
#pragma unroll
  for (int pp = 0; pp < NKP; ++pp) { const int c = (wid * NKP + pp) * 64 + lane; kpe_[pp] = false;
    if constexpr (MODE == 0) { const int row = c >> 4, chunk = (c & 15) ^ (row & 15); koff[pp] = row * LDK + chunk * 8; }
    else { const int row = c / 24, c2 = c % 24; const int chunk = c2 < 16 ? (c2 ^ ((row & 15) ^ ((row & 1) << 3))) : (16 + ((c2 - 16) ^ swz_g3(row)));
      if (chunk < 16) koff[pp] = row * LDK + chunk * 8; else { koff[pp] = row * 64 + (chunk - 16) * 8; kpe_[pp] = true; } } }
#pragma unroll
  for (int pp = 0; pp < 2; ++pp) { const int c = (wid * 2 + pp) * 64 + lane, st = c >> 5, kk = (st >> 2) * 8 + ((c & 31) >> 2), col = (st & 3) * 32 + (c & 3) * 8;
    const int k = (kk & ~0xC) | ((kk & 4) << 1) | ((kk & 8) >> 1); voff[pp] = k * LDV + col; }
  const bf16_t* Vb = P.V + h * VHS; const bf16_t* Kb = P.K + h * KHS;
  const unsigned ldsK = (unsigned)(uintptr_t)K_lds + (unsigned)wid * NKP * 1024u, ldsV = (unsigned)(uintptr_t)V_lds + (unsigned)wid * 2048u;
  const int vb0 = (int)(uintptr_t)V_lds + v_rd_base(lane);
#define ATT_GLDS(SRC, DST) do { unsigned keep_; asm volatile("s_mov_b32 %0, m0\n\ts_mov_b32 m0, %2\n\ts_nop 0\n\tglobal_load_lds_dwordx4 %1, off\n\ts_mov_b32 m0, %0" : "=&s"(keep_) : "v"(SRC), "s"(DST) : "memory"); } while (0)
#define ATT_DMA_K(T, SLOT) do { const int tk_ = TILE_TOK(T); _Pragma("unroll") for (int pp_ = 0; pp_ < NKP; ++pp_) { \
      const bf16_t* src_ = (MODE == 1 && kpe_[pp_]) ? P.KPE + (size_t)tk_ * 64 + koff[pp_] : Kb + (size_t)tk_ * LDK + koff[pp_]; \
      ATT_GLDS(src_, (unsigned)__builtin_amdgcn_readfirstlane(ldsK + (SLOT) * SHM_K + pp_ * 1024)); } } while (0)
#define ATT_DMA_V(T, SLOT) do { const int tv_ = TILE_TOK(T); _Pragma("unroll") for (int pp_ = 0; pp_ < 2; ++pp_) \
      ATT_GLDS(Vb + (size_t)tv_ * LDV + voff[pp_], (unsigned)__builtin_amdgcn_readfirstlane(ldsV + (SLOT) * SHM_V + pp_ * 1024)); } while (0)
#define ATT_LAND() do { asm volatile("s_waitcnt vmcnt(0)" ::: "memory"); __syncthreads(); } while (0)
#define ATT_QK(PX0, PX1, BUF, T) do { const int t_ = (T); if (NEED(t_)) { qkt<DQK>(PX0, PX1, K_lds + (BUF) * SHM_K, qr, qls, r32, hi); \
      if (band && t_ >= 4) na_mask(PX0, PX1, rpbS, (lo + t_ - 4 - rq + 7) * 31 + 15 - wq, cs, hi); } } while (0)
#define ATT_PSM(PX0, PX1, MN, AL, T) do { if (NEED(T)) partialSM<MODE>(PX0, PX1, m_reg, MN, AL); else { AL = 1.f; MN = m_reg; } } while (0)
#define ATT_FSM(PX0, PX1, AL, T) do { if (NEED(T)) finishSM(PX0, PX1, AL, l_reg, pa0, pa1, pa2, pa3); } while (0)
#define ATT_RESC(a) do { if (__any((a) < 1.f)) { if (hi == 0) al_l[r32] = (a); asm volatile("s_waitcnt lgkmcnt(0)" ::: "memory"); \
    _Pragma("unroll") for (int r_ = 0; r_ < 16; ++r_) { const float a_ = al_l[crow(r_, hi)]; _Pragma("unroll") for (int d_ = 0; d_ < 4; ++d_) o[d_][r_] *= a_; } } } while (0)
  float m_reg = -1e30f, l_reg = 0.f; f32x16 o[4];
#pragma unroll
  for (int d = 0; d < 4; ++d) o[d] = f32x16{};
  f32x16 pA0, pA1, pB0, pB1; float mnA, mnB, alA, alB; bf16x8 pa0, pa1, pa2, pa3;
  ATT_DMA_K(0, 0); ATT_LAND();
  ATT_DMA_K(1, 1); ATT_DMA_V(0, 0);
  ATT_QK(pA0, pA1, 0, 0); ATT_PSM(pA0, pA1, mnA, alA, 0);
  ATT_LAND();
  for (int j = 1; j + 1 < NT; j += 2) {
    ATT_DMA_K(j + 1, 0); ATT_DMA_V(j, 1);
    SBAR(); ATT_QK(pB0, pB1, 1, j);
    ATT_FSM(pA0, pA1, alA, j - 1); SBAR();
    if (NEED(j - 1)) pv_d0(o, vb0, pa0, pa1, pa2, pa3);
    ATT_PSM(pB0, pB1, mnB, alB, j);
    ATT_LAND(); ATT_RESC(alB);
    if (j + 2 < NT) ATT_DMA_K(j + 2, 1);
    ATT_DMA_V(j + 1, 0);
    SBAR(); ATT_QK(pA0, pA1, 0, j + 1);
    ATT_FSM(pB0, pB1, alB, j); SBAR();
    if (NEED(j)) pv_d0(o, vb0 + SHM_V, pa0, pa1, pa2, pa3);
    ATT_PSM(pA0, pA1, mnA, alA, j + 1);
    ATT_LAND(); ATT_RESC(alA);
  }
  ATT_DMA_V(NT - 1, 1);
  SBAR(); ATT_QK(pB0, pB1, 1, NT - 1);
  ATT_FSM(pA0, pA1, alA, NT - 2); SBAR();
  if (NEED(NT - 2)) pv_d0(o, vb0, pa0, pa1, pa2, pa3);
  ATT_PSM(pB0, pB1, mnB, alB, NT - 1);
  ATT_LAND(); ATT_RESC(alB);
  ATT_FSM(pB0, pB1, alB, NT - 1); SBAR();
  if (NEED(NT - 1)) pv_d0(o, vb0 + SHM_V, pa0, pa1, pa2, pa3);
  if (hi == 0) li_l[r32] = l_reg;
  __syncthreads();
  { ALAS char* ost = lds + wid * 8704;
#pragma unroll
    for (int r = 0; r < 16; ++r) { const int orow = crow(r, hi); const float rl = __builtin_amdgcn_rcpf(li_l[orow]);
#pragma unroll
      for (int d0 = 0; d0 < 4; ++d0) *(ALAS unsigned short*)(ost + orow * 272 + (d0 * 32 + r32) * 2) = (unsigned short)(cvtpk(o[d0][r] * rl, 0.f) & 0xffffu); }
    asm volatile("s_waitcnt lgkmcnt(0)" ::: "memory");
    bf16_t* Ow = P.O + (size_t)(qtok0 + wid * 32) * 2048 + h * 128;
#pragma unroll
    for (int i = 0; i < 8; ++i) { const int c = lane + 64 * i, row = c >> 4, cc = c & 15;
      const u32x4 v = *(const ALAS u32x4*)(ost + row * 272 + cc * 16);
      *(u32x4*)(Ow + (size_t)row * 2048 + cc * 8) = v; } }
  __syncthreads();
#undef TILE_TOK
#undef NEED
#undef ATT_GLDS
#undef ATT_DMA_K
#undef ATT_DMA_V
#undef ATT_LAND
#undef ATT_QK
#undef ATT_PSM
#undef ATT_FSM
#undef ATT_RESC
}

__device__ __forceinline__ void sgu_mix_unit(ALAS char* lds, const bf16_t* UV, const float* stats, const float* ln_g, const float* ln_b, const bf16_t* WSB, const float* bs, bf16_t* O, int c, int g) {
  int tid_ = threadIdx.x; asm volatile("" : "+v"(tid_));
  const int tid = tid_, wid = __builtin_amdgcn_readfirstlane(tid >> 6), lane = tid & 63, r32 = lane & 31, hi = lane >> 5;
  const int sr = tid >> 4, sc = (tid & 15) * 8, tok0 = c * 128;
  float gc[8], bc[8];
  { const f32x4 g0 = *(const f32x4*)(ln_g + g * 128 + sc), g1 = *(const f32x4*)(ln_g + g * 128 + sc + 4), b0 = *(const f32x4*)(ln_b + g * 128 + sc), b1 = *(const f32x4*)(ln_b + g * 128 + sc + 4);
#pragma unroll
    for (int i = 0; i < 4; ++i) { gc[i] = g0[i]; gc[4 + i] = g1[i]; bc[i] = b0[i]; bc[4 + i] = b1[i]; } }
#pragma unroll
  for (int tl = 0; tl < 2; ++tl)
#pragma unroll
    for (int hf = 0; hf < 2; ++hf) { const int row = hf * 32 + sr, tok = tok0 + tl * 64 + row;
      const bf16x8 raw = *(const bf16x8*)(UV + (size_t)tok * 4096 + 2048 + g * 128 + sc);
      const float mu = stats[tok * 2] * (1.0f / 2048.0f), var_ = stats[tok * 2 + 1] * (1.0f / 2048.0f) - mu * mu, rstd = 1.0f / sqrtf((var_ > 0.f ? var_ : 0.f) + 1e-6f);
      unsigned w[4];
#pragma unroll
      for (int i = 0; i < 8; i += 2) { const float a = (bf2f(raw[i]) - mu) * rstd * gc[i] + bc[i], bq = (bf2f(raw[i + 1]) - mu) * rstd * gc[i + 1] + bc[i + 1]; w[i >> 1] = cvtpk(a, bq); }
      u32x4 ww = {w[0], w[1], w[2], w[3]};
      *(ALAS bf16x8*)(lds + tl * SHM_V + v_st(row, sc)) = __builtin_bit_cast(bf16x8, ww); }
  __syncthreads();
  const int wp = wid & 3, wd = wid >> 2;
  const bf16_t* Ap = WSB + ((size_t)g * 128 + 32 * wp + r32) * 128 + 8 * hi;
  f32x16 o0 = f32x16{}, o1 = f32x16{};
#pragma unroll
  for (int tl = 0; tl < 2; ++tl) {
    const bf16x8 pa0 = *(const bf16x8*)(Ap + tl * 64), pa1 = *(const bf16x8*)(Ap + tl * 64 + 16), pa2 = *(const bf16x8*)(Ap + tl * 64 + 32), pa3 = *(const bf16x8*)(Ap + tl * 64 + 48);
    const int vb = (int)(uintptr_t)(lds + tl * SHM_V) + v_rd_base(lane);
    if (wd == 0) { pv_one<0>(o0, vb, pa0, pa1, pa2, pa3); pv_one<1>(o1, vb, pa0, pa1, pa2, pa3); }
    else         { pv_one<2>(o0, vb, pa0, pa1, pa2, pa3); pv_one<3>(o1, vb, pa0, pa1, pa2, pa3); }
  }
  __syncthreads();
  { ALAS float* st = (ALAS float*)(lds + wid * 8448);
#pragma unroll
    for (int r = 0; r < 16; ++r) { const int pr = crow(r, hi); const float bsv = bs[g * 128 + 32 * wp + pr];
      st[pr * 66 + r32] = o0[r] + bsv; st[pr * 66 + 32 + r32] = o1[r] + bsv; }
    asm volatile("s_waitcnt lgkmcnt(0)" ::: "memory");
#pragma unroll
    for (int i = 0; i < 4; ++i) { const int c = lane + 64 * i, pr = c >> 3, cc = c & 7, tok = tok0 + 32 * wp + pr; const size_t col = (size_t)g * 128 + 64 * wd + 8 * cc;
      const ALAS float* sp = st + pr * 66 + 8 * cc;
      const u32x4 uw = *(const u32x4*)(UV + (size_t)tok * 4096 + col);
      const float m0 = sp[0], m1 = sp[1], m2 = sp[2], m3 = sp[3], m4 = sp[4], m5 = sp[5], m6 = sp[6], m7 = sp[7];
      u32x4 ow; ow.x = cvtpk(__uint_as_float(uw.x << 16) * m0, __uint_as_float(uw.x & 0xffff0000u) * m1); ow.y = cvtpk(__uint_as_float(uw.y << 16) * m2, __uint_as_float(uw.y & 0xffff0000u) * m3);
      ow.z = cvtpk(__uint_as_float(uw.z << 16) * m4, __uint_as_float(uw.z & 0xffff0000u) * m5); ow.w = cvtpk(__uint_as_float(uw.w << 16) * m6, __uint_as_float(uw.w & 0xffff0000u) * m7);
      *(u32x4*)(O + (size_t)tok * 2048 + col) = ow; } }
  __syncthreads();
}
#undef SBAR
}
#ifndef EN_MASK
#define EN_MASK 0x1ffff
#endif
#define EN(k) (((EN_MASK) >> (k)) & 1)
#ifndef REP_MASK
#define REP_MASK 0
#endif
#define REPS(k) ((((REP_MASK) >> (k)) & 1) ? 2 : 1)
constexpr int DM = 2048, NBATCH = 4, SEQ = 2048, DEPTH = 4, CTXL = 256;
constexpr int ML = NBATCH * SEQ, MC = NBATCH * CTXL, MT = ML + MC;
constexpr int DFF = 5632, DFF2 = 2 * DFF;
constexpr int NHEAD = 16;
constexpr int MLA_IN = 1088, MLA_INP = 1280, MLA_QN = 3072, MLA_KVN = 4096;
constexpr int SGU_N = 4096;
constexpr float EPS = 1e-6f;
constexpr int MODS_ROW = 6 * DM, MODS_LAYER = 5 * MODS_ROW;

enum { I_X = 0, I_C, I_CTX, I_CCTX, I_ADAW, I_ADAB, I_NORMG, I_FINALG, I_AQKV, I_AWO, I_ARPB, I_BWIN, I_BQN, I_BKVN, I_BUQ, I_BUKV, I_BWO,
       I_CWIN, I_CBIN, I_CLNG, I_CLNB, I_CWS, I_CBS, I_CWO, I_FWIN, I_FCW, I_FCB, I_FWOUT, N_IN };

constexpr size_t al256(size_t x) { return (x + 255) & ~(size_t)255; }
constexpr size_t WS_CTL = 0, CTL_ZERO_BYTES = 4u << 20;
constexpr size_t WS_MODS = 1u << 20;
static_assert(WS_MODS + (size_t)DEPTH * MODS_LAYER * 4 <= (2u << 20), "mods inside the zeroed region");
constexpr int B2_QKV = 0, B2_BIN = 2 * 5 * 6144, B2_CIN = B2_BIN + 5 * MLA_INP, B2_F1 = B2_CIN + 5 * SGU_N, B2_END = B2_F1 + 4 * 5 * DFF2;
constexpr size_t WS_BIAS2 = 2u << 20, WS_ROWSS = WS_BIAS2 + al256((size_t)B2_END * 4);
constexpr size_t WS_SGST = WS_ROWSS + al256((size_t)8 * MT * 4);
constexpr size_t WS_MLSS = WS_SGST + al256((size_t)MT * 2 * 4);
constexpr size_t WS_ZEROS = 262144;
static_assert(WS_MLSS + (size_t)2 * MT * 4 <= CTL_ZERO_BYTES && WS_ZEROS + 5 * 4096 * 4 <= WS_MODS, "zeroed-region map");
constexpr size_t WS_WT_QKV = CTL_ZERO_BYTES;
constexpr size_t WS_WT_AO  = WS_WT_QKV + al256((size_t)2 * 6144 * 2048 * 2);
constexpr size_t WS_WT_BIN = WS_WT_AO + al256((size_t)2 * 2048 * 2048 * 2);
constexpr size_t WS_WT_UQ  = WS_WT_BIN + al256((size_t)MLA_INP * 2048 * 2);
constexpr size_t WS_WT_UKV = WS_WT_UQ + al256((size_t)3072 * 512 * 2);
constexpr size_t WS_WT_BO  = WS_WT_UKV + al256((size_t)4096 * 512 * 2);
constexpr size_t WS_WT_CIN = WS_WT_BO + al256((size_t)2048 * 2048 * 2);
constexpr size_t WS_WT_CO  = WS_WT_CIN + al256((size_t)4096 * 2048 * 2);
constexpr size_t WS_WT_F1  = WS_WT_CO + al256((size_t)2048 * 2048 * 2);
constexpr size_t WS_WT_F2  = WS_WT_F1 + al256((size_t)4 * DFF2 * 2048 * 2);
constexpr size_t WS_WSB    = WS_WT_F2 + al256((size_t)4 * 2048 * DFF * 2);
constexpr size_t WS_X      = WS_WSB + al256((size_t)16 * 128 * 128 * 2);
constexpr size_t WS_H      = WS_X + al256((size_t)MT * DM * 4);
constexpr size_t WS_QKV    = WS_H + al256((size_t)MT * DM * 2);
constexpr size_t WS_KV     = WS_QKV + al256((size_t)MT * MLA_QN * 2);
constexpr size_t WS_CW     = WS_QKV + al256((size_t)MT * (MLA_QN + MLA_KVN) * 2);
constexpr size_t WS_CQN    = WS_CW + al256((size_t)MT * MLA_INP * 4);
constexpr size_t WS_CKVN   = WS_CQN + al256((size_t)MT * 512 * 2);
constexpr size_t WS_KPE    = WS_CKVN + al256((size_t)MT * 512 * 2);
constexpr size_t WS_STATS  = WS_KPE + al256((size_t)MT * 64 * 2);
constexpr size_t WS_O      = WS_STATS + al256((size_t)MT * 2 * 4);
constexpr size_t WS_U      = WS_O + al256((size_t)MT * DM * 2);
constexpr size_t WS_ACT    = WS_U + al256((size_t)MT * DFF2 * 2);
constexpr size_t WS_UE     = WS_ACT + al256((size_t)MT * DFF * 2);
constexpr size_t WS_SLAB   = WS_UE + al256((size_t)(MT / 64) * 4 * DFF2 * 2);
constexpr size_t WS_END    = WS_SLAB + al256((size_t)8 * MC * DM * 4);
static_assert((size_t)MT * 6144 * 2 <= (size_t)MT * (MLA_QN + MLA_KVN) * 2, "NA QKV fits the shared region");
constexpr int CW_BAR = 4096;

constexpr int NWAVES = 8, NTHREADS = 512;
constexpr int RING_BYTES = 131072, LDSCTL_OFF = RING_BYTES, MISC_OFF = LDSCTL_OFF + 320, LDS_BYTES = 147456;
static_assert(att::L_END <= RING_BYTES && pg8::STAGE_BYTES <= RING_BYTES, "phase scratch fits");

constexpr int STEPS_PER_LAYER = 11, STEP_L0 = 2, STEP_FINAL = STEP_L0 + DEPTH * STEPS_PER_LAYER, N_STEPS = STEP_FINAL + 1;
__host__ __device__ constexpr bool step_used(int kind, int s) { return kind == 0 ? (s != 3 && s != 4 && s != 5) : (kind == 2 ? (s != 2 && s != 4 && s != 5) : (s != 2 && s != 4)); }

struct Args { const float* in[N_IN]; float* out; unsigned char* ws; int step_lo, step_hi; };
static_assert(sizeof(Args) == N_IN * 8 + 8 + 8 + 8, "Args has no padding");

struct Frame {
    LAS unsigned char* lds;
    int tid, lane, wave, G, gw, NGW;
};

typedef LAS unsigned long long* ArgTab;
__device__ __forceinline__ const float* inp(ArgTab ap, int i) { const unsigned long long v = ap[i]; const unsigned lo = __builtin_amdgcn_readfirstlane((unsigned)v), hi = __builtin_amdgcn_readfirstlane((unsigned)(v >> 32)); return (const float*)(const GAS float*)(((unsigned long long)hi << 32) | lo); }
constexpr int AP_OUT = N_IN, AP_WS = N_IN + 1;
__device__ __forceinline__ unsigned char* wsp(ArgTab ap) { return (unsigned char*)inp(ap, AP_WS); }
__device__ __forceinline__ float shfl_xor_l(float v, int mask, int lane) { return __builtin_bit_cast(float, __builtin_amdgcn_ds_bpermute((lane ^ mask) << 2, __builtin_bit_cast(int, v))); }
__device__ __forceinline__ float wave_sum(float v, int lane) {
#pragma unroll
    for (int o = 1; o < 64; o <<= 1) v += shfl_xor_l(v, o, lane);
    return v;
}
__device__ __forceinline__ unsigned cvt_pk(float lo, float hi) { unsigned r; asm volatile("v_cvt_pk_bf16_f32 %0, %1, %2" : "=v"(r) : "v"(lo), "v"(hi)); return r; }
__device__ __forceinline__ float bf_lo(unsigned w) { return __uint_as_float(w << 16); }
__device__ __forceinline__ float bf_hi(unsigned w) { return __uint_as_float(w & 0xffff0000u); }

__device__ __forceinline__ void transpose_item(const float* W, int K, int N, bf16* WT, LAS unsigned* scr, int item, int lane, const LAS float* sh, float (&bs)[5], bool perm) {
    const int nblk = N / 64, kb = item / nblk, nb = item % nblk, k0 = 64 * kb, n0 = 64 * nb;
    const int nbg = nb >= 88 ? nb - 88 : nb, d0 = perm ? (nbg >> 1) * 256 + (nb >= 88 ? 128 : 0) + (nbg & 1) * 64 : n0;
    const float* src = W + (size_t)k0 * N + n0 + lane;
    float v[64];
#pragma unroll
    for (int i = 0; i < 64; ++i) v[i] = __builtin_nontemporal_load(src + (size_t)i * N);
    if (sh) {
#pragma unroll
        for (int b = 0; b < 5; ++b) { const LAS f32x4* sp = (const LAS f32x4*)(sh + b * 2048 + k0); float a = 0.f;
#pragma unroll
            for (int i = 0; i < 16; ++i) { const f32x4 q = sp[i]; a = fmaf(v[4 * i], q.x, a); a = fmaf(v[4 * i + 1], q.y, a); a = fmaf(v[4 * i + 2], q.z, a); a = fmaf(v[4 * i + 3], q.w, a); }
            bs[b] = a; }
    }
#pragma unroll
    for (int i = 0; i < 32; ++i) scr[i * 64 + (lane ^ i)] = cvt_pk(v[2 * i], v[2 * i + 1]);
    LDS_WAIT(); asm volatile("" ::: "memory");
    const int c = lane & 7;
#pragma unroll
    for (int j = 0; j < 8; ++j) { const int n = (lane >> 3) + 8 * j;
        v4u o; o.x = scr[(4 * c + 0) * 64 + (n ^ (4 * c + 0))]; o.y = scr[(4 * c + 1) * 64 + (n ^ (4 * c + 1))]; o.z = scr[(4 * c + 2) * 64 + (n ^ (4 * c + 2))]; o.w = scr[(4 * c + 3) * 64 + (n ^ (4 * c + 3))];
        *(v4u*)(WT + (size_t)(d0 + n) * K + k0 + 8 * c) = o; }
    LDS_WAIT(); asm volatile("" ::: "memory");
}
__device__ __forceinline__ void transpose_matrix(Frame& F, const float* W, int K, int N, bf16* WT, LAS unsigned* scr, int& it, const float* sh, float* b2, int ldb, int nranks, bool perm) {
    const int KG = K / 512, NB = N / 64, nsup = KG * NB;
    LAS float* red = (LAS float*)(F.lds + 65536);
    LAS float* shl = (LAS float*)(F.lds + 81920);
    if (sh) { for (int i = F.tid; i < 5 * 2048; i += NTHREADS) shl[i] = sh[(size_t)(i >> 11) * MODS_ROW + (i & 2047)]; __syncthreads(); }
    for (; it < nsup; it += nranks) { const int nb = it / KG, kg = (it % KG + nb) % KG; float bs[5] = {0.f, 0.f, 0.f, 0.f, 0.f};
        transpose_item(W, K, N, WT, scr, (kg * 8 + F.wave) * NB + nb, F.lane, sh ? shl : (const LAS float*)nullptr, bs, perm);
        if (sh) {
#pragma unroll
            for (int b = 0; b < 5; ++b) red[(F.wave * 5 + b) * 64 + F.lane] = bs[b];
            __syncthreads();
            if (F.tid < 320) { const int b = F.tid >> 6, l = F.tid & 63; float a = 0.f;
#pragma unroll
                for (int w = 0; w < 8; ++w) a += red[(w * 5 + b) * 64 + l];
                atomicAdd(b2 + (size_t)b * ldb + nb * 64 + l, pg8::qgrid<pg8::QG_BIAS2>(a)); }
            __syncthreads();
        } }
    it -= nsup;
}

__device__ __forceinline__ void helper_ada(Frame& F, ArgTab a, int rank, int nranks) {
    unsigned char* ws = wsp(a);
    LAS float* S = (LAS float*)F.lds;
    for (int i = F.tid; i < 5 * DM; i += NTHREADS) { const float v = i < 4 * DM ? inp(a, I_C)[i] : inp(a, I_CCTX)[i - 4 * DM]; S[i] = v / (1.f + __expf(-v)); }
    __syncthreads();
    float* mods = (float*)(ws + WS_MODS);
    constexpr int NCB = MODS_ROW / 256, NKC = DM / 128, NTASK = DEPTH * NCB * NKC;
    for (int tk = rank * NWAVES + F.wave; tk < NTASK; tk += nranks * NWAVES) {
        const int kc = tk % NKC, cb = (tk / NKC) % NCB, l = tk / (NKC * NCB);
        const int n = cb * 256 + F.lane * 4, k0 = kc * 128;
        const float* wp = inp(a, I_ADAW) + ((size_t)l * DM + k0) * MODS_ROW + n;
        f32x4 acc[5];
#pragma unroll
        for (int r = 0; r < 5; ++r) acc[r] = (f32x4){0.f, 0.f, 0.f, 0.f};
        for (int kb = 0; kb < 128; kb += 32) { f32x4 w[32];
#pragma unroll
          for (int k = 0; k < 32; ++k) w[k] = __builtin_nontemporal_load((const f32x4*)(wp + (size_t)(kb + k) * MODS_ROW));
#pragma unroll
          for (int k = 0; k < 32; ++k)
#pragma unroll
            for (int r = 0; r < 5; ++r) acc[r] = acc[r] + w[k] * S[r * DM + k0 + kb + k]; }
        if (kc == 0) { const f32x4 bv = *(const f32x4*)(inp(a, I_ADAB) + (size_t)l * MODS_ROW + n);
#pragma unroll
          for (int r = 0; r < 5; ++r) acc[r] = acc[r] + bv; }
#pragma unroll
        for (int r = 0; r < 5; ++r) { float* mp = mods + ((size_t)l * 5 + r) * MODS_ROW + n;
          atomicAdd(mp + 0, pg8::qgrid<pg8::QG_MODS>(acc[r].x)); atomicAdd(mp + 1, pg8::qgrid<pg8::QG_MODS>(acc[r].y)); atomicAdd(mp + 2, pg8::qgrid<pg8::QG_MODS>(acc[r].z)); atomicAdd(mp + 3, pg8::qgrid<pg8::QG_MODS>(acc[r].w)); }
    }
    __syncthreads();
}
__device__ __forceinline__ void helper_wsb(Frame& F, ArgTab a) {
    const int gt = F.gw * 64 + F.lane, NGT = F.NGW * 64;
    const float* wsf = inp(a, I_CWS); bf16* wsb = (bf16*)(wsp(a) + WS_WSB);
    for (int i = gt; i < 16 * 128 * 128 / 4; i += NGT) { const f32x4 v = *(const f32x4*)(wsf + (size_t)i * 4); uint2 o; o.x = cvt_pk(v.x, v.y); o.y = cvt_pk(v.z, v.w); *(uint2*)(wsb + (size_t)i * 4) = o; }
}
__device__ __forceinline__ void build_job_table(LAS unsigned char* lds, ArgTab a) {
    unsigned char* ws = wsp(a);
    LAS unsigned long long* tab = (LAS unsigned long long*)(lds + LDSCTL_OFF + 2048);
    { int e = 0; const float* md = (const float*)(ws + WS_MODS); float* b2 = (float*)(ws + WS_BIAS2);
#define TJOB(SRC, DST, KK, NN, SH, B2, LDB) do { tab[8 * e] = (unsigned long long)(SRC); tab[8 * e + 1] = (unsigned long long)(DST); tab[8 * e + 2] = (unsigned long long)(KK); tab[8 * e + 3] = (unsigned long long)(NN); \
        tab[8 * e + 4] = (unsigned long long)(SH); tab[8 * e + 5] = (unsigned long long)(B2); tab[8 * e + 6] = (unsigned long long)(LDB); ++e; } while (0)
        TJOB(inp(a, I_AQKV), ws + WS_WT_QKV, 2048, 6144, md, b2 + B2_QKV, 6144);
        TJOB(inp(a, I_AWO), ws + WS_WT_AO, 2048, 2048, 0, 0, 0);
        TJOB(inp(a, I_FWIN), ws + WS_WT_F1, 2048, DFF2, md + 3 * DM, b2 + B2_F1, DFF2);
        TJOB(inp(a, I_FWOUT), ws + WS_WT_F2, DFF, 2048, 0, 0, 0);
        TJOB(inp(a, I_BWIN), ws + WS_WT_BIN, 2048, MLA_IN, md + (size_t)1 * MODS_LAYER, b2 + B2_BIN, MLA_INP);
        TJOB(inp(a, I_BUQ), ws + WS_WT_UQ, 512, 3072, 0, 0, 0);
        TJOB(inp(a, I_BUKV), ws + WS_WT_UKV, 512, 4096, 0, 0, 0);
        TJOB(inp(a, I_BWO), ws + WS_WT_BO, 2048, 2048, 0, 0, 0);
        TJOB(inp(a, I_FWIN) + (size_t)1 * 2048 * DFF2, (bf16*)(ws + WS_WT_F1) + (size_t)1 * DFF2 * 2048, 2048, DFF2, md + (size_t)1 * MODS_LAYER + 3 * DM, b2 + B2_F1 + 1 * 5 * DFF2, DFF2);
        TJOB(inp(a, I_FWOUT) + (size_t)1 * DFF * 2048, (bf16*)(ws + WS_WT_F2) + (size_t)1 * 2048 * DFF, DFF, 2048, 0, 0, 0);
        TJOB(inp(a, I_CWIN), ws + WS_WT_CIN, 2048, 4096, md + (size_t)2 * MODS_LAYER, b2 + B2_CIN, SGU_N);
        TJOB(inp(a, I_CWO), ws + WS_WT_CO, 2048, 2048, 0, 0, 0);
        TJOB(inp(a, I_FWIN) + (size_t)2 * 2048 * DFF2, (bf16*)(ws + WS_WT_F1) + (size_t)2 * DFF2 * 2048, 2048, DFF2, md + (size_t)2 * MODS_LAYER + 3 * DM, b2 + B2_F1 + 2 * 5 * DFF2, DFF2);
        TJOB(inp(a, I_FWOUT) + (size_t)2 * DFF * 2048, (bf16*)(ws + WS_WT_F2) + (size_t)2 * 2048 * DFF, DFF, 2048, 0, 0, 0);
        TJOB(inp(a, I_AQKV) + (size_t)2048 * 6144, (bf16*)(ws + WS_WT_QKV) + (size_t)6144 * 2048, 2048, 6144, md + (size_t)3 * MODS_LAYER, b2 + B2_QKV + 5 * 6144, 6144);
        TJOB(inp(a, I_AWO) + (size_t)2048 * 2048, (bf16*)(ws + WS_WT_AO) + (size_t)2048 * 2048, 2048, 2048, 0, 0, 0);
        TJOB(inp(a, I_FWIN) + (size_t)3 * 2048 * DFF2, (bf16*)(ws + WS_WT_F1) + (size_t)3 * DFF2 * 2048, 2048, DFF2, md + (size_t)3 * MODS_LAYER + 3 * DM, b2 + B2_F1 + 3 * 5 * DFF2, DFF2);
        TJOB(inp(a, I_FWOUT) + (size_t)3 * DFF * 2048, (bf16*)(ws + WS_WT_F2) + (size_t)3 * 2048 * DFF, DFF, 2048, 0, 0, 0);
#undef TJOB
    }
}
__device__ __forceinline__ void helper_transposes(Frame& F, ArgTab a, unsigned mask, int rank, int nranks) {
    LAS unsigned long long* tab = (LAS unsigned long long*)(F.lds + LDSCTL_OFF + 2048);
    __syncthreads();
    LAS unsigned* scr = (LAS unsigned*)(F.lds + F.wave * 8192); int it = rank;
    for (int m = 0; m < 18; ++m) {
        if (!((mask >> m) & 1u)) continue;
        const float* src = inp((ArgTab)tab, 8 * m); bf16* dst = (bf16*)inp((ArgTab)tab, 8 * m + 1);
        const int KK = __builtin_amdgcn_readfirstlane((int)tab[8 * m + 2]), NN = __builtin_amdgcn_readfirstlane((int)tab[8 * m + 3]), LDB = __builtin_amdgcn_readfirstlane((int)tab[8 * m + 6]);
        const float* sh = inp((ArgTab)tab, 8 * m + 4); float* b2p = (float*)inp((ArgTab)tab, 8 * m + 5);
        transpose_matrix(F, src, KK, NN, dst, scr, it, sh, b2p, LDB, nranks, NN == DFF2); }
    __syncthreads();
}

__device__ __forceinline__ void phase_prep(Frame& F, ArgTab a, int layer, int which, int r0, int r1, const float* slab_gate) {
    bf16* X = (bf16*)(wsp(a) + WS_X); bf16* H = (bf16*)(wsp(a) + WS_H); const bf16* SL = (const bf16*)(wsp(a) + WS_SLAB);
    float* rowss = (float*)(wsp(a) + WS_ROWSS) + (size_t)(layer * 2 + which) * MT;
    const float* g = inp(a, I_NORMG) + ((size_t)layer * 2 + which) * DM;
    const float* md = (const float*)(wsp(a) + WS_MODS) + (size_t)layer * MODS_LAYER;
    const bool first = (layer == 0 && which == 0);
    for (int row = r0 + F.gw; row < r1; row += F.NGW) {
        const int bidx = row < ML ? (row >> 11) : 4;
        const float* scale = md + (size_t)bidx * MODS_ROW + (which * 3 + 1) * DM;
        bf16* xr = X + (size_t)row * DM + F.lane * 4;
        f32x4 v[8]; float ss = 0.f;
        if (first) {
            const float* ir = (row < ML ? inp(a, I_X) + (size_t)row * DM : inp(a, I_CTX) + (size_t)(row - ML) * DM) + F.lane * 4;
#pragma unroll
            for (int j = 0; j < 8; ++j) { v[j] = *(const f32x4*)(ir + 256 * j); uint2 o; o.x = pg8::pack_h2(v[j].x, v[j].y); o.y = pg8::pack_h2(v[j].z, v[j].w); *(uint2*)(xr + 256 * j) = o; }
        } else {
#pragma unroll
            for (int j = 0; j < 8; ++j) { const uint2 w = *(const uint2*)(xr + 256 * j); v[j] = (f32x4){pg8::h2_lo(w.x), pg8::h2_hi(w.x), pg8::h2_lo(w.y), pg8::h2_hi(w.y)}; }
        }
        if (slab_gate && row >= ML) {
            const bf16* sr = SL + (size_t)(row - ML) * DM + F.lane * 4;
#pragma unroll
            for (int j = 0; j < 8; ++j) { f32x4 t = (f32x4){0.f, 0.f, 0.f, 0.f};
#pragma unroll
                for (int s8 = 0; s8 < 8; ++s8) { const uint2 w = *(const uint2*)(sr + (size_t)s8 * MC * DM + 256 * j); t = t + (f32x4){bf_lo(w.x), bf_hi(w.x), bf_lo(w.y), bf_hi(w.y)}; }
                v[j] = v[j] + *(const f32x4*)(slab_gate + 256 * j + F.lane * 4) * t; { uint2 o; o.x = pg8::pack_h2(v[j].x, v[j].y); o.y = pg8::pack_h2(v[j].z, v[j].w); *(uint2*)(xr + 256 * j) = o; } }
        }
#pragma unroll
        for (int j = 0; j < 8; ++j) ss += (v[j].x * v[j].x + v[j].y * v[j].y) + (v[j].z * v[j].z + v[j].w * v[j].w);
        ss = wave_sum(ss, F.lane);
        if (F.lane == 0) rowss[row] = ss;
        bf16* hr = H + (size_t)row * DM + F.lane * 4;
#pragma unroll
        for (int j = 0; j < 8; ++j) { const int c = 256 * j + F.lane * 4;
            const f32x4 gg = *(const f32x4*)(g + c), sc = *(const f32x4*)(scale + c);
            const f32x4 h = v[j] * (gg * (sc + 1.f));
            uint2 o; o.x = cvt_pk(h.x, h.y); o.y = cvt_pk(h.z, h.w); *(uint2*)(hr + 256 * j) = o; }
    }
}
__device__ __forceinline__ void phase_prep_ctx(Frame& F, ArgTab a, int layer, int which, const float* slab_gate) {
    bf16* X = (bf16*)(wsp(a) + WS_X); bf16* H = (bf16*)(wsp(a) + WS_H); const bf16* SL = (const bf16*)(wsp(a) + WS_SLAB);
    float* rowss = (float*)(wsp(a) + WS_ROWSS) + (size_t)(layer * 2 + which) * MT;
    const float* g = inp(a, I_NORMG) + ((size_t)layer * 2 + which) * DM;
    const float* scale = (const float*)(wsp(a) + WS_MODS) + (size_t)layer * MODS_LAYER + (size_t)4 * MODS_ROW + (which * 3 + 1) * DM;
    for (int tk = F.gw; tk < 2 * MC; tk += F.NGW) {
        const int row = ML + (tk >> 1), c0 = (tk & 1) * 1024 + F.lane * 4;
        bf16* xr = X + (size_t)row * DM + c0; const bf16* sr = SL + (size_t)(row - ML) * DM + c0;
        f32x4 v[4]; float ss = 0.f;
#pragma unroll
        for (int j = 0; j < 4; ++j) { const uint2 w = *(const uint2*)(xr + 256 * j); v[j] = (f32x4){pg8::h2_lo(w.x), pg8::h2_hi(w.x), pg8::h2_lo(w.y), pg8::h2_hi(w.y)}; }
#pragma unroll
        for (int j = 0; j < 4; ++j) { f32x4 t = (f32x4){0.f, 0.f, 0.f, 0.f};
#pragma unroll
            for (int s8 = 0; s8 < 8; ++s8) { const uint2 w = *(const uint2*)(sr + (size_t)s8 * MC * DM + 256 * j); t = t + (f32x4){bf_lo(w.x), bf_hi(w.x), bf_lo(w.y), bf_hi(w.y)}; }
            v[j] = v[j] + *(const f32x4*)(slab_gate + c0 + 256 * j) * t; { uint2 o; o.x = pg8::pack_h2(v[j].x, v[j].y); o.y = pg8::pack_h2(v[j].z, v[j].w); *(uint2*)(xr + 256 * j) = o; }
            ss += (v[j].x * v[j].x + v[j].y * v[j].y) + (v[j].z * v[j].z + v[j].w * v[j].w); }
        ss = wave_sum(ss, F.lane);
        if (F.lane == 0) atomicAdd(rowss + row, pg8::qgrid<pg8::QG_ROWSS>(ss));
        bf16* hr = H + (size_t)row * DM + c0;
#pragma unroll
        for (int j = 0; j < 4; ++j) { const f32x4 gg = *(const f32x4*)(g + c0 + 256 * j), sc = *(const f32x4*)(scale + c0 + 256 * j);
            const f32x4 h = v[j] * (gg * (sc + 1.f));
            uint2 o; o.x = cvt_pk(h.x, h.y); o.y = cvt_pk(h.z, h.w); *(uint2*)(hr + 256 * j) = o; }
    }
}
__device__ __forceinline__ void phase_final(Frame& F, ArgTab a) {
    const bf16* X = (const bf16*)(wsp(a) + WS_X); const float* g = inp(a, I_FINALG); float* out = (float*)inp(a, AP_OUT);
    for (int base = F.gw; base < ML; base += 4 * F.NGW) {
        f32x4 v[4][8];
#pragma unroll
        for (int k = 0; k < 4; ++k) { const int row = base + k * F.NGW; const bf16* xr = X + (size_t)(row < ML ? row : base) * DM + F.lane * 4;
#pragma unroll
            for (int j = 0; j < 8; ++j) { const uint2 w = *(const uint2*)(xr + 256 * j); v[k][j] = (f32x4){pg8::h2_lo(w.x), pg8::h2_hi(w.x), pg8::h2_lo(w.y), pg8::h2_hi(w.y)}; } }
#pragma unroll
        for (int k = 0; k < 4; ++k) { const int row = base + k * F.NGW; float ss = 0.f;
#pragma unroll
            for (int j = 0; j < 8; ++j) ss += (v[k][j].x * v[k][j].x + v[k][j].y * v[k][j].y) + (v[k][j].z * v[k][j].z + v[k][j].w * v[k][j].w);
            const float rstd = 1.f / sqrtf(wave_sum(ss, F.lane) * (1.f / DM) + EPS);
            if (row < ML) { float* orow = out + (size_t)row * DM + F.lane * 4;
#pragma unroll
                for (int j = 0; j < 8; ++j) { const f32x4 gg = *(const f32x4*)(g + 256 * j + F.lane * 4); *(f32x4*)(orow + 256 * j) = (v[k][j] * rstd) * gg; } } }
    }
}
__device__ __forceinline__ void phase_mla_norm(Frame& F, ArgTab a) {
    const float* CW = (const float*)(wsp(a) + WS_CW); bf16* CQN = (bf16*)(wsp(a) + WS_CQN); bf16* CKVN = (bf16*)(wsp(a) + WS_CKVN); bf16* KPE = (bf16*)(wsp(a) + WS_KPE);
    const float* qn = inp(a, I_BQN); const float* kn = inp(a, I_BKVN);
    for (int row = F.gw; row < MT; row += F.NGW) {
        const float* r = CW + (size_t)row * MLA_INP;
        const f32x4 q0 = *(const f32x4*)(r + F.lane * 8), q1 = *(const f32x4*)(r + F.lane * 8 + 4), k0 = *(const f32x4*)(r + 512 + F.lane * 8), k1 = *(const f32x4*)(r + 512 + F.lane * 8 + 4);
        const float pe = r[1024 + F.lane];
        float sq = (q0.x * q0.x + q0.y * q0.y) + (q0.z * q0.z + q0.w * q0.w) + (q1.x * q1.x + q1.y * q1.y) + (q1.z * q1.z + q1.w * q1.w);
        float sk = (k0.x * k0.x + k0.y * k0.y) + (k0.z * k0.z + k0.w * k0.w) + (k1.x * k1.x + k1.y * k1.y) + (k1.z * k1.z + k1.w * k1.w);
        const float rq = 1.f / sqrtf(wave_sum(sq, F.lane) * (1.f / 512.f) + EPS), rk = 1.f / sqrtf(wave_sum(sk, F.lane) * (1.f / 512.f) + EPS);
        const f32x4 gq0 = *(const f32x4*)(qn + F.lane * 8), gq1 = *(const f32x4*)(qn + F.lane * 8 + 4), gk0 = *(const f32x4*)(kn + F.lane * 8), gk1 = *(const f32x4*)(kn + F.lane * 8 + 4);
        const f32x4 a0 = (q0 * rq) * gq0, a1 = (q1 * rq) * gq1, b0 = (k0 * rk) * gk0, b1 = (k1 * rk) * gk1;
        v4u o; o.x = cvt_pk(a0.x, a0.y); o.y = cvt_pk(a0.z, a0.w); o.z = cvt_pk(a1.x, a1.y); o.w = cvt_pk(a1.z, a1.w);
        *(v4u*)(CQN + (size_t)row * 512 + F.lane * 8) = o;
        o.x = cvt_pk(b0.x, b0.y); o.y = cvt_pk(b0.z, b0.w); o.z = cvt_pk(b1.x, b1.y); o.w = cvt_pk(b1.z, b1.w);
        *(v4u*)(CKVN + (size_t)row * 512 + F.lane * 8) = o;
        float outv = pe;
        const float partner = shfl_xor_l(pe, 16, F.lane);
        if (row < ML) { const int t = row & (SEQ - 1), pos = (F.lane >> 5) ? (t & 63) : (t >> 6), j = F.lane & 15;
            const float cs = att::g_rope.c[pos * 16 + j], sn = att::g_rope.s[pos * 16 + j];
            outv = ((F.lane >> 4) & 1) ? (partner * sn + pe * cs) : (pe * cs - partner * sn); }
        KPE[(size_t)row * 64 + F.lane] = (bf16)(cvt_pk(outv, 0.f) & 0xffffu);
    }
}
__device__ __forceinline__ void phase_sgu_stats(Frame& F, ArgTab a) {
    const bf16* UV = (const bf16*)(wsp(a) + WS_QKV); float* st = (float*)(wsp(a) + WS_STATS);
    for (int row = F.gw; row < MT; row += F.NGW) {
        const bf16* r = UV + (size_t)row * SGU_N + 2048 + F.lane * 8;
        float v[32]; float s = 0.f;
#pragma unroll
        for (int j = 0; j < 4; ++j) { const v4u w = *(const v4u*)(r + 512 * j);
            v[8 * j + 0] = bf_lo(w.x); v[8 * j + 1] = bf_hi(w.x); v[8 * j + 2] = bf_lo(w.y); v[8 * j + 3] = bf_hi(w.y); v[8 * j + 4] = bf_lo(w.z); v[8 * j + 5] = bf_hi(w.z); v[8 * j + 6] = bf_lo(w.w); v[8 * j + 7] = bf_hi(w.w); }
#pragma unroll
        for (int i = 0; i < 32; ++i) s += v[i];
        const float mean = wave_sum(s, F.lane) * (1.f / 2048.f); float q = 0.f;
#pragma unroll
        for (int i = 0; i < 32; ++i) { const float d = v[i] - mean; q += d * d; }
        const float rstd = 1.f / sqrtf(wave_sum(q, F.lane) * (1.f / 2048.f) + EPS);
        if (F.lane == 0) { st[row * 2] = mean; st[row * 2 + 1] = rstd; }
    }
}
__device__ __forceinline__ void phase_conv_fix(Frame& F, ArgTab a, int layer, int nrows) {
    const bf16* UE = (const bf16*)(wsp(a) + WS_UE); bf16* ACT = (bf16*)(wsp(a) + WS_ACT);
    const float* cw = inp(a, I_FCW) + (size_t)layer * 3 * DFF2; const float* cb = inp(a, I_FCB) + (size_t)layer * DFF2;
    const int ntask = (nrows / 64) * 2 * 11;
    for (int tk = F.gw; tk < ntask; tk += F.NGW) {
        const int cbk = tk % 11, er = tk / 11, blk = er >> 1, which = er & 1, t = 64 * blk + (which ? 63 : 0), j0 = cbk * 512 + F.lane * 8;
        const bool first = t < ML ? ((t & (SEQ - 1)) == 0) : (((t - ML) & (CTXL - 1)) == 0), lastr = t < ML ? ((t & (SEQ - 1)) == SEQ - 1) : (((t - ML) & (CTXL - 1)) == CTXL - 1);
        const v4u zero = {0u, 0u, 0u, 0u};
        const bf16* pc = UE + ((size_t)blk * 4 + (which ? 3 : 0)) * DFF2 + j0;
        const v4u ca = *(const v4u*)pc, cg = *(const v4u*)(pc + DFF);
        v4u pa = zero, pg = zero, na = zero, ng = zero;
        if (which) { const bf16* pp = UE + ((size_t)blk * 4 + 2) * DFF2 + j0; pa = *(const v4u*)pp; pg = *(const v4u*)(pp + DFF);
                     if (!lastr) { const bf16* pn = UE + ((size_t)(blk + 1) * 4 + 0) * DFF2 + j0; na = *(const v4u*)pn; ng = *(const v4u*)(pn + DFF); } }
        else       { const bf16* pn = UE + ((size_t)blk * 4 + 1) * DFF2 + j0; na = *(const v4u*)pn; ng = *(const v4u*)(pn + DFF);
                     if (!first) { const bf16* pp = UE + ((size_t)(blk - 1) * 4 + 3) * DFF2 + j0; pa = *(const v4u*)pp; pg = *(const v4u*)(pp + DFF); } }
        const unsigned pav[4] = {pa.x, pa.y, pa.z, pa.w}, cav[4] = {ca.x, ca.y, ca.z, ca.w}, nav[4] = {na.x, na.y, na.z, na.w};
        const unsigned pgv[4] = {pg.x, pg.y, pg.z, pg.w}, cgv[4] = {cg.x, cg.y, cg.z, cg.w}, ngv[4] = {ng.x, ng.y, ng.z, ng.w};
        float wa[3][8], wg[3][8], ba[8], bg[8];
#pragma unroll
        for (int k = 0; k < 3; ++k)
#pragma unroll
            for (int h = 0; h < 2; ++h) { const f32x4 x = *(const f32x4*)(cw + (size_t)k * DFF2 + j0 + 4 * h), y = *(const f32x4*)(cw + (size_t)k * DFF2 + DFF + j0 + 4 * h);
                wa[k][4 * h] = x.x; wa[k][4 * h + 1] = x.y; wa[k][4 * h + 2] = x.z; wa[k][4 * h + 3] = x.w; wg[k][4 * h] = y.x; wg[k][4 * h + 1] = y.y; wg[k][4 * h + 2] = y.z; wg[k][4 * h + 3] = y.w; }
#pragma unroll
        for (int h = 0; h < 2; ++h) { const f32x4 x = *(const f32x4*)(cb + j0 + 4 * h), y = *(const f32x4*)(cb + DFF + j0 + 4 * h);
            ba[4 * h] = x.x; ba[4 * h + 1] = x.y; ba[4 * h + 2] = x.z; ba[4 * h + 3] = x.w; bg[4 * h] = y.x; bg[4 * h + 1] = y.y; bg[4 * h + 2] = y.z; bg[4 * h + 3] = y.w; }
        unsigned ow[4];
#pragma unroll
        for (int e = 0; e < 4; ++e) {
            const float a0 = wa[0][2 * e] * bf_lo(pav[e]) + wa[1][2 * e] * bf_lo(cav[e]) + wa[2][2 * e] * bf_lo(nav[e]) + ba[2 * e];
            const float a1 = wa[0][2 * e + 1] * bf_hi(pav[e]) + wa[1][2 * e + 1] * bf_hi(cav[e]) + wa[2][2 * e + 1] * bf_hi(nav[e]) + ba[2 * e + 1];
            const float g0 = wg[0][2 * e] * bf_lo(pgv[e]) + wg[1][2 * e] * bf_lo(cgv[e]) + wg[2][2 * e] * bf_lo(ngv[e]) + bg[2 * e];
            const float g1 = wg[0][2 * e + 1] * bf_hi(pgv[e]) + wg[1][2 * e + 1] * bf_hi(cgv[e]) + wg[2][2 * e + 1] * bf_hi(ngv[e]) + bg[2 * e + 1];
            const float s0 = g0 * __builtin_amdgcn_rcpf(1.f + __builtin_amdgcn_exp2f(-1.4426950408889634f * g0));
            const float s1 = g1 * __builtin_amdgcn_rcpf(1.f + __builtin_amdgcn_exp2f(-1.4426950408889634f * g1));
            ow[e] = cvt_pk(a0 * s0, a1 * s1); }
        v4u o = {ow[0], ow[1], ow[2], ow[3]};
        *(v4u*)(ACT + (size_t)t * DFF + j0) = o;
    }
}

__global__ void __launch_bounds__(NTHREADS, 2) fwd_kernel(Args args) {
    extern __shared__ __attribute__((aligned(16))) unsigned char lds_raw[];
#define MKFRAME() Frame F; { int t_ = threadIdx.x; asm volatile("" : "+v"(t_)); F.lds = (LAS unsigned char*)lds_raw; F.tid = t_; F.lane = t_ & 63; F.wave = __builtin_amdgcn_readfirstlane(t_ >> 6); \
      F.G = gridDim.x; F.gw = blockIdx.x * NWAVES + F.wave; F.NGW = F.G * NWAVES; }
    LAS unsigned char* const lds0 = (LAS unsigned char*)lds_raw; const int G = gridDim.x;
    volatile LAS unsigned* MISC = (volatile LAS unsigned*)(lds0 + MISC_OFF);
    for (int u = threadIdx.x; u < (LDS_BYTES - LDSCTL_OFF) / 4; u += NTHREADS) ((LAS unsigned*)(lds0 + LDSCTL_OFF))[u] = 0u;
    __syncthreads();
    const int lo = args.step_lo, hi = args.step_hi;
    const ArgTab AP = (ArgTab)(lds0 + LDSCTL_OFF + 1024);
    if (threadIdx.x == 0) {
#pragma unroll
        for (int i = 0; i < N_IN; ++i) AP[i] = (unsigned long long)args.in[i];
        AP[AP_OUT] = (unsigned long long)args.out; AP[AP_WS] = (unsigned long long)args.ws; }
    __syncthreads();
    if (threadIdx.x == 0) build_job_table(lds0, AP);
    __syncthreads();
    const bool multi = (hi - lo) > 1;
    if (multi) { const XcdBarrier b0 = xcd_barrier_post((unsigned*)(wsp(AP) + WS_CTL) + CW_BAR, MISC + 8); if (threadIdx.x == 0) MISC[10] = b0.x; }
#define IN(k) (lo <= (k) && (k) < hi)
#define SEAM(k) do { if ((k) + 1 < hi) { XcdBarrier bar_; bar_.bar = (unsigned*)(wsp(AP) + WS_CTL) + CW_BAR; bar_.x = MISC[10]; bar_.st = MISC + 8; xcd_barrier(bar_); } } while (0)
#define SITE_WS() unsigned char* const ws = wsp(AP)
#define SPLIT_BEGIN(UNITS, DO_HELP, ADA_L, MASK) \
        const int rnd_ = ((UNITS) + G - 1) / G, need_ = ((UNITS) + rnd_ - 1) / rnd_; const bool spare_ = (DO_HELP) && need_ < G; const int NACT_ = spare_ ? need_ : G; \
        if ((DO_HELP) && (!spare_ || (int)blockIdx.x >= NACT_)) { MKFRAME(); helper_transposes(F, AP, (MASK), spare_ ? (int)blockIdx.x - NACT_ : (int)blockIdx.x, spare_ ? G - NACT_ : G); } \
        if ((int)blockIdx.x < NACT_)
#define H ((bf16*)(ws + WS_H))
#define QKV ((bf16*)(ws + WS_QKV))
#define OB ((bf16*)(ws + WS_O))
#define UB ((bf16*)(ws + WS_U))
#define ACT ((bf16*)(ws + WS_ACT))
#define X ((bf16*)(ws + WS_X))
#define mods ((const float*)(ws + WS_MODS) + (size_t)layer * MODS_LAYER)
#define RSS(w) ((const float*)(ws + WS_ROWSS) + (size_t)(layer * 2 + (w)) * MT)
    LAS unsigned char* const ring = lds0;

    if (EN(0) && IN(0)) { MKFRAME(); helper_wsb(F, AP); helper_ada(F, AP, (int)blockIdx.x, G); SEAM(0); }
    if (EN(0) && IN(1)) { MKFRAME(); helper_transposes(F, AP, 0x200Fu, (int)blockIdx.x, G); phase_prep(F, AP, 0, 0, 0, MT, nullptr); SEAM(1); }

    for (int layer = 0; layer < DEPTH; ++layer) {
        const int kind = layer % 3, jm = layer / 3, sb = STEP_L0 + layer * STEPS_PER_LAYER;
        const bool last = layer == DEPTH - 1;
#ifdef PROBE_SLEEP_TICKS
        { const unsigned long long t0_ = __builtin_amdgcn_s_memrealtime(); while (__builtin_amdgcn_s_memrealtime() - t0_ < PROBE_SLEEP_TICKS) __builtin_amdgcn_s_sleep(32); }
#endif
        const int mrows = last ? ML : MT;
        if (EN(1) && layer > 0 && IN(sb + 0)) { MKFRAME(); phase_prep_ctx(F, AP, layer, 0, (const float*)(wsp(AP) + WS_MODS) + (size_t)(layer - 1) * MODS_LAYER + 4 * MODS_ROW + 5 * DM); SEAM(sb + 0); }
        if (kind == 0) {
            if (EN(2) && IN(sb + 1)) { for (int rep_ = 0; rep_ < REPS(2); ++rep_) { SITE_WS(); SPLIT_BEGIN((MT / 256) * (6144 / 256), !last, -1, 0x2F0u) {
                pg8::Gemm g{H, (const bf16*)(ws + WS_WT_QKV) + (size_t)jm * 6144 * 2048, MT, 6144, 2048}; pg8::StaticOrder S; S.init(MT, 6144, NACT_, (int)blockIdx.x);
                pg8::EpiNormBf16<0> E{QKV, 6144, nullptr, RSS(0), (const float*)(ws + WS_BIAS2) + B2_QKV + jm * 5 * 6144, 6144};
                pg8::gemm_phase<pg8::EpiNormBf16<0>, pg8::StaticOrder, true, true>(ring, g, S, E); } SEAM(sb + 1); } }
            if (EN(3) && IN(sb + 2)) { for (int rep_ = 0; rep_ < REPS(3); ++rep_) { SITE_WS(); att::AttnP P{QKV, QKV + 2048, QKV + 4096, nullptr, OB, inp(AP, I_ARPB) + (size_t)jm * 16 * 465};
                const int nun = last ? 512 : 576;
                for (int u = blockIdx.x; u < nun; u += G) { if (u < 512) { const int x_ = u & 7, s_ = u >> 3, bh_ = x_ + 8 * (s_ >> 3); att::attn_unit<0>((LAS char*)ring, P, bh_ >> 4, bh_ & 15, s_ & 7, false); } else att::attn_unit<0>((LAS char*)ring, P, (u - 512) >> 4, (u - 512) & 15, 0, true); }
                SEAM(sb + 2); } }
        } else if (kind == 1) {
            if (EN(4) && IN(sb + 1)) { for (int rep_ = 0; rep_ < REPS(4); ++rep_) { SITE_WS(); SPLIT_BEGIN((MT / 256) * (MLA_INP / 256), true, -1, 0xC00u) {
                pg8::Gemm g{H, (const bf16*)(ws + WS_WT_BIN), MT, MLA_INP, 2048}; pg8::StaticOrder S; S.init(MT, MLA_INP, NACT_, (int)blockIdx.x);
                pg8::EpiMlaIn E{RSS(0), (const float*)(ws + WS_BIAS2) + B2_BIN, MLA_INP, inp(AP, I_BQN), inp(AP, I_BKVN), (bf16*)(ws + WS_CQN), (bf16*)(ws + WS_CKVN), (bf16*)(ws + WS_KPE),
                                (float*)(ws + WS_MLSS), (float*)(ws + WS_MLSS) + MT, att::g_rope.c, att::g_rope.s};
                pg8::gemm_phase<pg8::EpiMlaIn, pg8::StaticOrder, true, true>(ring, g, S, E); } SEAM(sb + 1); } }
            if (EN(6) && IN(sb + 3)) { for (int rep_ = 0; rep_ < REPS(6); ++rep_) { SITE_WS();
                pg8::Gemm g{(const bf16*)(ws + WS_CQN), (const bf16*)(ws + WS_WT_UQ), MT, MLA_QN, 512, (const bf16*)(ws + WS_CKVN), (const bf16*)(ws + WS_WT_UKV)};
                pg8::DualOrder S; S.init(MT, MLA_QN, MLA_KVN, G, (int)blockIdx.x);
                pg8::EpiMlaUp E{QKV, MLA_QN, (const float*)(ws + WS_MLSS), (bf16*)(ws + WS_KV), MLA_KVN, (const float*)(ws + WS_MLSS) + MT};
                pg8::gemm_phase<pg8::EpiMlaUp, pg8::DualOrder, true, true>(ring, g, S, E);
                SEAM(sb + 3); } }
            if (EN(7) && IN(sb + 5)) { for (int rep_ = 0; rep_ < REPS(7); ++rep_) { SITE_WS(); const bf16* KV = (const bf16*)(ws + WS_KV);
                att::AttnP P{QKV, KV, KV + 128, (const bf16*)(ws + WS_KPE), OB, nullptr};
                for (int u = blockIdx.x; u < 576; u += G) { if (u < 512) { const int x_ = u & 7, s_ = u >> 3, bh_ = x_ + 8 * (s_ >> 3); att::attn_unit<1>((LAS char*)ring, P, bh_ >> 4, bh_ & 15, s_ & 7, false); } else att::attn_unit<1>((LAS char*)ring, P, (u - 512) >> 4, (u - 512) & 15, 0, true); }
                SEAM(sb + 5); } }
        } else {
            if (EN(8) && IN(sb + 1)) { for (int rep_ = 0; rep_ < REPS(8); ++rep_) { SITE_WS(); SPLIT_BEGIN((MT / 256) * (SGU_N / 256), true, -1, 0x2C000u) {
                pg8::Gemm g{H, (const bf16*)(ws + WS_WT_CIN), MT, SGU_N, 2048}; pg8::StaticOrder S; S.init(MT, SGU_N, NACT_, (int)blockIdx.x);
                pg8::EpiSguIn E{QKV, SGU_N, inp(AP, I_CBIN), RSS(0), (const float*)(ws + WS_BIAS2) + B2_CIN, SGU_N, (float*)(ws + WS_SGST), 2048};
                pg8::gemm_phase<pg8::EpiSguIn, pg8::StaticOrder, true, true>(ring, g, S, E); } SEAM(sb + 1); } }
            if (EN(10) && IN(sb + 3)) { for (int rep_ = 0; rep_ < REPS(10); ++rep_) { SITE_WS(); for (int u = blockIdx.x; u < 72 * 16; u += G)
                    att::sgu_mix_unit((LAS char*)ring, QKV, (const float*)(ws + WS_SGST), inp(AP, I_CLNG), inp(AP, I_CLNB), (const bf16*)(ws + WS_WSB), inp(AP, I_CBS), OB, u >> 4, u & 15);
                SEAM(sb + 3); } }
        }
        if (EN(11) && IN(sb + 6)) { for (int rep_ = 0; rep_ < REPS(11); ++rep_) { SITE_WS(); const bf16* wt = kind == 0 ? (const bf16*)(ws + WS_WT_AO) + (size_t)jm * 2048 * 2048 : (kind == 1 ? (const bf16*)(ws + WS_WT_BO) : (const bf16*)(ws + WS_WT_CO));
            pg8::Gemm g{OB, wt, mrows, DM, DM}; pg8::ResOrder S; S.init(mrows, DM, DM, G, (int)blockIdx.x);
            pg8::EpiResN E{X, DM, mods, 2 * DM, (bf16*)(ws + WS_SLAB), H, inp(AP, I_NORMG) + ((size_t)layer * 2 + 1) * DM, mods + 4 * DM, (float*)(ws + WS_ROWSS) + (size_t)(layer * 2 + 1) * MT};
            pg8::gemm_phase<pg8::EpiResN, pg8::ResOrder, true, true>(ring, g, S, E); SEAM(sb + 6); } }
        if (EN(1) && !last && IN(sb + 7)) { MKFRAME(); phase_prep_ctx(F, AP, layer, 1, (const float*)(wsp(AP) + WS_MODS) + (size_t)layer * MODS_LAYER + 4 * MODS_ROW + 2 * DM); SEAM(sb + 7); }
        if (EN(12) && IN(sb + 8)) { for (int rep_ = 0; rep_ < REPS(12); ++rep_) { SITE_WS(); SPLIT_BEGIN((mrows / 256) * (DFF2 / 256), !last, -1, layer == 0 ? 0x100u : (layer == 1 ? 0x1000u : 0x10000u)) {
            pg8::Gemm g{H, (const bf16*)(ws + WS_WT_F1) + (size_t)layer * DFF2 * 2048, mrows, DFF2, 2048}; pg8::StaticOrder S; S.init(mrows, DFF2, NACT_, (int)blockIdx.x);
            pg8::EpiConvF1 E{ACT, RSS(1), (const float*)(ws + WS_BIAS2) + B2_F1 + layer * 5 * DFF2, inp(AP, I_FCW) + (size_t)layer * 3 * DFF2, inp(AP, I_FCB) + (size_t)layer * DFF2, (bf16*)(ws + WS_UE)};
            pg8::gemm_phase<pg8::EpiConvF1, pg8::StaticOrder, true, true>(ring, g, S, E); } SEAM(sb + 8); } }
        if (EN(13) && IN(sb + 9)) { for (int rep_ = 0; rep_ < REPS(13); ++rep_) { MKFRAME(); phase_conv_fix(F, AP, layer, mrows); SEAM(sb + 9); } }
        if (EN(14) && IN(sb + 10)) { for (int rep_ = 0; rep_ < REPS(14); ++rep_) { SITE_WS(); pg8::Gemm g{ACT, (const bf16*)(ws + WS_WT_F2) + (size_t)layer * 2048 * DFF, mrows, DM, DFF}; pg8::ResOrder S; S.init(mrows, DM, DFF, G, (int)blockIdx.x);
            pg8::EpiResN E{X, DM, mods, 5 * DM, (bf16*)(ws + WS_SLAB), last ? (bf16*)nullptr : H, inp(AP, I_NORMG) + ((size_t)(last ? layer : layer + 1) * 2) * DM, mods + (last ? 0 : MODS_LAYER) + 1 * DM, (float*)(ws + WS_ROWSS) + (size_t)((last ? layer : layer + 1) * 2) * MT};
            pg8::gemm_phase<pg8::EpiResN, pg8::ResOrder, true, true>(ring, g, S, E); SEAM(sb + 10); } }
    }
    if (EN(15) && IN(STEP_FINAL)) {
#ifdef PROBE_BARRIERS
        for (int pb_ = 0; pb_ < PROBE_BARRIERS; ++pb_) { XcdBarrier bar_; bar_.bar = (unsigned*)(wsp(AP) + WS_CTL) + CW_BAR; bar_.x = MISC[10]; bar_.st = MISC + 8; xcd_barrier(bar_); }
#endif
        MKFRAME(); phase_final(F, AP); }
#undef IN
#undef SEAM
#undef SITE_WS
#undef SPLIT_BEGIN
#undef H
#undef QKV
#undef OB
#undef UB
#undef ACT
#undef X
#undef mods
#undef RSS
}

#ifndef MK_ONE_LAUNCH
#define MK_ONE_LAUNCH 1
#endif
extern "C" void kernel_launch(void* const* d_in, const int* in_sizes, int n_in, void* d_out, int out_size, void* d_ws, size_t ws_size, hipStream_t stream) {
    static int grid = 0;
    if (grid == 0) {
        if (n_in != N_IN || out_size != ML * DM || ws_size < WS_END) { fprintf(stderr, "kernel_launch: unexpected shapes: n_in %d out %d ws %zu (need %zu)\n", n_in, out_size, ws_size, (size_t)WS_END); grid = -1; return; }
        int dev = 0, cus = 0, per_cu = 0;
        if (hipGetDevice(&dev) != hipSuccess || hipDeviceGetAttribute(&cus, hipDeviceAttributeMultiprocessorCount, dev) != hipSuccess) { grid = -1; return; }
        if (hipFuncSetAttribute((const void*)fwd_kernel, hipFuncAttributeMaxDynamicSharedMemorySize, LDS_BYTES) != hipSuccess) { fprintf(stderr, "kernel_launch: hipFuncSetAttribute failed\n"); grid = -1; return; }
        if (hipOccupancyMaxActiveBlocksPerMultiprocessor(&per_cu, (const void*)fwd_kernel, NTHREADS, LDS_BYTES) != hipSuccess || per_cu < 1) { fprintf(stderr, "kernel_launch: occupancy query says %d\n", per_cu); }
        (void)hipGetLastError();
        grid = cus;
    }
    if (grid < 0) return;
    if (hipMemsetAsync((char*)d_ws + WS_CTL, 0, CTL_ZERO_BYTES, stream) != hipSuccess) return;
    Args ka{};
    for (int i = 0; i < N_IN; ++i) ka.in[i] = (const float*)d_in[i];
    ka.out = (float*)d_out; ka.ws = (unsigned char*)d_ws;
#if MK_ONE_LAUNCH
    ka.step_lo = 0; ka.step_hi = N_STEPS;
    hipLaunchKernelGGL(fwd_kernel, dim3(grid), dim3(NTHREADS), LDS_BYTES, stream, ka);
#else
    for (int s = 0; s < N_STEPS; ++s) {
        if (s >= STEP_L0 && s < STEP_FINAL) { const int layer = (s - STEP_L0) / STEPS_PER_LAYER, slot = (s - STEP_L0) % STEPS_PER_LAYER; if (!step_used(layer % 3, slot) || (slot == 7 && layer == DEPTH - 1) || (slot == 0 && layer == 0)) continue; }
        ka.step_lo = s; ka.step_hi = s + 1;
        hipLaunchKernelGGL(fwd_kernel, dim3(grid), dim3(NTHREADS), LDS_BYTES, stream, ka);
    }
#endif
    const hipError_t le = hipPeekAtLastError();
    if (le != hipSuccess) fprintf(stderr, "kernel_launch: launch failed: %s\n", hipGetErrorName(le));
}
```

```cpp
#include <hip/hip_runtime.h>
#include <cstdio>
#include <cstdint>
namespace pg8 {
#define PG8_LAS __attribute__((address_space(3)))
typedef unsigned short bf16_t;
typedef short bf16x8 __attribute__((ext_vector_type(8)));
typedef float f32x4 __attribute__((ext_vector_type(4)));
typedef unsigned u32x4 __attribute__((ext_vector_type(4)));
constexpr int BM = 256, BK = 64, HALF = 128, HTB = HALF * BK * 2  , STAGE_BYTES = 8 * HTB, NXCD = 8, WGM = 8;

__host__ __device__ __forceinline__ int lds_byte(int r, int c) { const int st = (r >> 4) * 2 + (c >> 5), rr = r & 15, cc = c & 31, ob = rr * 64 + cc * 2; return st * 1024 + (ob ^ (((ob >> 9) & 1) << 5)); }
__host__ __device__ __forceinline__ void stage_rc(int b, int& R, int& C) { const int st = b / 1024, sb = b % 1024, swz = sb ^ (((sb >> 9) & 1) << 5); R = (st >> 1) * 16 + swz / 64; C = (st & 1) * 32 + (swz % 64) / 2; }
__host__ __device__ __forceinline__ int perm32(int rho) { const int n = rho >> 4, i = rho & 15; return 8 * (i >> 2) + 4 * n + (i & 3); }

struct Unit { int pm, pn, kt0, nt, slab; };
struct Gemm { const bf16_t* A; const bf16_t* Bt; int M, N, K; const bf16_t* A1; const bf16_t* Bt1; };

struct StaticOrder {
    int nM, nN, nwg, G, c;
    __host__ __device__ void init(int M, int N, int G_, int c_) { nM = M / BM; nN = N / BM; nwg = nM * nN; G = G_; c = c_; }
    __host__ __device__ __forceinline__ bool next(int i, Unit& u) const {
        const long L = (long)i * G + c; if (L >= nwg) return false;
        int wgid = (int)L; { const int q = nwg / NXCD, r = nwg % NXCD, xcd = wgid % NXCD, off = wgid / NXCD; wgid = (xcd < r ? xcd * (q + 1) : r * (q + 1) + (xcd - r) * q) + off; }
        const int nig = WGM * nN, gid = wgid / nig, fm = gid * WGM, gsz = (nM - fm) < WGM ? (nM - fm) : WGM;
        u.pm = fm + ((wgid % nig) % gsz); u.pn = (wgid % nig) / gsz; u.kt0 = 0; u.nt = 0; u.slab = -1; return true;
    }
    __host__ __device__ __forceinline__ bool by_index(long L, int& pm, int& pn) const {
        pm = 0; pn = 0; if (L >= nwg) return false;
        int wgid = (int)L; { const int q = nwg / NXCD, r = nwg % NXCD, xcd = wgid % NXCD, off = wgid / NXCD; wgid = (xcd < r ? xcd * (q + 1) : r * (q + 1) + (xcd - r) * q) + off; }
        const int nig = WGM * nN, gid = wgid / nig, fm = gid * WGM, gsz = (nM - fm) < WGM ? (nM - fm) : WGM;
        pm = fm + ((wgid % nig) % gsz); pn = (wgid % nig) / gsz; return true;
    }
    __device__ __forceinline__ bool get(int i, int& pm, int& pn, int& kt0, int& nt, int& slab) const { Unit u; u.pm = 0; u.pn = 0; const bool ok = next(i, u); pm = u.pm; pn = u.pn; kt0 = 0; nt = 0; slab = -1; return ok; }
    __device__ __forceinline__ void a_ready(const Unit&) const {}
    __device__ __forceinline__ void done(const Unit&) const {}
};

__device__ __forceinline__ unsigned cvt_pk_bf16(float lo, float hi) { unsigned r; asm volatile("v_cvt_pk_bf16_f32 %0, %1, %2" : "=v"(r) : "v"(lo), "v"(hi)); return r; }
typedef float f32x2 __attribute__((ext_vector_type(2)));
__device__ __forceinline__ f32x2 gelu_pk(f32x2 v) {
    const f32x2 av = __builtin_elementwise_abs(v), d = av * 0.2316418882f + 1.0f;
    f32x2 t; t.x = __builtin_amdgcn_rcpf(d.x); t.y = __builtin_amdgcn_rcpf(d.y);
    f32x2 q = t * 0.5307027145f + (-0.7265760135f); q = q * t + 0.7107068705f; q = q * t + (-0.142248368f); q = q * t + 0.127414796f; q = q * t;
    const f32x2 s = (v * v) * (-0.72134752044f);
    f32x2 e; e.x = __builtin_amdgcn_exp2f(s.x); e.y = __builtin_amdgcn_exp2f(s.y);
    const f32x2 m = v * (q * e), r = v - m;
    f32x2 o; o.x = v.x < 0.f ? m.x : r.x; o.y = v.y < 0.f ? m.y : r.y; return o;
}

template <int ACT  > struct EpiBf16 {
    static constexpr bool PERM = true, AFTER_DRAIN = false; static_assert(ACT == 0 || ACT == 1, "EpiBf16: ACT is 0 (none) or 1 (gelu_pk)");
    bf16_t* O; int ldc; const float* bias; int split_cols; size_t split_stride; float scale0;
    __device__ __forceinline__ void operator()(const f32x4 (&acc)[2][2][4][2], const Unit& u, int wr, int wc, int fr, int fq) const {
        const int row0 = u.pm * BM + wr * 64 + fr; int colt = u.pn * BM; bf16_t* base = O;
        float sc = 1.f; if (split_cols) { const int t = colt / split_cols; base += (size_t)t * split_stride; colt -= t * split_cols; if (t == 0) sc = scale0; }
        const int col0 = colt + wc * 32 + 8 * fq, bcol0 = u.pn * BM + wc * 32 + 8 * fq;
        f32x4 bv[2][2];
#pragma unroll
        for (int bj = 0; bj < 2; ++bj)
#pragma unroll
            for (int n = 0; n < 2; ++n) bv[bj][n] = bias ? *(const f32x4*)(bias + bcol0 + bj * HALF + 4 * n) : (f32x4){0.f, 0.f, 0.f, 0.f};
#pragma unroll
        for (int ai = 0; ai < 2; ++ai)
#pragma unroll
            for (int m = 0; m < 4; ++m) { bf16_t* rowp = base + (size_t)(row0 + ai * HALF + m * 16) * ldc + col0;
#pragma unroll
                for (int bj = 0; bj < 2; ++bj) { f32x4 v0 = acc[ai][bj][m][0] + bv[bj][0], v1 = acc[ai][bj][m][1] + bv[bj][1];
                    if (ACT == 1) { f32x2 a = gelu_pk((f32x2){v0[0], v0[1]}), b = gelu_pk((f32x2){v0[2], v0[3]}), c = gelu_pk((f32x2){v1[0], v1[1]}), d = gelu_pk((f32x2){v1[2], v1[3]});
                        v0 = (f32x4){a.x, a.y, b.x, b.y}; v1 = (f32x4){c.x, c.y, d.x, d.y}; }
                    v0 = v0 * sc; v1 = v1 * sc; u32x4 w; w.x = cvt_pk_bf16(v0[0], v0[1]); w.y = cvt_pk_bf16(v0[2], v0[3]); w.z = cvt_pk_bf16(v1[0], v1[1]); w.w = cvt_pk_bf16(v1[2], v1[3]);
                    *(u32x4*)(rowp + bj * HALF) = w; } }
    }
};

struct PanelStats {
    unsigned* xbuf;
    unsigned* cnt;
    unsigned* tmo;
    int ntn; float eps;
    unsigned code;
    __device__ __forceinline__ bool run(const f32x4 (&v)[2][2][4][2], const Unit& u, int wr, int wc, int fr, int fq, PG8_LAS unsigned char* lds, int wid, int lane) const {
        typedef float f32x2v __attribute__((ext_vector_type(2)));
        PG8_LAS f32x2v* P = (PG8_LAS f32x2v*)lds;
        PG8_LAS f32x2v* S = (PG8_LAS f32x2v*)(lds + 8192);
        PG8_LAS unsigned* flag = (PG8_LAS unsigned*)(lds + 8192 + 2048);
#pragma unroll
        for (int ai = 0; ai < 2; ++ai)
#pragma unroll
            for (int m = 0; m < 4; ++m) {
                float s = 0.f;
#pragma unroll
                for (int bj = 0; bj < 2; ++bj)
#pragma unroll
                    for (int n = 0; n < 2; ++n) { const f32x4 x = v[ai][bj][m][n]; s += (x[0] + x[1]) + (x[2] + x[3]); }
                s += __shfl_xor(s, 16); s += __shfl_xor(s, 32);
                const float mw = s * (1.0f / 64.0f); float q = 0.f;
#pragma unroll
                for (int bj = 0; bj < 2; ++bj)
#pragma unroll
                    for (int n = 0; n < 2; ++n) { const f32x4 d = v[ai][bj][m][n] - mw; q += (d[0] * d[0] + d[1] * d[1]) + (d[2] * d[2] + d[3] * d[3]); }
                q += __shfl_xor(q, 16); q += __shfl_xor(q, 32);
                if (fq == 0) P[(ai * HALF + wr * 64 + m * 16 + fr) * 4 + wc] = (f32x2v){mw, q};
            }
        asm volatile("s_waitcnt lgkmcnt(0)" ::: "memory"); __builtin_amdgcn_s_barrier(); asm volatile("" ::: "memory");
#if defined(BROKEN_EXCHANGE_NO_WAIT)
#warning BROKEN CONTROL BUILD: the row-statistics exchange does not wait; results are wrong by design
        if (blockIdx.x >= 64) { const long long t0_ = clock64(); while (clock64() - t0_ < 60000) __builtin_amdgcn_s_sleep(8); }
#endif
        const int row = wid * 32 + (lane & 31);
        if (lane < 32) {
            const f32x2v a = P[row * 4 + 0], b = P[row * 4 + 1], c = P[row * 4 + 2], d = P[row * 4 + 3];
            const float mt = (a.x + b.x + c.x + d.x) * 0.25f;
            const float da = a.x - mt, db = b.x - mt, dc = c.x - mt, dd = d.x - mt;
            const float m2 = (a.y + b.y) + (c.y + d.y) + 64.0f * ((da * da + db * db) + (dc * dc + dd * dd));
            unsigned long long* slot = (unsigned long long*)xbuf + ((size_t)(u.pm * BM + row) * 4 + u.pn);
            __hip_atomic_store(slot, ((unsigned long long)__float_as_uint(m2) << 32) | __float_as_uint(mt), __ATOMIC_RELAXED, __HIP_MEMORY_SCOPE_AGENT);
        }
        asm volatile("s_waitcnt vmcnt(0)" ::: "memory");
        if (lane == 0) __hip_atomic_fetch_add(cnt + 64 * u.pm, 1u, __ATOMIC_RELAXED, __HIP_MEMORY_SCOPE_AGENT);
        if (wid == 0) {
            bool dead = false; const unsigned long long t0 = __builtin_amdgcn_s_memrealtime(); const unsigned want = 8u * (unsigned)ntn;
            for (;;) {
#if defined(BROKEN_EXCHANGE_NO_WAIT)
                break;
#endif
                if ((unsigned)__builtin_amdgcn_readfirstlane(__hip_atomic_load(cnt + 64 * u.pm, __ATOMIC_RELAXED, __HIP_MEMORY_SCOPE_AGENT)) >= want) break;
                if (__builtin_amdgcn_s_memrealtime() - t0 > 2000000ull) {
                    if (lane == 0) { unsigned expect = 0u; __hip_atomic_compare_exchange_strong(tmo + 1, &expect, code | (unsigned)(u.pm & 0xff), __ATOMIC_RELAXED, __ATOMIC_RELAXED, __HIP_MEMORY_SCOPE_AGENT);
                                     __hip_atomic_store(tmo, 1u, __ATOMIC_RELAXED, __HIP_MEMORY_SCOPE_AGENT); }
                    dead = true; break; }
                __builtin_amdgcn_s_sleep(2);
            }
            __builtin_amdgcn_fence(__ATOMIC_ACQUIRE, "agent");
            if (lane == 0) flag[0] = dead ? 1u : 0u;
        }
        asm volatile("s_waitcnt vmcnt(0) lgkmcnt(0)" ::: "memory"); __builtin_amdgcn_s_barrier(); asm volatile("" ::: "memory");
        const bool bad = flag[0] != 0u;
        if (lane < 32) {
            const unsigned long long* slot = (const unsigned long long*)xbuf + (size_t)(u.pm * BM + row) * 4; float mt[4], m2[4]; float ms = 0.f;
#pragma unroll
            for (int t = 0; t < 4; ++t) { if (t < ntn) { const unsigned long long w = __hip_atomic_load(slot + t, __ATOMIC_RELAXED, __HIP_MEMORY_SCOPE_AGENT); mt[t] = __uint_as_float((unsigned)w); m2[t] = __uint_as_float((unsigned)(w >> 32)); } else { mt[t] = 0.f; m2[t] = 0.f; } ms += mt[t]; }
            const float mean = ms / (float)ntn; float q = 0.f;
#pragma unroll
            for (int t = 0; t < 4; ++t) if (t < ntn) { const float dm = mt[t] - mean; q += m2[t] + 256.0f * dm * dm; }
            S[row] = (f32x2v){mean, 1.0f / sqrtf(q / (256.0f * (float)ntn) + eps)};
        }
        asm volatile("s_waitcnt lgkmcnt(0)" ::: "memory"); __builtin_amdgcn_s_barrier(); asm volatile("" ::: "memory");
        return bad;
    }
};
struct EpiLnRes {
    static constexpr bool PERM = false, AFTER_DRAIN = true;
    const float* base; float* out; int ldc; const float* bias; PanelStats st; unsigned poison;
    __device__ __forceinline__ void fused(f32x4 (&acc)[2][2][4][2], const Unit& u, int wr, int wc, int fr, int fq, PG8_LAS unsigned char* lds, int wid, int lane) const {
        typedef float f32x2v __attribute__((ext_vector_type(2)));
        const PG8_LAS f32x2v* S = (const PG8_LAS f32x2v*)(lds + 8192);
        const int col0 = u.pn * BM + wc * 32 + 4 * fq;
#pragma unroll
        for (int bj = 0; bj < 2; ++bj)
#pragma unroll
            for (int n = 0; n < 2; ++n) { const f32x4 bv = bias ? *(const f32x4*)(bias + col0 + bj * HALF + n * 16) : (f32x4){0.f, 0.f, 0.f, 0.f};
#pragma unroll
                for (int ai = 0; ai < 2; ++ai)
#pragma unroll
                    for (int m = 0; m < 4; ++m) acc[ai][bj][m][n] += bv; }
        f32x4 pre[4][2][2];
#pragma unroll
        for (int m = 0; m < 4; ++m) { const size_t off = (size_t)(u.pm * BM + wr * 64 + m * 16 + fr) * ldc + col0;
#pragma unroll
            for (int bj = 0; bj < 2; ++bj)
#pragma unroll
                for (int n = 0; n < 2; ++n) pre[m][bj][n] = *(const f32x4*)(base + off + bj * HALF + n * 16); }
        const bool bad = st.run(acc, u, wr, wc, fr, fq, lds, wid, lane) || poison != 0u;
        const float qnan = __builtin_nanf("");
#pragma unroll
        for (int ai = 0; ai < 2; ++ai)
#pragma unroll
            for (int m = 0; m < 4; ++m) { const int r = ai * HALF + wr * 64 + m * 16 + fr; const f32x2v sr = S[r]; const size_t off = (size_t)(u.pm * BM + r) * ldc + col0;
#pragma unroll
                for (int bj = 0; bj < 2; ++bj)
#pragma unroll
                    for (int n = 0; n < 2; ++n) { const f32x4 bs = ai == 0 ? pre[m][bj][n] : *(const f32x4*)(base + off + bj * HALF + n * 16); f32x4 o = bs + (acc[ai][bj][m][n] - sr.x) * sr.y;
                        if (bad) o = (f32x4){qnan, qnan, qnan, qnan}; *(f32x4*)(out + off + bj * HALF + n * 16) = o; }
                if (m & 1) asm volatile("" ::: "memory"); }
    }
};
struct EpiLnResLn {
    static constexpr bool PERM = false, AFTER_DRAIN = true;
    const float* base; float* out; bf16_t* xn; int ldc; const float* bias; PanelStats st1, st2; unsigned poison;
    __device__ __forceinline__ void fused(f32x4 (&acc)[2][2][4][2], const Unit& u, int wr, int wc, int fr, int fq, PG8_LAS unsigned char* lds, int wid, int lane) const {
        typedef float f32x2v __attribute__((ext_vector_type(2))); typedef unsigned u32x2v __attribute__((ext_vector_type(2)));
        const PG8_LAS f32x2v* S = (const PG8_LAS f32x2v*)(lds + 8192);
        const int col0 = u.pn * BM + wc * 32 + 4 * fq;
#pragma unroll
        for (int bj = 0; bj < 2; ++bj)
#pragma unroll
            for (int n = 0; n < 2; ++n) { const f32x4 bv = bias ? *(const f32x4*)(bias + col0 + bj * HALF + n * 16) : (f32x4){0.f, 0.f, 0.f, 0.f};
#pragma unroll
                for (int ai = 0; ai < 2; ++ai)
#pragma unroll
                    for (int m = 0; m < 4; ++m) acc[ai][bj][m][n] += bv; }
        bool bad = st1.run(acc, u, wr, wc, fr, fq, lds, wid, lane) || poison != 0u;
        const float qnan = __builtin_nanf("");
#pragma unroll
        for (int ai = 0; ai < 2; ++ai)
#pragma unroll
            for (int m = 0; m < 4; ++m) { const int r = ai * HALF + wr * 64 + m * 16 + fr; const f32x2v sr = S[r]; const size_t off = (size_t)(u.pm * BM + r) * ldc + col0;
#pragma unroll
                for (int bj = 0; bj < 2; ++bj)
#pragma unroll
                    for (int n = 0; n < 2; ++n) { const f32x4 bs = *(const f32x4*)(base + off + bj * HALF + n * 16); acc[ai][bj][m][n] = bs + (acc[ai][bj][m][n] - sr.x) * sr.y; }
                asm volatile("" : "+v"(acc[ai][0][m][0]), "+v"(acc[ai][0][m][1]), "+v"(acc[ai][1][m][0]), "+v"(acc[ai][1][m][1]));
                if (m & 1) asm volatile("" ::: "memory"); }
        const bool bad1 = bad;
        bad = st2.run(acc, u, wr, wc, fr, fq, lds, wid, lane) || bad;
#pragma unroll
        for (int ai = 0; ai < 2; ++ai)
#pragma unroll
            for (int m = 0; m < 4; ++m) { const int r = ai * HALF + wr * 64 + m * 16 + fr; const f32x2v sr = S[r]; const size_t off = (size_t)(u.pm * BM + r) * ldc + col0;
#pragma unroll
                for (int bj = 0; bj < 2; ++bj)
#pragma unroll
                    for (int n = 0; n < 2; ++n) { const f32x4 x1 = acc[ai][bj][m][n]; *(f32x4*)(out + off + bj * HALF + n * 16) = bad1 ? (f32x4){qnan, qnan, qnan, qnan} : x1;
                        const f32x4 o = (x1 - sr.x) * sr.y; u32x2v w; w.x = cvt_pk_bf16(o[0], o[1]); w.y = cvt_pk_bf16(o[2], o[3]);
                        if (bad) { w.x = 0x7fc07fc0u; w.y = 0x7fc07fc0u; } *(u32x2v*)(xn + off + bj * HALF + n * 16) = w; }
                asm volatile("" ::: "memory"); }
    }
};

template <class E, class = void> struct PermA { static constexpr bool v = false; };
template <class E> struct PermA<E, decltype((void)E::PERMA)> { static constexpr bool v = E::PERMA; };
template <class Epi, class Sched, bool ALIGN_EPI = false, bool SP2 = false>
__device__ __forceinline__ void gemm_phase(PG8_LAS unsigned char* lds, const Gemm g, const Sched& S, const Epi& E) {
    int tid_ = threadIdx.x; asm volatile("" : "+v"(tid_));
    const int tid = tid_, wid = __builtin_amdgcn_readfirstlane(tid >> 6), lane = tid & 63, wr = wid >> 2, wc = wid & 3, fr = lane & 15, fq = lane >> 4;
    const int K = g.K, nt_full = K / BK;
    unsigned voffA[2], voffB[2];
#pragma unroll
    for (int i = 0; i < 2; ++i) { int R, C; stage_rc(tid * 16 + i * 8192, R, C); const int Rb = Epi::PERM ? ((R & ~31) + perm32(R & 31)) : R;
        const int Ra = PermA<Epi>::v ? ((R & ~63) + 4 * (R & 15) + ((R >> 4) & 3)) : R;
        voffA[i] = (unsigned)(Ra * K + C) * 2u; voffB[i] = (unsigned)(Rb * K + C) * 2u; }
    const size_t kstep = (size_t)(BK * 2);
    const size_t hstep = (size_t)HALF * K * 2;
    const size_t tstep = 2 * hstep;
    const unsigned ldsw = (unsigned)wid * 1024u;
    const int aoff = lds_byte(wr * 64 + fr, fq * 8), boff = lds_byte(wc * 32 + fr, fq * 8);
#define PG8_SA(b, h) (((b) * 2 + (h)) * HTB)
#define PG8_SB(b, h) ((4 + (b) * 2 + (h)) * HTB)
#define PG8_STAGE(bufoff, gbase, voff) do { _Pragma("unroll") for (int _i = 0; _i < 2; ++_i) \
        __builtin_amdgcn_global_load_lds((const unsigned*)((const char*)(gbase) + (voff)[_i]), (PG8_LAS unsigned*)(lds + (bufoff) + ldsw + _i * 8192), 16, 0, 0); } while (0)
#define PG8_LDA(dst, b, h) do { _Pragma("unroll") for (int m = 0; m < 4; ++m) _Pragma("unroll") for (int k = 0; k < 2; ++k) dst[m][k] = *(const PG8_LAS bf16x8*)(lds + PG8_SA(b, h) + aoff + m * 2048 + k * 1024); } while (0)
#define PG8_LDB(dst, b, h) do { _Pragma("unroll") for (int n = 0; n < 2; ++n) _Pragma("unroll") for (int k = 0; k < 2; ++k) dst[n][k] = *(const PG8_LAS bf16x8*)(lds + PG8_SB(b, h) + boff + n * 2048 + k * 1024); } while (0)
#define PG8_MMA(ai, bj, At, Bt) do { __builtin_amdgcn_s_setprio(1); _Pragma("unroll") for (int m = 0; m < 4; ++m) _Pragma("unroll") for (int n = 0; n < 2; ++n) _Pragma("unroll") for (int k = 0; k < 2; ++k) \
        acc[ai][bj][m][n] = __builtin_amdgcn_mfma_f32_16x16x32_bf16(Bt[n][k], At[m][k], acc[ai][bj][m][n], 0, 0, 0); __builtin_amdgcn_s_setprio(0); } while (0)
#define PG8_WAIT_V(n) asm volatile("s_waitcnt vmcnt(" #n ")" ::: "memory")
#define PG8_WAIT_L(n) asm volatile("s_waitcnt lgkmcnt(" #n ")" ::: "memory")
#define PG8_BAR __builtin_amdgcn_s_barrier()
#define PG8_SCHED __builtin_amdgcn_sched_barrier(0)
    Unit cur, nxt; int ui = 0;
    { int pm_, pn_, kt0_, nt_, slab_; if (!S.get(0, pm_, pn_, kt0_, nt_, slab_)) return; cur.pm = pm_; cur.pn = pn_; cur.kt0 = kt0_; cur.nt = nt_; cur.slab = slab_; }
    f32x4 acc[2][2][4][2];
#pragma unroll
    for (int a = 0; a < 2; ++a)
#pragma unroll
        for (int b = 0; b < 2; ++b)
#pragma unroll
            for (int m = 0; m < 4; ++m)
#pragma unroll
                for (int n = 0; n < 2; ++n) acc[a][b][m][n] = (f32x4){0.f, 0.f, 0.f, 0.f};
    bf16x8 At[4][2], B0[2][2], B1[2][2];
    const char* cA = (const char*)((g.A1 && cur.slab == 1) ? g.A1 : g.A) + (size_t)cur.pm * tstep + (size_t)cur.kt0 * kstep; const char* cB = (const char*)((g.A1 && cur.slab == 1) ? g.Bt1 : g.Bt) + (size_t)cur.pn * tstep + (size_t)cur.kt0 * kstep;
    S.a_ready(cur);
    if constexpr (SP2) {
        PG8_STAGE(PG8_SB(0, 0), cB, voffB); PG8_STAGE(PG8_SB(0, 1), cB + hstep, voffB); PG8_STAGE(PG8_SA(0, 0), cA, voffA); PG8_STAGE(PG8_SA(0, 1), cA + hstep, voffA);
        if (wr == 1) PG8_BAR;
        PG8_WAIT_V(2); PG8_BAR;
        PG8_STAGE(PG8_SB(1, 0), cB + kstep, voffB); PG8_STAGE(PG8_SA(1, 0), cA + kstep, voffA); PG8_STAGE(PG8_SB(1, 1), cB + hstep + kstep, voffB);
        PG8_WAIT_V(6); PG8_BAR;
    } else {
        PG8_STAGE(PG8_SB(0, 0), cB, voffB); PG8_STAGE(PG8_SA(0, 0), cA, voffA); PG8_STAGE(PG8_SB(0, 1), cB + hstep, voffB); PG8_STAGE(PG8_SA(0, 1), cA + hstep, voffA);
        if (wr == 1) PG8_BAR;
        PG8_WAIT_V(4); PG8_BAR;
        PG8_STAGE(PG8_SB(1, 0), cB + kstep, voffB); PG8_STAGE(PG8_SA(1, 0), cA + kstep, voffA); PG8_STAGE(PG8_SB(1, 1), cB + hstep + kstep, voffB);
        PG8_WAIT_V(6); PG8_BAR;
    }
    for (;;) {
        bool has_next; { int pm_, pn_, kt0_, nt_, slab_; has_next = S.get(ui + 1, pm_, pn_, kt0_, nt_, slab_); nxt.pm = pm_; nxt.pn = pn_; nxt.kt0 = kt0_; nxt.nt = nt_; nxt.slab = slab_; }
        const char* nA = has_next ? (const char*)((g.A1 && nxt.slab == 1) ? g.A1 : g.A) + (size_t)nxt.pm * tstep + (size_t)nxt.kt0 * kstep : cA; const char* nB = has_next ? (const char*)((g.A1 && nxt.slab == 1) ? g.Bt1 : g.Bt) + (size_t)nxt.pn * tstep + (size_t)nxt.kt0 * kstep : cB;
        const int nt = cur.nt ? cur.nt : nt_full;
        for (int t = 0; t < nt; t += 2) {
            const bool last = (t == nt - 2);
            const char* a1 = cA + (size_t)(t + 1) * kstep;
            const char* a2 = last ? nA : cA + (size_t)(t + 2) * kstep; const char* b2 = last ? nB : cB + (size_t)(t + 2) * kstep;
            const char* a3 = a2 + kstep; const char* b3 = b2 + kstep;
            if (last && has_next) S.a_ready(nxt);
            if constexpr (SP2) {
            PG8_LDB(B0, 0, 0); PG8_LDB(B1, 0, 1); PG8_SCHED; PG8_LDA(At, 0, 0); PG8_STAGE(PG8_SA(1, 1), a1 + hstep, voffA);
            PG8_WAIT_V(8); PG8_WAIT_L(0); PG8_BAR; PG8_MMA(0, 0, At, B0); PG8_MMA(0, 1, At, B1); PG8_BAR; PG8_SCHED;
            PG8_LDA(At, 0, 1); PG8_STAGE(PG8_SB(0, 0), b2, voffB); PG8_STAGE(PG8_SB(0, 1), b2 + hstep, voffB); PG8_STAGE(PG8_SA(0, 0), a2, voffA);
            PG8_WAIT_V(8); PG8_WAIT_L(0); PG8_BAR; PG8_MMA(1, 0, At, B0); PG8_MMA(1, 1, At, B1); PG8_BAR; PG8_SCHED;
            PG8_LDB(B0, 1, 0); PG8_LDB(B1, 1, 1); PG8_SCHED; PG8_LDA(At, 1, 0); PG8_STAGE(PG8_SA(0, 1), a2 + hstep, voffA);
            PG8_WAIT_V(8); PG8_WAIT_L(0); PG8_BAR; PG8_MMA(0, 0, At, B0); PG8_MMA(0, 1, At, B1); PG8_BAR; PG8_SCHED;
            PG8_LDA(At, 1, 1); PG8_STAGE(PG8_SB(1, 0), b3, voffB); PG8_STAGE(PG8_SB(1, 1), b3 + hstep, voffB); PG8_STAGE(PG8_SA(1, 0), a3, voffA);
            PG8_WAIT_V(8); PG8_WAIT_L(0); PG8_BAR; PG8_MMA(1, 0, At, B0); PG8_MMA(1, 1, At, B1); PG8_BAR; PG8_SCHED;
            } else {
            PG8_LDB(B0, 0, 0); PG8_SCHED; PG8_LDA(At, 0, 0); PG8_STAGE(PG8_SA(1, 1), a1 + hstep, voffA);
            PG8_WAIT_L(8); PG8_BAR; PG8_WAIT_L(0); PG8_MMA(0, 0, At, B0); PG8_BAR; PG8_SCHED;
            PG8_LDB(B1, 0, 1); PG8_STAGE(PG8_SB(0, 0), b2, voffB);
            PG8_BAR; PG8_WAIT_L(0); PG8_MMA(0, 1, At, B1); PG8_BAR;
            PG8_LDA(At, 0, 1); PG8_STAGE(PG8_SA(0, 0), a2, voffA);
            PG8_BAR; PG8_WAIT_L(0); PG8_MMA(1, 0, At, B0); PG8_BAR; PG8_SCHED;
            PG8_STAGE(PG8_SB(0, 1), b2 + hstep, voffB);
            PG8_WAIT_V(6); PG8_BAR; PG8_MMA(1, 1, At, B1); PG8_BAR;
            PG8_LDB(B0, 1, 0); PG8_SCHED; PG8_LDA(At, 1, 0); PG8_STAGE(PG8_SA(0, 1), a2 + hstep, voffA);
            PG8_WAIT_L(8); PG8_BAR; PG8_WAIT_L(0); PG8_MMA(0, 0, At, B0); PG8_BAR; PG8_SCHED;
            PG8_LDB(B1, 1, 1); PG8_STAGE(PG8_SB(1, 0), b3, voffB);
            PG8_BAR; PG8_WAIT_L(0); PG8_MMA(0, 1, At, B1); PG8_BAR;
            PG8_LDA(At, 1, 1); PG8_STAGE(PG8_SA(1, 0), a3, voffA);
            PG8_BAR; PG8_WAIT_L(0); PG8_MMA(1, 0, At, B0); PG8_BAR; PG8_SCHED;
            PG8_STAGE(PG8_SB(1, 1), b3 + hstep, voffB);
            PG8_WAIT_V(6); PG8_BAR; PG8_MMA(1, 1, At, B1); PG8_BAR;
            }
        }
        if constexpr (ALIGN_EPI) { if (wr == 0) PG8_BAR; }
        if constexpr (!Epi::AFTER_DRAIN) { E(acc, cur, wr, wc, fr, fq); S.done(cur); }
        if (!has_next) break;
#pragma unroll
        for (int a = 0; a < 2; ++a)
#pragma unroll
            for (int b = 0; b < 2; ++b)
#pragma unroll
                for (int m = 0; m < 4; ++m)
#pragma unroll
                    for (int n = 0; n < 2; ++n) acc[a][b][m][n] = (f32x4){0.f, 0.f, 0.f, 0.f};
        cur = nxt; cA = nA; cB = nB; ++ui;
        if constexpr (ALIGN_EPI) { if (wr == 1) PG8_BAR; }
    }
    PG8_WAIT_V(0);
    if constexpr (!ALIGN_EPI) { if (wr == 0) PG8_BAR; }
    PG8_BAR;
    if constexpr (Epi::AFTER_DRAIN) { E.fused(acc, cur, wr, wc, fr, fq, lds, wid, lane); S.done(cur); }
#undef PG8_SA
#undef PG8_SB
#undef PG8_STAGE
#undef PG8_LDA
#undef PG8_LDB
#undef PG8_MMA
#undef PG8_WAIT_V
#undef PG8_WAIT_L
#undef PG8_BAR
#undef PG8_SCHED
}
}
namespace pg8 {
struct EpiRes {
    static constexpr bool PERM = false, AFTER_DRAIN = false;
    float* X; int ldc; const float* mods; int gate_off;
    float* slab;
    __device__ __forceinline__ void operator()(const f32x4 (&acc)[2][2][4][2], const Unit& u, int wr, int wc, int fr, int fq) const {
        const int prow = u.pm * BM; const int col0 = u.pn * BM + wc * 32 + 4 * fq;
        if (u.slab >= 0) {
            float* base = slab + ((size_t)u.slab * 1024 + (prow - 8192)) * ldc + col0;
#pragma unroll
            for (int ai = 0; ai < 2; ++ai)
#pragma unroll
                for (int m = 0; m < 4; ++m) { float* rowp = base + (size_t)(ai * HALF + wr * 64 + m * 16 + fr) * ldc;
#pragma unroll
                    for (int bj = 0; bj < 2; ++bj)
#pragma unroll
                        for (int n = 0; n < 2; ++n) *(f32x4*)(rowp + bj * HALF + n * 16) = acc[ai][bj][m][n]; }
            return;
        }
        const int bidx = prow < 8192 ? (prow >> 11) : 4;
        const float* gate = mods + bidx * 12288 + gate_off;
        f32x4 gv[2][2];
#pragma unroll
        for (int bj = 0; bj < 2; ++bj)
#pragma unroll
            for (int n = 0; n < 2; ++n) gv[bj][n] = *(const f32x4*)(gate + col0 + bj * HALF + n * 16);
#pragma unroll
        for (int ai = 0; ai < 2; ++ai)
#pragma unroll
            for (int m = 0; m < 4; ++m) { float* rowp = X + (size_t)(prow + ai * HALF + wr * 64 + m * 16 + fr) * ldc + col0;
#pragma unroll
                for (int bj = 0; bj < 2; ++bj)
#pragma unroll
                    for (int n = 0; n < 2; ++n) { f32x4* p = (f32x4*)(rowp + bj * HALF + n * 16); f32x4 v = *p; v = v + gv[bj][n] * acc[ai][bj][m][n]; *p = v; } }
    }
};
struct ResOrder {
    StaticOrder lat; int G, c, nlat, nchunk, nN, q8, r8;
    __device__ __forceinline__ void init(int Mrows, int N, int K, int G_, int c_) { lat.init(8192, N, G_, c_); G = G_; c = c_; nN = N / BM; nlat = 32 * nN; nchunk = Mrows > 8192 ? 4 * nN * 8 : 0;
        const int pairs = K / (2 * BK); q8 = pairs / 8; r8 = pairs % 8; }
    __device__ __forceinline__ bool get(int i, int& pm, int& pn, int& kt0, int& nt, int& slab) const {
        const int L = i * G + c; pm = 0; pn = 0; kt0 = 0; nt = 0; slab = -1;
        if (L < nlat) { Unit t; t.pm = 0; t.pn = 0; const bool ok = lat.next(L / G, t); pm = t.pm; pn = t.pn; return ok; }
        const int e = L - nlat; if (e >= nchunk) return false;
        const int q = e >> 3, sidx = e & 7;
        pm = 32 + q / nN; pn = q % nN; slab = sidx; nt = 2 * (q8 + (sidx < r8 ? 1 : 0)); kt0 = 2 * (sidx * q8 + (sidx < r8 ? sidx : r8)); return true;
    }
    __device__ __forceinline__ void a_ready(const Unit&) const {}
    __device__ __forceinline__ void done(const Unit&) const {}
};
struct EpiF32 {
    static constexpr bool PERM = false, AFTER_DRAIN = false;
    float* O; int ldc;
    __device__ __forceinline__ void operator()(const f32x4 (&acc)[2][2][4][2], const Unit& u, int wr, int wc, int fr, int fq) const {
        const int col0 = u.pn * BM + wc * 32 + 4 * fq;
#pragma unroll
        for (int ai = 0; ai < 2; ++ai)
#pragma unroll
            for (int m = 0; m < 4; ++m) { float* rowp = O + (size_t)(u.pm * BM + ai * HALF + wr * 64 + m * 16 + fr) * ldc + col0;
#pragma unroll
                for (int bj = 0; bj < 2; ++bj)
#pragma unroll
                    for (int n = 0; n < 2; ++n) *(f32x4*)(rowp + bj * HALF + n * 16) = acc[ai][bj][m][n]; }
    }
};
typedef _Float16 h16x2 __attribute__((ext_vector_type(2)));
__device__ __forceinline__ unsigned pack_h2(float a, float b) { const h16x2 v = {(_Float16)a, (_Float16)b}; return __builtin_bit_cast(unsigned, v); }
__device__ __forceinline__ float h2_lo(unsigned u) { return (float)__builtin_bit_cast(h16x2, u)[0]; }
__device__ __forceinline__ float h2_hi(unsigned u) { return (float)__builtin_bit_cast(h16x2, u)[1]; }
constexpr int QG_ROWSS = 1, QG_MODS = 18, QG_BIAS2 = 17, QG_SGST = 6, QG_MLSS = 4;
template <int SH> __device__ __forceinline__ float qgrid(float v) { return rintf(v * (float)(1 << SH)) * (1.0f / (float)(1 << SH)); }
__device__ __forceinline__ float epi_shfl_xor(float v, int mask, int lane) { return __builtin_bit_cast(float, __builtin_amdgcn_ds_bpermute((lane ^ mask) << 2, __builtin_bit_cast(int, v))); }
template <int ACT> struct EpiNormBf16 {
    static constexpr bool PERM = true, AFTER_DRAIN = false;
    bf16_t* O; int ldc; const float* bias; const float* rowss; const float* bias2; int ldb;
    __device__ __forceinline__ void operator()(const f32x4 (&acc)[2][2][4][2], const Unit& u, int wr, int wc, int fr, int fq) const {
        const int prow = u.pm * BM, row0 = prow + wr * 64 + fr, col0 = u.pn * BM + wc * 32 + 8 * fq, bidx = prow < 8192 ? (prow >> 11) : 4;
        f32x4 bv[2][2];
#pragma unroll
        for (int bj = 0; bj < 2; ++bj)
#pragma unroll
            for (int n = 0; n < 2; ++n) { bv[bj][n] = *(const f32x4*)(bias2 + (size_t)bidx * ldb + col0 + bj * HALF + 4 * n); if (bias) bv[bj][n] = bv[bj][n] + *(const f32x4*)(bias + col0 + bj * HALF + 4 * n); }
#pragma unroll
        for (int ai = 0; ai < 2; ++ai)
#pragma unroll
            for (int m = 0; m < 4; ++m) { const int row = row0 + ai * HALF + m * 16; bf16_t* rowp = O + (size_t)row * ldc + col0;
                const float rs = __builtin_amdgcn_rsqf(rowss[row] * (1.0f / 2048.0f) + 1e-6f);
#pragma unroll
                for (int bj = 0; bj < 2; ++bj) { f32x4 v0 = acc[ai][bj][m][0] * rs + bv[bj][0], v1 = acc[ai][bj][m][1] * rs + bv[bj][1];
                    if (ACT == 1) { f32x2 a = gelu_pk((f32x2){v0[0], v0[1]}), b = gelu_pk((f32x2){v0[2], v0[3]}), c = gelu_pk((f32x2){v1[0], v1[1]}), d = gelu_pk((f32x2){v1[2], v1[3]});
                        v0 = (f32x4){a.x, a.y, b.x, b.y}; v1 = (f32x4){c.x, c.y, d.x, d.y}; }
                    u32x4 w; w.x = cvt_pk_bf16(v0[0], v0[1]); w.y = cvt_pk_bf16(v0[2], v0[3]); w.z = cvt_pk_bf16(v1[0], v1[1]); w.w = cvt_pk_bf16(v1[2], v1[3]);
                    *(u32x4*)(rowp + bj * HALF) = w; } }
    }
};
struct EpiNormF32 {
    static constexpr bool PERM = false, AFTER_DRAIN = false;
    float* O; int ldc; const float* rowss; const float* bias2; int ldb;
    __device__ __forceinline__ void operator()(const f32x4 (&acc)[2][2][4][2], const Unit& u, int wr, int wc, int fr, int fq) const {
        const int prow = u.pm * BM, col0 = u.pn * BM + wc * 32 + 4 * fq, bidx = prow < 8192 ? (prow >> 11) : 4;
        f32x4 bv[2][2];
#pragma unroll
        for (int bj = 0; bj < 2; ++bj)
#pragma unroll
            for (int n = 0; n < 2; ++n) bv[bj][n] = *(const f32x4*)(bias2 + (size_t)bidx * ldb + col0 + bj * HALF + n * 16);
#pragma unroll
        for (int ai = 0; ai < 2; ++ai)
#pragma unroll
            for (int m = 0; m < 4; ++m) { const int row = prow + ai * HALF + wr * 64 + m * 16 + fr; float* rowp = O + (size_t)row * ldc + col0;
                const float rs = __builtin_amdgcn_rsqf(rowss[row] * (1.0f / 2048.0f) + 1e-6f);
#pragma unroll
                for (int bj = 0; bj < 2; ++bj)
#pragma unroll
                    for (int n = 0; n < 2; ++n) *(f32x4*)(rowp + bj * HALF + n * 16) = acc[ai][bj][m][n] * rs + bv[bj][n]; }
    }
};
struct EpiResN {
    static constexpr bool PERM = false, AFTER_DRAIN = false;
    bf16_t* X; int ldc; const float* mods; int gate_off; bf16_t* slab;
    bf16_t* A2; const float* gnext; const float* scale_next; float* rowss_next;
    static __device__ __forceinline__ u32x4 regroup(const f32x4 h0, const f32x4 h1) {
        unsigned px = cvt_pk_bf16(h0[0], h0[1]), py = cvt_pk_bf16(h0[2], h0[3]), qx = cvt_pk_bf16(h1[0], h1[1]), qy = cvt_pk_bf16(h1[2], h1[3]);
        { auto r = __builtin_amdgcn_permlane32_swap(px, qx, false, false); px = r[0]; qx = r[1]; } { auto r = __builtin_amdgcn_permlane16_swap(px, qx, false, false); px = r[0]; qx = r[1]; }
        { auto r = __builtin_amdgcn_permlane32_swap(py, qy, false, false); py = r[0]; qy = r[1]; } { auto r = __builtin_amdgcn_permlane16_swap(py, qy, false, false); py = r[0]; qy = r[1]; }
        u32x4 w; w.x = px; w.y = py; w.z = qx; w.w = qy; return w; }
    static __device__ __forceinline__ u32x4 regroup_h(const f32x4 h0, const f32x4 h1) {
        unsigned px = pack_h2(h0[0], h0[1]), py = pack_h2(h0[2], h0[3]), qx = pack_h2(h1[0], h1[1]), qy = pack_h2(h1[2], h1[3]);
        { auto r = __builtin_amdgcn_permlane32_swap(px, qx, false, false); px = r[0]; qx = r[1]; } { auto r = __builtin_amdgcn_permlane16_swap(px, qx, false, false); px = r[0]; qx = r[1]; }
        { auto r = __builtin_amdgcn_permlane32_swap(py, qy, false, false); py = r[0]; qy = r[1]; } { auto r = __builtin_amdgcn_permlane16_swap(py, qy, false, false); py = r[0]; qy = r[1]; }
        u32x4 w; w.x = px; w.y = py; w.z = qx; w.w = qy; return w; }
    static __device__ __forceinline__ void ungroup(const u32x4 w, f32x4& h0, f32x4& h1) {
        unsigned px = w.x, py = w.y, qx = w.z, qy = w.w;
        { auto r = __builtin_amdgcn_permlane16_swap(px, qx, false, false); px = r[0]; qx = r[1]; } { auto r = __builtin_amdgcn_permlane32_swap(px, qx, false, false); px = r[0]; qx = r[1]; }
        { auto r = __builtin_amdgcn_permlane16_swap(py, qy, false, false); py = r[0]; qy = r[1]; } { auto r = __builtin_amdgcn_permlane32_swap(py, qy, false, false); py = r[0]; qy = r[1]; }
        h0 = (f32x4){h2_lo(px), h2_hi(px), h2_lo(py), h2_hi(py)};
        h1 = (f32x4){h2_lo(qx), h2_hi(qx), h2_lo(qy), h2_hi(qy)}; }
    __device__ __forceinline__ void operator()(const f32x4 (&acc_)[2][2][4][2], const Unit& u, int wr, int wc, int fr, int fq) const {
        f32x4 (&U)[2][2][4][2] = const_cast<f32x4 (&)[2][2][4][2]>(acc_);
        constexpr unsigned LDC = 2048;
        int pm_ = u.pm, pn_ = u.pn; asm volatile("" : "+s"(pm_), "+s"(pn_));
        const int prow = pm_ * BM; const int col0 = pn_ * BM + wc * 32 + 4 * fq, colb = pn_ * BM + wc * 32 + 8 * fq;
        const unsigned rl = (unsigned)(wr * 64 + fr);
        const unsigned ob = (rl * LDC + (unsigned)colb) * 2u;
        if (u.slab < 0) {
        const int bidx = prow < 8192 ? (prow >> 11) : 4;
        const float* gate = mods + bidx * 12288 + gate_off;
        f32x4 gv[2][2];
#pragma unroll
        for (int bj = 0; bj < 2; ++bj)
#pragma unroll
            for (int n = 0; n < 2; ++n) gv[bj][n] = *(const f32x4*)(gate + col0 + bj * HALF + 16 * n);
        const int lane = fq * 16 + fr;
        char* Xp = (char*)(X + (size_t)prow * LDC);
        { u32x4 ta[2], tb[2];
#define RESN_LD(T, ai, m) do { _Pragma("unroll") for (int bj = 0; bj < 2; ++bj) T[bj] = *(const u32x4*)(Xp + (ob + (unsigned)(((ai) * HALF + (m) * 16) * LDC + bj * HALF) * 2u)); } while (0)
#define RESN_FMA(T, ai, m) do { asm volatile("" ::: "memory"); _Pragma("unroll") for (int bj = 0; bj < 2; ++bj) { f32x4 x0_, x1_; ungroup(T[bj], x0_, x1_); \
            U[ai][bj][m][0] = x0_ + gv[bj][0] * U[ai][bj][m][0]; U[ai][bj][m][1] = x1_ + gv[bj][1] * U[ai][bj][m][1]; \
            asm volatile("" : "+v"(U[ai][bj][m][0]), "+v"(U[ai][bj][m][1])); } \
            asm volatile("" ::: "memory"); } while (0)
          RESN_LD(ta, 0, 0); RESN_LD(tb, 0, 1); RESN_FMA(ta, 0, 0); RESN_LD(ta, 0, 2); RESN_FMA(tb, 0, 1); RESN_LD(tb, 0, 3); RESN_FMA(ta, 0, 2); RESN_LD(ta, 1, 0); RESN_FMA(tb, 0, 3);
          RESN_LD(tb, 1, 1); RESN_FMA(ta, 1, 0); RESN_LD(ta, 1, 2); RESN_FMA(tb, 1, 1); RESN_LD(tb, 1, 3); RESN_FMA(ta, 1, 2);
          f32x4 gs[2][2];
#pragma unroll
          for (int bj = 0; bj < 2; ++bj)
#pragma unroll
            for (int n = 0; n < 2; ++n) { const int c = col0 + bj * HALF + 16 * n;
                gs[bj][n] = A2 ? *(const f32x4*)(gnext + c) * (*(const f32x4*)(scale_next + bidx * 12288 + c) + 1.0f) : (f32x4){0.f, 0.f, 0.f, 0.f}; }
          RESN_FMA(tb, 1, 3);
#undef RESN_LD
#undef RESN_FMA
        char* Ap = (char*)(A2 + (size_t)prow * LDC);
        unsigned ob2 = ob; asm volatile("" : "+v"(ob2));
#pragma unroll
        for (int ai = 0; ai < 2; ++ai)
#pragma unroll
            for (int m = 0; m < 4; ++m) { float ss = 0.f;
#pragma unroll
                for (int bj = 0; bj < 2; ++bj) { const unsigned o_ = ob2 + (unsigned)((ai * HALF + m * 16) * LDC + bj * HALF) * 2u;
#pragma unroll
                    for (int n = 0; n < 2; ++n) { const f32x4 v = U[ai][bj][m][n]; ss += (v[0] * v[0] + v[1] * v[1]) + (v[2] * v[2] + v[3] * v[3]); }
                    *(u32x4*)(Xp + o_) = regroup_h(U[ai][bj][m][0], U[ai][bj][m][1]);
                    if (A2) *(u32x4*)(Ap + o_) = regroup(U[ai][bj][m][0] * gs[bj][0], U[ai][bj][m][1] * gs[bj][1]); }
                if (A2) { ss += epi_shfl_xor(ss, 16, lane); ss += epi_shfl_xor(ss, 32, lane); if (fq == 0) atomicAdd(rowss_next + prow + (int)rl + ai * HALF + m * 16, qgrid<QG_ROWSS>(ss)); } }
        }
        return;
        }
        {
            char* base = (char*)(slab + ((size_t)u.slab * 1024 + (prow - 8192)) * LDC);
#pragma unroll
            for (int ai = 0; ai < 2; ++ai)
#pragma unroll
                for (int m = 0; m < 4; ++m)
#pragma unroll
                    for (int bj = 0; bj < 2; ++bj) *(u32x4*)(base + (ob + (unsigned)((ai * HALF + m * 16) * LDC + bj * HALF) * 2u)) = regroup(U[ai][bj][m][0], U[ai][bj][m][1]);
        }
    }
};
struct EpiSguIn {
    static constexpr bool PERM = true, AFTER_DRAIN = false;
    bf16_t* O; int ldc; const float* bias; const float* rowss; const float* bias2; int ldb; float* stat; int vcol0;
    __device__ __forceinline__ void operator()(const f32x4 (&acc)[2][2][4][2], const Unit& u, int wr, int wc, int fr, int fq) const {
        const int prow = u.pm * BM, row0 = prow + wr * 64 + fr, col0 = u.pn * BM + wc * 32 + 8 * fq, bidx = prow < 8192 ? (prow >> 11) : 4, lane = fq * 16 + fr;
        const bool vhalf = u.pn * BM >= vcol0;
        f32x4 bv[2][2];
#pragma unroll
        for (int bj = 0; bj < 2; ++bj)
#pragma unroll
            for (int n = 0; n < 2; ++n) bv[bj][n] = *(const f32x4*)(bias2 + (size_t)bidx * ldb + col0 + bj * HALF + 4 * n) + *(const f32x4*)(bias + col0 + bj * HALF + 4 * n);
#pragma unroll
        for (int ai = 0; ai < 2; ++ai)
#pragma unroll
            for (int m = 0; m < 4; ++m) { const int row = row0 + ai * HALF + m * 16; bf16_t* rowp = O + (size_t)row * ldc + col0;
                const float rs = __builtin_amdgcn_rsqf(rowss[row] * (1.0f / 2048.0f) + 1e-6f); float s1 = 0.f, s2 = 0.f;
#pragma unroll
                for (int bj = 0; bj < 2; ++bj) { f32x4 v0 = acc[ai][bj][m][0] * rs + bv[bj][0], v1 = acc[ai][bj][m][1] * rs + bv[bj][1];
                    { f32x2 a = gelu_pk((f32x2){v0[0], v0[1]}), b = gelu_pk((f32x2){v0[2], v0[3]}), c = gelu_pk((f32x2){v1[0], v1[1]}), d = gelu_pk((f32x2){v1[2], v1[3]});
                      v0 = (f32x4){a.x, a.y, b.x, b.y}; v1 = (f32x4){c.x, c.y, d.x, d.y}; }
                    s1 += (v0[0] + v0[1]) + (v0[2] + v0[3]) + (v1[0] + v1[1]) + (v1[2] + v1[3]);
                    s2 += (v0[0] * v0[0] + v0[1] * v0[1]) + (v0[2] * v0[2] + v0[3] * v0[3]) + (v1[0] * v1[0] + v1[1] * v1[1]) + (v1[2] * v1[2] + v1[3] * v1[3]);
                    u32x4 w; w.x = cvt_pk_bf16(v0[0], v0[1]); w.y = cvt_pk_bf16(v0[2], v0[3]); w.z = cvt_pk_bf16(v1[0], v1[1]); w.w = cvt_pk_bf16(v1[2], v1[3]);
                    *(u32x4*)(rowp + bj * HALF) = w; }
                if (vhalf) { s1 += epi_shfl_xor(s1, 16, lane); s1 += epi_shfl_xor(s1, 32, lane); s2 += epi_shfl_xor(s2, 16, lane); s2 += epi_shfl_xor(s2, 32, lane);
                    if (fq == 0) { atomicAdd(stat + 2 * row, qgrid<QG_SGST>(s1)); atomicAdd(stat + 2 * row + 1, qgrid<QG_SGST>(s2)); } } }
    }
};
struct EpiMlaIn {
    static constexpr bool PERM = false, AFTER_DRAIN = false;
    const float* rowss; const float* bias2; int ldb; const float* qn; const float* kvn; bf16_t* CQN; bf16_t* CKVN; bf16_t* KPE; float* sq; float* skv; const float* rope_c; const float* rope_s;
    __device__ __forceinline__ void operator()(const f32x4 (&acc)[2][2][4][2], const Unit& u, int wr, int wc, int fr, int fq) const {
        if (u.pn > 4) return;
        const int prow = u.pm * BM, col0 = u.pn * BM + wc * 32 + 4 * fq, bidx = prow < 8192 ? (prow >> 11) : 4, lane = fq * 16 + fr;
        if (u.pn < 4) {
            const bool isq = u.pn < 2; const int cb = isq ? col0 : col0 - 512; const float* gn = isq ? qn : kvn; bf16_t* dst = isq ? CQN : CKVN; float* ssd = isq ? sq : skv;
            f32x4 bv[2][2], gg[2][2];
#pragma unroll
            for (int bj = 0; bj < 2; ++bj)
#pragma unroll
                for (int n = 0; n < 2; ++n) { bv[bj][n] = *(const f32x4*)(bias2 + (size_t)bidx * ldb + col0 + bj * HALF + n * 16); gg[bj][n] = *(const f32x4*)(gn + cb + bj * HALF + n * 16); }
#pragma unroll
            for (int ai = 0; ai < 2; ++ai)
#pragma unroll
                for (int m = 0; m < 4; ++m) { const int row = prow + ai * HALF + wr * 64 + m * 16 + fr; const float rs = __builtin_amdgcn_rsqf(rowss[row] * (1.0f / 2048.0f) + 1e-6f); float ss = 0.f;
#pragma unroll
                    for (int bj = 0; bj < 2; ++bj)
#pragma unroll
                        for (int n = 0; n < 2; ++n) { const f32x4 v = acc[ai][bj][m][n] * rs + bv[bj][n]; ss += (v[0] * v[0] + v[1] * v[1]) + (v[2] * v[2] + v[3] * v[3]); const f32x4 h = v * gg[bj][n];
                            uint2 w; w.x = cvt_pk_bf16(h[0], h[1]); w.y = cvt_pk_bf16(h[2], h[3]); *(uint2*)(dst + (size_t)row * 512 + cb + bj * HALF + n * 16) = w; }
                    ss += epi_shfl_xor(ss, 16, lane); ss += epi_shfl_xor(ss, 32, lane); if (fq == 0) atomicAdd(ssd + row, qgrid<QG_MLSS>(4.0f * ss)); }
            return;
        }
        if (wc >= 2) return;
        const f32x4 b0 = *(const f32x4*)(bias2 + (size_t)bidx * ldb + col0), b1 = *(const f32x4*)(bias2 + (size_t)bidx * ldb + col0 + 16);
#pragma unroll
        for (int ai = 0; ai < 2; ++ai)
#pragma unroll
            for (int m = 0; m < 4; ++m) { const int row = prow + ai * HALF + wr * 64 + m * 16 + fr; const float rs = __builtin_amdgcn_rsqf(rowss[row] * (1.0f / 2048.0f) + 1e-6f);
                f32x4 u1 = acc[ai][0][m][0] * rs + b0, u2 = acc[ai][0][m][1] * rs + b1;
                if (row < 8192) { const int t = row & 2047, pos = wc ? (t & 63) : (t >> 6);
                    const f32x4 cs = *(const f32x4*)(rope_c + pos * 16 + 4 * fq), sn = *(const f32x4*)(rope_s + pos * 16 + 4 * fq);
                    const f32x4 o1 = u1 * cs - u2 * sn, o2 = u1 * sn + u2 * cs; u1 = o1; u2 = o2; }
                bf16_t* kp = KPE + (size_t)row * 64 + wc * 32 + 4 * fq;
                uint2 w; w.x = cvt_pk_bf16(u1[0], u1[1]); w.y = cvt_pk_bf16(u1[2], u1[3]); *(uint2*)kp = w;
                w.x = cvt_pk_bf16(u2[0], u2[1]); w.y = cvt_pk_bf16(u2[2], u2[3]); *(uint2*)(kp + 16) = w; }
    }
};
struct EpiConvF1 {
    static constexpr bool PERM = true, PERMA = true, AFTER_DRAIN = false;
    bf16_t* ACT; const float* rowss; const float* bias2; const float* cw; const float* cb; bf16_t* UE;
    template <int CTRL> static __device__ __forceinline__ f32x4 dpp4(const f32x4 v) { f32x4 r;
#pragma unroll
        for (int e = 0; e < 4; ++e) { const float t = v[e]; r[e] = __builtin_bit_cast(float, __builtin_amdgcn_mov_dpp(__builtin_bit_cast(int, t), CTRL, 0xf, 0xf, false)); }
        return r; }
    __device__ __forceinline__ void operator()(const f32x4 (&acc_)[2][2][4][2], const Unit& u, int wr, int wc, int fr, int fq) const {
        f32x4 (&U)[2][2][4][2] = const_cast<f32x4 (&)[2][2][4][2]>(acc_);
        const int prow = u.pm * BM, bidx = prow < 8192 ? (prow >> 11) : 4; int ja = u.pn * 128 + wc * 32 + 8 * fq;
        int r0 = prow + wr * 64 + 4 * fr;
        f32x4 bv[2][2], ss[2], wa[3], wg[3], ba, bg;
#define CONV_W(n) do { _Pragma("unroll") for (int k = 0; k < 3; ++k) { wa[k] = *(const f32x4*)(cw + (size_t)k * 11264 + ja + 4 * (n)); wg[k] = *(const f32x4*)(cw + (size_t)k * 11264 + 5632 + ja + 4 * (n)); } \
        ba = *(const f32x4*)(cb + ja + 4 * (n)); bg = *(const f32x4*)(cb + 5632 + ja + 4 * (n)); } while (0)
#pragma unroll
        for (int bj = 0; bj < 2; ++bj)
#pragma unroll
            for (int n = 0; n < 2; ++n) bv[bj][n] = *(const f32x4*)(bias2 + (size_t)bidx * 11264 + bj * 5632 + ja + 4 * n);
#pragma unroll
        for (int ai = 0; ai < 2; ++ai) ss[ai] = *(const f32x4*)(rowss + r0 + ai * HALF);
        CONV_W(0);
#pragma unroll
        for (int ai = 0; ai < 2; ++ai) {
#pragma unroll
            for (int m = 0; m < 4; ++m) { const float rs = __builtin_amdgcn_rsqf(ss[ai][m] * (1.0f / 2048.0f) + 1e-6f);
#pragma unroll
                for (int bj = 0; bj < 2; ++bj)
#pragma unroll
                    for (int n = 0; n < 2; ++n) U[ai][bj][m][n] = U[ai][bj][m][n] * rs + bv[bj][n]; } }
        if (fr == 0 || fr == 15) { const bool hi = fr == 15;
#pragma unroll
            for (int ai = 0; ai < 2; ++ai) { const int blk = (prow >> 6) + 2 * ai + wr;
#pragma unroll
                for (int mm = 0; mm < 2; ++mm) { bf16_t* p = UE + ((size_t)blk * 4 + (hi ? 2 + mm : mm)) * 11264 + ja;
#pragma unroll
                    for (int bj = 0; bj < 2; ++bj) { const f32x4 v0 = hi ? U[ai][bj][2 + mm][0] : U[ai][bj][mm][0], v1 = hi ? U[ai][bj][2 + mm][1] : U[ai][bj][mm][1];
                        u32x4 w; w.x = cvt_pk_bf16(v0[0], v0[1]); w.y = cvt_pk_bf16(v0[2], v0[3]); w.z = cvt_pk_bf16(v1[0], v1[1]); w.w = cvt_pk_bf16(v1[2], v1[3]);
                        *(u32x4*)(p + bj * 5632) = w; } } } }
        uint2 pk[2][4];
        float nl2e = -1.4426950408889634f; asm volatile("" : "+v"(nl2e));
#pragma unroll
        for (int n = 0; n < 2; ++n) {
            if (n == 1) CONV_W(1);
#pragma unroll
            for (int ai = 0; ai < 2; ++ai) {
#pragma unroll
                for (int m = 0; m < 4; ++m) {
                    const f32x4 pa = m > 0 ? U[ai][0][m > 0 ? m - 1 : 0][n] : dpp4<0x121>(U[ai][0][3][n]), pg = m > 0 ? U[ai][1][m > 0 ? m - 1 : 0][n] : dpp4<0x121>(U[ai][1][3][n]);
                    const f32x4 na = m < 3 ? U[ai][0][m < 3 ? m + 1 : 3][n] : dpp4<0x12F>(U[ai][0][0][n]), ng = m < 3 ? U[ai][1][m < 3 ? m + 1 : 3][n] : dpp4<0x12F>(U[ai][1][0][n]);
                    const f32x4 a = __builtin_elementwise_fma(wa[2], na, __builtin_elementwise_fma(wa[1], U[ai][0][m][n], __builtin_elementwise_fma(wa[0], pa, ba)));
                    const f32x4 g = __builtin_elementwise_fma(wg[2], ng, __builtin_elementwise_fma(wg[1], U[ai][1][m][n], __builtin_elementwise_fma(wg[0], pg, bg)));
                    const f32x4 x = g * nl2e; f32x4 d;
#pragma unroll
                    for (int e = 0; e < 4; ++e) d[e] = __builtin_amdgcn_exp2f(x[e]);
                    d = d + 1.f;
#pragma unroll
                    for (int e = 0; e < 4; ++e) d[e] = __builtin_amdgcn_rcpf(d[e]);
                    const f32x4 o = a * (g * d);
                    if (n == 0) { pk[ai][m].x = cvt_pk_bf16(o[0], o[1]); pk[ai][m].y = cvt_pk_bf16(o[2], o[3]); }
                    else { u32x4 w; w.x = pk[ai][m].x; w.y = pk[ai][m].y; w.z = cvt_pk_bf16(o[0], o[1]); w.w = cvt_pk_bf16(o[2], o[3]);
                        const bool edge = (m == 0 && fr == 0) || (m == 3 && fr == 15);
                        if (!edge) *(u32x4*)(ACT + (size_t)(r0 + ai * HALF + m) * 5632 + ja) = w; } } }
        }
#undef CONV_W
#ifdef PROBE_EPI2
        }
#endif
    }
};
struct DualOrder {
    StaticOrder s0, s1; int G, c;
    __device__ __forceinline__ void init(int M, int N0, int N1, int G_, int c_) { s0.init(M, N0, G_, c_); s1.init(M, N1, G_, c_); G = G_; c = c_; }
    __device__ __forceinline__ bool get(int i, int& pm, int& pn, int& kt0, int& nt, int& slab) const {
        const long L = (long)i * G + c; kt0 = 0; nt = 0;
        if (L < s0.nwg) { slab = 0; return s0.by_index(L, pm, pn); }
        slab = 1; return s1.by_index(L - s0.nwg, pm, pn);
    }
    __device__ __forceinline__ void a_ready(const Unit&) const {}
    __device__ __forceinline__ void done(const Unit&) const {}
};
struct EpiMlaUp {
    static constexpr bool PERM = true, AFTER_DRAIN = false;
    bf16_t* O0; int ldc0; const float* rss0; bf16_t* O1; int ldc1; const float* rss1;
    __device__ __forceinline__ void operator()(const f32x4 (&acc)[2][2][4][2], const Unit& u, int wr, int wc, int fr, int fq) const {
        bf16_t* O = u.slab ? O1 : O0; const int ldc = u.slab ? ldc1 : ldc0; const float* rss = u.slab ? rss1 : rss0;
        const int row0 = u.pm * BM + wr * 64 + fr, col0 = u.pn * BM + wc * 32 + 8 * fq;
#pragma unroll
        for (int ai = 0; ai < 2; ++ai)
#pragma unroll
            for (int m = 0; m < 4; ++m) { const int row = row0 + ai * HALF + m * 16; bf16_t* rowp = O + (size_t)row * ldc + col0;
                const float rs = __builtin_amdgcn_rsqf(rss[row] * (1.0f / 2048.0f) + 1e-6f);
#pragma unroll
                for (int bj = 0; bj < 2; ++bj) { const f32x4 v0 = acc[ai][bj][m][0] * rs, v1 = acc[ai][bj][m][1] * rs;
                    u32x4 w; w.x = cvt_pk_bf16(v0[0], v0[1]); w.y = cvt_pk_bf16(v0[2], v0[3]); w.z = cvt_pk_bf16(v1[0], v1[1]); w.w = cvt_pk_bf16(v1[2], v1[3]);
                    *(u32x4*)(rowp + bj * HALF) = w; } }
    }
};
}
#define GAS __attribute__((address_space(1)))
#define LAS __attribute__((address_space(3)))
typedef unsigned short bf16;
typedef unsigned v4u __attribute__((ext_vector_type(4)));
typedef float f32x4 __attribute__((ext_vector_type(4)));
typedef short bf16x8 __attribute__((ext_vector_type(8)));
typedef GAS unsigned gu32;
typedef GAS unsigned long long gu64;
#define RLX_AGENT __ATOMIC_RELAXED, __HIP_MEMORY_SCOPE_AGENT
#define LDS_WAIT() asm volatile("s_waitcnt lgkmcnt(0)" ::: "memory")
#define VM_WAIT() asm volatile("s_waitcnt vmcnt(0)" ::: "memory")
__device__ __forceinline__ unsigned long long rt() { return __builtin_amdgcn_s_memrealtime(); }
__device__ __forceinline__ unsigned f2bf(float f) { unsigned u = __builtin_bit_cast(unsigned, f); return (u + 0x7fffu + ((u >> 16) & 1u)) >> 16; }
__device__ __forceinline__ unsigned pk2(float lo, float hi) { return f2bf(lo) | (f2bf(hi) << 16); }

#define XB_TMO      128
#define XB_XCNT(j)  (256  + 64 * (j))
#define XB_XSUB(j)  (1280 + 64 * (j))
#define XB_XGEN(j)  (2304 + 64 * (j))
#define XB_TOP      3328
#define XB_TOPGEN   3392
#define XCD_BAR_WORDS 3456
#define XB_SPIN_CAP (1u << 18)

__device__ __forceinline__ unsigned xb_ld(unsigned* p)              { return __hip_atomic_load(p, __ATOMIC_RELAXED, __HIP_MEMORY_SCOPE_AGENT); }
__device__ __forceinline__ unsigned xb_add(unsigned* p, unsigned v) { return __hip_atomic_fetch_add(p, v, __ATOMIC_RELAXED, __HIP_MEMORY_SCOPE_AGENT); }
__device__ __forceinline__ unsigned xb_xcc_id() { return (unsigned)__builtin_amdgcn_s_getreg((3 << 11) | 20) & 0xFu; }
#define XB_SPIN(cond, bar) do { unsigned _sp = 0; while (cond) { __builtin_amdgcn_s_sleep(1); \
    if ((++_sp & 255u) == 0u) { if (xb_ld(&(bar)[XB_TMO])) break; if (_sp > XB_SPIN_CAP) { atomicAdd(&(bar)[XB_TMO], 1u); break; } } } } while (0)

struct XcdBarrier {
    unsigned* bar; unsigned x;
    volatile LAS unsigned* st;
};

__device__ __forceinline__ XcdBarrier xcd_barrier_post(unsigned* bar, volatile LAS unsigned* st) {
    XcdBarrier b; b.bar = bar; b.x = xb_xcc_id(); b.st = st;
    if (threadIdx.x == 0) (void)xb_add(&bar[XB_XCNT(b.x)], 1u);
    return b;
}
__device__ __forceinline__ void xcd_barrier_complete(unsigned* bar, unsigned x, unsigned& nloc, unsigned& nx) {
    const unsigned G = gridDim.x * gridDim.y * gridDim.z;
    unsigned sum, cnt, mine, sp = 0u;
    for (;;) {
        sum = 0u; cnt = 0u; mine = 0u;
#pragma unroll
        for (unsigned j = 0; j < 16; ++j) { const unsigned c = xb_ld(&bar[XB_XCNT(j)]); sum += c; cnt += (c > 0u) ? 1u : 0u; mine = (j == x) ? c : mine; }
        if (sum == G) break;
        __builtin_amdgcn_s_sleep(1);
        if ((++sp & 255u) == 0u) { if (xb_ld(&bar[XB_TMO])) break; if (sp > XB_SPIN_CAP) { atomicAdd(&bar[XB_TMO], 1u); break; } }
    }
    nloc = mine > 0u ? mine : 1u; nx = cnt > 0u ? cnt : 1u;
}

__device__ __forceinline__ void xcd_barrier(const XcdBarrier& b) {
    asm volatile("s_waitcnt vmcnt(0)" ::: "memory");
    __syncthreads();
    if (threadIdx.x == 0) {
        unsigned* bar = b.bar;
        __builtin_amdgcn_s_waitcnt(0);
        unsigned nloc = b.st[0], nx = b.st[1];
        if (nloc == 0u) { xcd_barrier_complete(bar, b.x, nloc, nx); b.st[0] = nloc; b.st[1] = nx; }
        const unsigned old = xb_add(&bar[XB_XSUB(b.x)], 1u);
        const unsigned gen = old / nloc;
        if (old + 1u == (gen + 1u) * nloc) {
            __builtin_amdgcn_fence(__ATOMIC_RELEASE, "agent");
            asm volatile("s_waitcnt vmcnt(0)" ::: "memory");
            const unsigned og = xb_add(&bar[XB_TOP], 1u);
            const unsigned tg = og / nx;
            if (og + 1u == (tg + 1u) * nx) xb_add(&bar[XB_TOPGEN], 1u);
            else XB_SPIN(xb_ld(&bar[XB_TOPGEN]) == tg, bar);
            __builtin_amdgcn_fence(__ATOMIC_ACQUIRE, "agent");
            xb_add(&bar[XB_XGEN(b.x)], 1u);
            asm volatile("s_waitcnt vmcnt(0)" ::: "memory");
        } else {
            XB_SPIN(xb_ld(&bar[XB_XGEN(b.x)]) == gen, bar);
            __builtin_amdgcn_fence(__ATOMIC_ACQUIRE, "agent");
            asm volatile("s_waitcnt vmcnt(0)" ::: "memory");
        }
    }
    __syncthreads();
}
namespace att {
#define ALAS __attribute__((address_space(3)))
using bf16x8 = __attribute__((ext_vector_type(8))) short;
using s16x4  = __attribute__((ext_vector_type(4))) short;
using f32x16 = __attribute__((ext_vector_type(16))) float;
using f32x4  = __attribute__((ext_vector_type(4))) float;
using u32x4  = __attribute__((ext_vector_type(4))) unsigned;
typedef unsigned short bf16_t;
#define SBAR() __builtin_amdgcn_sched_barrier(0)
__device__ __forceinline__ int crow(int r, int hi) { return (r & 3) + 8 * (r >> 2) + 4 * hi; }
__device__ __forceinline__ unsigned cvtpk(float lo, float hi) { unsigned r; asm volatile("v_cvt_pk_bf16_f32 %0, %1, %2" : "=v"(r) : "v"(lo), "v"(hi)); return r; }
__device__ __forceinline__ float bf2f(short s) { return __uint_as_float(((unsigned)(unsigned short)s) << 16); }
__device__ __forceinline__ int iclamp(int v, int lo, int hi) { return v < lo ? lo : (v > hi ? hi : v); }
__device__ __forceinline__ int swz_g3(int row) { return ((row >> 1) & 1) | (((row >> 3) & 1) << 1) | (((row >> 4) & 1) << 2); }
template <int DQK> __device__ __forceinline__ int kswz(int row, int colB) {
  const int chunk = colB >> 4, within = colB & 15; int c2;
  if (DQK == 128) c2 = chunk ^ (row & 15);
  else c2 = chunk < 16 ? (chunk ^ ((row & 15) ^ ((row & 1) << 3))) : (16 + ((chunk - 16) ^ swz_g3(row)));
  return row * (DQK * 2) + (c2 << 4) + within; }
__device__ __forceinline__ int v_st(int k, int c) { const int kk = (k & ~0xC) | ((k & 4) << 1) | ((k & 8) >> 1); return ((kk >> 3) * 4 + (c >> 5)) * 512 + ((kk & 7) * 32 + (c & 31)) * 2; }
__device__ __forceinline__ int v_rd_base(int lane) { return ((lane & 3) << 3) | (((lane >> 2) & 3) << 6) | (((lane >> 4) & 1) << 5) | (((lane >> 5) & 1) << 8); }
constexpr int v_rd_off(int d0, int ks, int half) { return d0 * 512 + ks * 4096 + half * 2048; }
template <int OFF> __device__ __forceinline__ s16x4 tr_read(int vb) { s16x4 r; asm volatile("ds_read_b64_tr_b16 %0, %1 offset:%2" : "=&v"(r) : "v"(vb), "i"(OFF) : "memory"); return r; }
struct VFrag { s16x4 l0, h0, l1, h1, l2, h2, l3, h3; };
template <int D0> __device__ __forceinline__ void v_issue(VFrag& f, int vb) {
  f.l0 = tr_read<v_rd_off(D0, 0, 0)>(vb); f.h0 = tr_read<v_rd_off(D0, 0, 1)>(vb); f.l1 = tr_read<v_rd_off(D0, 1, 0)>(vb); f.h1 = tr_read<v_rd_off(D0, 1, 1)>(vb);
  f.l2 = tr_read<v_rd_off(D0, 2, 0)>(vb); f.h2 = tr_read<v_rd_off(D0, 2, 1)>(vb); f.l3 = tr_read<v_rd_off(D0, 3, 0)>(vb); f.h3 = tr_read<v_rd_off(D0, 3, 1)>(vb);
}
__device__ __forceinline__ void v_mma(f32x16& od, const VFrag& f, bf16x8 pa0, bf16x8 pa1, bf16x8 pa2, bf16x8 pa3) {
#define ATT_PK(L, H) (bf16x8){L[0], L[1], L[2], L[3], H[0], H[1], H[2], H[3]}
  od = __builtin_amdgcn_mfma_f32_32x32x16_bf16(pa0, ATT_PK(f.l0, f.h0), od, 0, 0, 0);
  od = __builtin_amdgcn_mfma_f32_32x32x16_bf16(pa1, ATT_PK(f.l1, f.h1), od, 0, 0, 0);
  od = __builtin_amdgcn_mfma_f32_32x32x16_bf16(pa2, ATT_PK(f.l2, f.h2), od, 0, 0, 0);
  od = __builtin_amdgcn_mfma_f32_32x32x16_bf16(pa3, ATT_PK(f.l3, f.h3), od, 0, 0, 0);
#undef ATT_PK
}
template <int D0> __device__ __forceinline__ void pv_one(f32x16& od, int vb, bf16x8 pa0, bf16x8 pa1, bf16x8 pa2, bf16x8 pa3) {
  VFrag f; v_issue<D0>(f, vb); asm volatile("s_waitcnt lgkmcnt(0)" ::: "memory"); SBAR(); v_mma(od, f, pa0, pa1, pa2, pa3);
}
__device__ __forceinline__ void pv_d0(f32x16* o, int vb, bf16x8 pa0, bf16x8 pa1, bf16x8 pa2, bf16x8 pa3) {
  VFrag fa, fb;
  v_issue<0>(fa, vb); v_issue<1>(fb, vb);
  asm volatile("s_waitcnt lgkmcnt(8)" ::: "memory"); SBAR(); v_mma(o[0], fa, pa0, pa1, pa2, pa3); SBAR();
  v_issue<2>(fa, vb);
  asm volatile("s_waitcnt lgkmcnt(8)" ::: "memory"); SBAR(); v_mma(o[1], fb, pa0, pa1, pa2, pa3); SBAR();
  v_issue<3>(fb, vb);
  asm volatile("s_waitcnt lgkmcnt(8)" ::: "memory"); SBAR(); v_mma(o[2], fa, pa0, pa1, pa2, pa3); SBAR();
  asm volatile("s_waitcnt lgkmcnt(0)" ::: "memory"); SBAR(); v_mma(o[3], fb, pa0, pa1, pa2, pa3);
}
template <int DQK> __device__ __forceinline__ void qkt(f32x16& p0, f32x16& p1, const ALAS char* Ks, const bf16x8* qr, const ALAS char* qls, int r32, int hi) {
  p0 = f32x16{}; p1 = f32x16{};
  if constexpr (DQK != 128) {
#pragma unroll
    for (int d0 = 0; d0 < DQK / 16; ++d0) { const int cb = (d0 * 16 + hi * 8) * 2;
      const bf16x8 b0 = *(const ALAS bf16x8*)(Ks + kswz<DQK>(r32, cb));
      const bf16x8 b1 = *(const ALAS bf16x8*)(Ks + kswz<DQK>(32 + r32, cb));
      bf16x8 q;
      if (d0 < 8) q = qr[d0 < 8 ? d0 : 0]; else q = *(const ALAS bf16x8*)(qls + (((2 * (d0 - 8) + hi) ^ swz_g3(r32)) << 4));
      p0 = __builtin_amdgcn_mfma_f32_32x32x16_bf16(b0, q, p0, 0, 0, 0);
      p1 = __builtin_amdgcn_mfma_f32_32x32x16_bf16(b1, q, p1, 0, 0, 0);
      if ((d0 & 3) == 3) SBAR(); }
    return;
  }
  constexpr int NG = DQK / 32;
  bf16x8 kb[2][4], qq[2][2];
#define QKT_LOAD(G, B) do { _Pragma("unroll") for (int e_ = 0; e_ < 2; ++e_) { const int d0_ = 2 * (G) + e_, cb_ = (d0_ * 16 + hi * 8) * 2; \
      kb[B][2 * e_] = *(const ALAS bf16x8*)(Ks + kswz<DQK>(r32, cb_)); kb[B][2 * e_ + 1] = *(const ALAS bf16x8*)(Ks + kswz<DQK>(32 + r32, cb_)); \
      if (d0_ >= 8) qq[B][e_] = *(const ALAS bf16x8*)(qls + (((2 * (d0_ - 8) + hi) ^ swz_g3(r32)) << 4)); } } while (0)
  QKT_LOAD(0, 0);
#pragma unroll
  for (int g = 0; g < NG; ++g) {
    if (g + 1 < NG) { if ((g + 1) & 1) QKT_LOAD(g + 1, 1); else QKT_LOAD(g + 1, 0); }
    SBAR();
#pragma unroll
    for (int e = 0; e < 2; ++e) { const int d0 = 2 * g + e; const bf16x8 q = d0 < 8 ? qr[d0 < 8 ? d0 : 0] : qq[g & 1][e];
      p0 = __builtin_amdgcn_mfma_f32_32x32x16_bf16(kb[g & 1][2 * e], q, p0, 0, 0, 0);
      p1 = __builtin_amdgcn_mfma_f32_32x32x16_bf16(kb[g & 1][2 * e + 1], q, p1, 0, 0, 0); }
    SBAR();
  }
#undef QKT_LOAD
}

constexpr int SHM_V = 16384;
constexpr int L_V = 0, L_K = 32768, L_WS = L_K + 2 * 24576, L_RPB = L_WS + 2048, L_QR = L_RPB + 2048, L_END = L_QR + 32768;

struct RopeTab { float c[64 * 16]; float s[64 * 16]; };
constexpr double c_exp(double x) { double y = x / 1024.0, t = 1.0, sum = 1.0; for (int i = 1; i < 24; ++i) { t *= y / i; sum += t; } for (int i = 0; i < 10; ++i) sum *= sum; return sum; }
constexpr double c_sin(double x) { const double tp = 6.283185307179586476925286766559; long long k = (long long)(x / tp); x -= (double)k * tp; if (x > tp / 2) x -= tp;
  double t = x, sum = x; for (int i = 1; i < 16; ++i) { t *= -x * x / ((2.0 * i) * (2.0 * i + 1.0)); sum += t; } return sum; }
constexpr double c_cos(double x) { const double tp = 6.283185307179586476925286766559; long long k = (long long)(x / tp); x -= (double)k * tp; if (x > tp / 2) x -= tp;
  double t = 1.0, sum = 1.0; for (int i = 1; i < 16; ++i) { t *= -x * x / ((2.0 * i - 1.0) * (2.0 * i)); sum += t; } return sum; }
constexpr RopeTab make_rope() { RopeTab r{}; for (int j = 0; j < 16; ++j) { const double f = (double)(float)c_exp(-(double)j / 16.0 * 9.2103403719761836);
    for (int p = 0; p < 64; ++p) { const double a = (double)(float)((double)p * f); r.c[p * 16 + j] = (float)c_cos(a); r.s[p * 16 + j] = (float)c_sin(a); } } return r; }
__device__ const RopeTab g_rope = make_rope();

struct AttnP {
  const bf16_t* Q;
  const bf16_t* K;
  const bf16_t* V;
  const bf16_t* KPE;
  bf16_t* O;
  const float* rpb;
};

template <int MODE> struct SmC { static constexpr float SCALE = MODE ? 0.07216878364870322f : 0.08838834764831845f, C = SCALE * 1.4426950408889634f, THRS = 8.0f / SCALE; };
template <int MODE> __device__ __forceinline__ void partialSM(f32x16& p0, f32x16& p1, float& m_reg, float& mn, float& alpha) {
  constexpr float C = SmC<MODE>::C;
  float pmax = p0[0];
#pragma unroll
  for (int r = 1; r < 16; ++r) pmax = fmaxf(pmax, p0[r]);
#pragma unroll
  for (int r = 0; r < 16; ++r) pmax = fmaxf(pmax, p1[r]);
  { auto rr = __builtin_amdgcn_permlane32_swap(__float_as_uint(pmax), __float_as_uint(pmax), false, false); pmax = fmaxf(__uint_as_float(rr[0]), __uint_as_float(rr[1])); }
  if (__builtin_expect(__all(pmax - m_reg <= SmC<MODE>::THRS), 1)) { mn = m_reg; alpha = 1.f; }
  else { mn = fmaxf(m_reg, pmax); alpha = __builtin_amdgcn_exp2f((m_reg - mn) * C); m_reg = mn; }
  const float mnC = -mn * C;
#pragma unroll
  for (int r = 0; r < 16; ++r) p0[r] = fmaf(p0[r], C, mnC);
#pragma unroll
  for (int r = 0; r < 16; ++r) p1[r] = fmaf(p1[r], C, mnC);
#pragma unroll
  for (int r = 0; r < 16; ++r) p0[r] = __builtin_amdgcn_exp2f(p0[r]);
}
__device__ __forceinline__ void finishSM(f32x16& p0, f32x16& p1, float alpha, float& l_reg, bf16x8& pa0, bf16x8& pa1, bf16x8& pa2, bf16x8& pa3) {
#pragma unroll
  for (int r = 0; r < 16; ++r) p1[r] = __builtin_amdgcn_exp2f(p1[r]);
  float ps = 0.f;
#pragma unroll
  for (int r = 0; r < 16; ++r) ps += p0[r];
#pragma unroll
  for (int r = 0; r < 16; ++r) ps += p1[r];
  { auto rr = __builtin_amdgcn_permlane32_swap(__float_as_uint(ps), __float_as_uint(ps), false, false); ps = __uint_as_float(rr[0]) + __uint_as_float(rr[1]); }
  l_reg = l_reg * alpha + ps;
#define ATT_PK4(PP, BASE, OUT) do { unsigned a0 = cvtpk(PP[BASE + 0], PP[BASE + 1]), a1 = cvtpk(PP[BASE + 2], PP[BASE + 3]); \
    unsigned b0 = cvtpk(PP[BASE + 4], PP[BASE + 5]), b1 = cvtpk(PP[BASE + 6], PP[BASE + 7]); \
    auto r0 = __builtin_amdgcn_permlane32_swap(a0, b0, false, false); auto r1 = __builtin_amdgcn_permlane32_swap(a1, b1, false, false); \
    u32x4 w = {r0[0], r1[0], r0[1], r1[1]}; OUT = __builtin_bit_cast(bf16x8, w); } while (0)
  ATT_PK4(p0, 0, pa0); ATT_PK4(p0, 8, pa1); ATT_PK4(p1, 0, pa2); ATT_PK4(p1, 8, pa3);
#undef ATT_PK4
}
__device__ __forceinline__ void na_mask(f32x16& p0, f32x16& p1, const ALAS float* rpbS, int base, int cs, int hi) {
#pragma unroll
  for (int r = 0; r < 16; ++r) { const int k0 = crow(r, hi), k1 = k0 + 32;
    const bool v0 = (k0 >= cs) && (k0 < cs + 16), v1 = (k1 >= cs) && (k1 < cs + 16);
    const float b0 = rpbS[v0 ? base + k0 : 0], b1 = rpbS[v1 ? base + k1 : 0];
    p0[r] = v0 ? p0[r] + b0 : -1e30f; p1[r] = v1 ? p1[r] + b1 : -1e30f; }
}

template <int MODE>
__device__ __forceinline__ void attn_unit(ALAS char* lds, const AttnP& P, int b, int h, int qb, bool ctxq) {
  constexpr int DQK = MODE ? 192 : 128, ND0 = DQK / 16, NKC = DQK / 64, SHM_K = 64 * DQK * 2;
  constexpr float SCALE = SmC<MODE>::SCALE;
  constexpr int LDQ = MODE ? 3072 : 6144, QHS = MODE ? 192 : 128, LDK = MODE ? 4096 : 6144, KHS = MODE ? 256 : 128, LDV = LDK, VHS = KHS;
  int tid_ = threadIdx.x; asm volatile("" : "+v"(tid_));
  const int tid = tid_, wid = __builtin_amdgcn_readfirstlane(tid >> 6), lane = tid & 63, r32 = lane & 31, hi = lane >> 5;
  ALAS char* V_lds = lds + L_V; ALAS char* K_lds = lds + L_K;
  ALAS float* wsf = (ALAS float*)(lds + L_WS) + wid * 64; ALAS float* li_l = wsf; ALAS float* al_l = wsf + 32;
  ALAS float* rpbS = (ALAS float*)(lds + L_RPB);
  const int qtok0 = ctxq ? 8192 + b * 256 : b * 2048 + qb * 256;
  const int ctok0 = 8192 + b * 256, ltok0 = b * 2048;
  int NT, lo = 0;
  if (ctxq) NT = 4; else if (MODE == 1) NT = 36; else { lo = iclamp(4 * qb - 4, 0, 24); NT = 4 + (iclamp(4 * qb - 1, 0, 24) + 7 - lo + 1); NT += NT & 1; }
  const bool band = (MODE == 0) && !ctxq;
#define TILE_TOK(t) (MODE == 1 ? (ctxq ? ctok0 + 64 * (t) : ((t) < 32 ? ltok0 + 64 * (t) : ctok0 + 64 * ((t) - 32))) : ((ctxq || (t) < 4) ? ctok0 + 64 * (t) : ltok0 + 64 * iclamp(lo + (t) - 4, 0, 31)))
  const int rq = 4 * qb + (wid >> 1), wq = 32 * (wid & 1) + r32, rs = iclamp(rq - 4, 0, 24), cs = iclamp(wq - 8, 0, 48);
#define NEED(t) (!(band && (t) >= 4) || ((lo + (t) - 4 >= rs) && (lo + (t) - 4 < rs + 8)))
  if (band) { for (int i = tid; i < 465; i += 512) rpbS[i] = P.rpb[h * 465 + i] * (1.0f / SCALE); }
  bf16x8 qr[8];
  const bf16_t* Qp = P.Q + (size_t)(qtok0 + wid * 32 + r32) * LDQ + h * QHS + hi * 8;
#pragma unroll
  for (int d0 = 0; d0 < 8; ++d0) qr[d0] = *(const bf16x8*)(Qp + d0 * 16);
  ALAS char* qls = lds + L_QR + (wid * 32 + r32) * 128;
  if constexpr (MODE == 1) {
    bf16x8 qe[4];
#pragma unroll
    for (int d = 0; d < 4; ++d) qe[d] = *(const bf16x8*)(Qp + (8 + d) * 16);
    if (!ctxq) {
      const int prow = 4 * qb + (wid >> 1), pcol = 32 * (wid & 1) + r32;
#pragma unroll
      for (int hh = 0; hh < 2; ++hh) { const int pos = hh ? pcol : prow; const float* ct = g_rope.c + pos * 16 + 8 * hi; const float* st = g_rope.s + pos * 16 + 8 * hi;
        const f32x4 c0 = *(const f32x4*)ct, c1 = *(const f32x4*)(ct + 4), s0 = *(const f32x4*)st, s1 = *(const f32x4*)(st + 4);
        float cc[8], ss[8];
#pragma unroll
        for (int e = 0; e < 4; ++e) { cc[e] = c0[e]; cc[4 + e] = c1[e]; ss[e] = s0[e]; ss[4 + e] = s1[e]; }
        unsigned w1[4], w2[4];
#pragma unroll
        for (int e = 0; e < 8; e += 2) {
          const float a0 = bf2f(qe[2 * hh][e]), a1 = bf2f(qe[2 * hh][e + 1]), b0 = bf2f(qe[2 * hh + 1][e]), b1 = bf2f(qe[2 * hh + 1][e + 1]);
          w1[e >> 1] = cvtpk(a0 * cc[e] - b0 * ss[e], a1 * cc[e + 1] - b1 * ss[e + 1]); w2[e >> 1] = cvtpk(a0 * ss[e] + b0 * cc[e], a1 * ss[e + 1] + b1 * cc[e + 1]); }
        u32x4 x1 = {w1[0], w1[1], w1[2], w1[3]}, x2 = {w2[0], w2[1], w2[2], w2[3]};
        qe[2 * hh] = __builtin_bit_cast(bf16x8, x1); qe[2 * hh + 1] = __builtin_bit_cast(bf16x8, x2); }
    }
#pragma unroll
    for (int d = 0; d < 4; ++d) *(ALAS bf16x8*)(qls + (((2 * d + hi) ^ swz_g3(r32)) << 4)) = qe[d];
  }
  constexpr int NKP = DQK / 64;
  int koff[NKP], voff[2]; bool kpe_[NKP];
#pragma unroll
  for (int pp = 0; pp < NKP; ++pp) { const int c = (wid * NKP + pp) * 64 + lane; kpe_[pp] = false;
    if constexpr (MODE == 0) { const int row = c >> 4, chunk = (c & 15) ^ (row & 15); koff[pp] = row * LDK + chunk * 8; }
    else { const int row = c / 24, c2 = c % 24; const int chunk = c2 < 16 ? (c2 ^ ((row & 15) ^ ((row & 1) << 3))) : (16 + ((c2 - 16) ^ swz_g3(row)));
      if (chunk < 16) koff[pp] = row * LDK + chunk * 8; else { koff[pp] = row * 64 + (chunk - 16) * 8; kpe_[pp] = true; } } }
#pragma unroll
  for (int pp = 0; pp < 2; ++pp) { const int c = (wid * 2 + pp) * 64 + lane, st = c >> 5, kk = (st >> 2) * 8 + ((c & 31) >> 2), col = (st & 3) * 32 + (c & 3) * 8;
    const int k = (kk & ~0xC) | ((kk & 4) << 1) | ((kk & 8) >> 1); voff[pp] = k * LDV + col; }
  const bf16_t* Vb = P.V + h * VHS; const bf16_t* Kb = P.K + h * KHS;
  const unsigned ldsK = (unsigned)(uintptr_t)K_lds + (unsigned)wid * NKP * 1024u, ldsV = (unsigned)(uintptr_t)V_lds + (unsigned)wid * 2048u;
  const int vb0 = (int)(uintptr_t)V_lds + v_rd_base(lane);
#define ATT_GLDS(SRC, DST) do { unsigned keep_; asm volatile("s_mov_b32 %0, m0\n\ts_mov_b32 m0, %2\n\ts_nop 0\n\tglobal_load_lds_dwordx4 %1, off\n\ts_mov_b32 m0, %0" : "=&s"(keep_) : "v"(SRC), "s"(DST) : "memory"); } while (0)
#define ATT_DMA_K(T, SLOT) do { const int tk_ = TILE_TOK(T); _Pragma("unroll") for (int pp_ = 0; pp_ < NKP; ++pp_) { \
      const bf16_t* src_ = (MODE == 1 && kpe_[pp_]) ? P.KPE + (size_t)tk_ * 64 + koff[pp_] : Kb + (size_t)tk_ * LDK + koff[pp_]; \
      ATT_GLDS(src_, (unsigned)__builtin_amdgcn_readfirstlane(ldsK + (SLOT) * SHM_K + pp_ * 1024)); } } while (0)
#define ATT_DMA_V(T, SLOT) do { const int tv_ = TILE_TOK(T); _Pragma("unroll") for (int pp_ = 0; pp_ < 2; ++pp_) \
      ATT_GLDS(Vb + (size_t)tv_ * LDV + voff[pp_], (unsigned)__builtin_amdgcn_readfirstlane(ldsV + (SLOT) * SHM_V + pp_ * 1024)); } while (0)
#define ATT_LAND() do { asm volatile("s_waitcnt vmcnt(0)" ::: "memory"); __syncthreads(); } while (0)
#define ATT_QK(PX0, PX1, BUF, T) do { const int t_ = (T); if (NEED(t_)) { qkt<DQK>(PX0, PX1, K_lds + (BUF) * SHM_K, qr, qls, r32, hi); \
      if (band && t_ >= 4) na_mask(PX0, PX1, rpbS, (lo + t_ - 4 - rq + 7) * 31 + 15 - wq, cs, hi); } } while (0)
#define ATT_PSM(PX0, PX1, MN, AL, T) do { if (NEED(T)) partialSM<MODE>(PX0, PX1, m_reg, MN, AL); else { AL = 1.f; MN = m_reg; } } while (0)
#define ATT_FSM(PX0, PX1, AL, T) do { if (NEED(T)) finishSM(PX0, PX1, AL, l_reg, pa0, pa1, pa2, pa3); } while (0)
#define ATT_RESC(a) do { if (__any((a) < 1.f)) { if (hi == 0) al_l[r32] = (a); asm volatile("s_waitcnt lgkmcnt(0)" ::: "memory"); \
    _Pragma("unroll") for (int r_ = 0; r_ < 16; ++r_) { const float a_ = al_l[crow(r_, hi)]; _Pragma("unroll") for (int d_ = 0; d_ < 4; ++d_) o[d_][r_] *= a_; } } } while (0)
  float m_reg = -1e30f, l_reg = 0.f; f32x16 o[4];
#pragma unroll
  for (int d = 0; d < 4; ++d) o[d] = f32x16{};
  f32x16 pA0, pA1, pB0, pB1; float mnA, mnB, alA, alB; bf16x8 pa0, pa1, pa2, pa3;
  ATT_DMA_K(0, 0); ATT_LAND();
  ATT_DMA_K(1, 1); ATT_DMA_V(0, 0);
  ATT_QK(pA0, pA1, 0, 0); ATT_PSM(pA0, pA1, mnA, alA, 0);
  ATT_LAND();
  for (int j = 1; j + 1 < NT; j += 2) {
    ATT_DMA_K(j + 1, 0); ATT_DMA_V(j, 1);
    SBAR(); ATT_QK(pB0, pB1, 1, j);
    ATT_FSM(pA0, pA1, alA, j - 1); SBAR();
    if (NEED(j - 1)) pv_d0(o, vb0, pa0, pa1, pa2, pa3);
    ATT_PSM(pB0, pB1, mnB, alB, j);
    ATT_LAND(); ATT_RESC(alB);
    if (j + 2 < NT) ATT_DMA_K(j + 2, 1);
    ATT_DMA_V(j + 1, 0);
    SBAR(); ATT_QK(pA0, pA1, 0, j + 1);
    ATT_FSM(pB0, pB1, alB, j); SBAR();
    if (NEED(j)) pv_d0(o, vb0 + SHM_V, pa0, pa1, pa2, pa3);
    ATT_PSM(pA0, pA1, mnA, alA, j + 1);
    ATT_LAND(); ATT_RESC(alA);
  }
  ATT_DMA_V(NT - 1, 1);
  SBAR(); ATT_QK(pB0, pB1, 1, NT - 1);
  ATT_FSM(pA0, pA1, alA, NT - 2); SBAR();
  if (NEED(NT - 2)) pv_d0(o, vb0, pa0, pa1, pa2, pa3);
  ATT_PSM(pB0, pB1, mnB, alB, NT - 1);
  ATT_LAND(); ATT_RESC(alB);
  ATT_FSM(pB0, pB1, alB, NT - 1); SBAR();
  if (NEED(NT - 1)) pv_d0(o, vb0 + SHM_V, pa0, pa1, pa2, pa3);
  if (hi == 0) li_l[r32] = l_reg;
  __syncthreads();
  { ALAS char* ost = lds + wid * 8704;
#pragma unroll
    for (int r = 0; r < 16; ++r) { const int orow = crow(r, hi); const float rl = __builtin_amdgcn_rcpf(li_l[orow]);
#pragma unroll
      for (int d0 = 0; d0 < 4; ++d0) *(ALAS unsigned short*)(ost + orow * 272 + (d0 * 32 + r32) * 2) = (unsigned short)(cvtpk(o[d0][r] * rl, 0.f) & 0xffffu); }
    asm volatile("s_waitcnt lgkmcnt(0)" ::: "memory");
    bf16_t* Ow = P.O + (size_t)(qtok0 + wid * 32) * 2048 + h * 128;
#pragma unroll
    for (int i = 0; i < 8; ++i) { const int c = lane + 64 * i, row = c >> 4, cc = c & 15;
      const u32x4 v = *(const ALAS u32x4*)(ost + row * 272 + cc * 16);
      *(u32x4*)(Ow + (size_t)row * 2048 + cc * 8) = v; } }
  __syncthreads();
#undef TILE_TOK
#undef NEED
#undef ATT_GLDS
#undef ATT_DMA_K
#undef ATT_DMA_V
#undef ATT_LAND
#undef ATT_QK
#undef ATT_PSM
#undef ATT_FSM
#undef ATT_RESC
}

__device__ __forceinline__ void sgu_mix_unit(ALAS char* lds, const bf16_t* UV, const float* stats, const float* ln_g, const float* ln_b, const bf16_t* WSB, const float* bs, bf16_t* O, int c, int g) {
  int tid_ = threadIdx.x; asm volatile("" : "+v"(tid_));
  const int tid = tid_, wid = __builtin_amdgcn_readfirstlane(tid >> 6), lane = tid & 63, r32 = lane & 31, hi = lane >> 5;
  const int sr = tid >> 4, sc = (tid & 15) * 8, tok0 = c * 128;
  float gc[8], bc[8];
  { const f32x4 g0 = *(const f32x4*)(ln_g + g * 128 + sc), g1 = *(const f32x4*)(ln_g + g * 128 + sc + 4), b0 = *(const f32x4*)(ln_b + g * 128 + sc), b1 = *(const f32x4*)(ln_b + g * 128 + sc + 4);
#pragma unroll
    for (int i = 0; i < 4; ++i) { gc[i] = g0[i]; gc[4 + i] = g1[i]; bc[i] = b0[i]; bc[4 + i] = b1[i]; } }
#pragma unroll
  for (int tl = 0; tl < 2; ++tl)
#pragma unroll
    for (int hf = 0; hf < 2; ++hf) { const int row = hf * 32 + sr, tok = tok0 + tl * 64 + row;
      const bf16x8 raw = *(const bf16x8*)(UV + (size_t)tok * 4096 + 2048 + g * 128 + sc);
      const float mu = stats[tok * 2] * (1.0f / 2048.0f), var_ = stats[tok * 2 + 1] * (1.0f / 2048.0f) - mu * mu, rstd = 1.0f / sqrtf((var_ > 0.f ? var_ : 0.f) + 1e-6f);
      unsigned w[4];
#pragma unroll
      for (int i = 0; i < 8; i += 2) { const float a = (bf2f(raw[i]) - mu) * rstd * gc[i] + bc[i], bq = (bf2f(raw[i + 1]) - mu) * rstd * gc[i + 1] + bc[i + 1]; w[i >> 1] = cvtpk(a, bq); }
      u32x4 ww = {w[0], w[1], w[2], w[3]};
      *(ALAS bf16x8*)(lds + tl * SHM_V + v_st(row, sc)) = __builtin_bit_cast(bf16x8, ww); }
  __syncthreads();
  const int wp = wid & 3, wd = wid >> 2;
  const bf16_t* Ap = WSB + ((size_t)g * 128 + 32 * wp + r32) * 128 + 8 * hi;
  f32x16 o0 = f32x16{}, o1 = f32x16{};
#pragma unroll
  for (int tl = 0; tl < 2; ++tl) {
    const bf16x8 pa0 = *(const bf16x8*)(Ap + tl * 64), pa1 = *(const bf16x8*)(Ap + tl * 64 + 16), pa2 = *(const bf16x8*)(Ap + tl * 64 + 32), pa3 = *(const bf16x8*)(Ap + tl * 64 + 48);
    const int vb = (int)(uintptr_t)(lds + tl * SHM_V) + v_rd_base(lane);
    if (wd == 0) { pv_one<0>(o0, vb, pa0, pa1, pa2, pa3); pv_one<1>(o1, vb, pa0, pa1, pa2, pa3); }
    else         { pv_one<2>(o0, vb, pa0, pa1, pa2, pa3); pv_one<3>(o1, vb, pa0, pa1, pa2, pa3); }
  }
  __syncthreads();
  { ALAS float* st = (ALAS float*)(lds + wid * 8448);
#pragma unroll
    for (int r = 0; r < 16; ++r) { const int pr = crow(r, hi); const float bsv = bs[g * 128 + 32 * wp + pr];
      st[pr * 66 + r32] = o0[r] + bsv; st[pr * 66 + 32 + r32] = o1[r] + bsv; }
    asm volatile("s_waitcnt lgkmcnt(0)" ::: "memory");
#pragma unroll
    for (int i = 0; i < 4; ++i) { const int c = lane + 64 * i, pr = c >> 3, cc = c & 7, tok = tok0 + 32 * wp + pr; const size_t col = (size_t)g * 128 + 64 * wd + 8 * cc;
      const ALAS float* sp = st + pr * 66 + 8 * cc;
      const u32x4 uw = *(const u32x4*)(UV + (size_t)tok * 4096 + col);
      const float m0 = sp[0], m1 = sp[1], m2 = sp[2], m3 = sp[3], m4 = sp[4], m5 = sp[5], m6 = sp[6], m7 = sp[7];
      u32x4 ow; ow.x = cvtpk(__uint_as_float(uw.x << 16) * m0, __uint_as_float(uw.x & 0xffff0000u) * m1); ow.y = cvtpk(__uint_as_float(uw.y << 16) * m2, __uint_as_float(uw.y & 0xffff0000u) * m3);
      ow.z = cvtpk(__uint_as_float(uw.z << 16) * m4, __uint_as_float(uw.z & 0xffff0000u) * m5); ow.w = cvtpk(__uint_as_float(uw.w << 16) * m6, __uint_as_float(uw.w & 0xffff0000u) * m7);
      *(u32x4*)(O + (size_t)tok * 2048 + col) = ow; } }
  __syncthreads();
}
#undef SBAR
}
#ifndef EN_MASK
#define EN_MASK 0x1ffff
#endif
#define EN(k) (((EN_MASK) >> (k)) & 1)
#ifndef REP_MASK
#define REP_MASK 0
#endif
#define REPS(k) ((((REP_MASK) >> (k)) & 1) ? 2 : 1)
constexpr int DM = 2048, NBATCH = 4, SEQ = 2048, DEPTH = 4, CTXL = 256;
constexpr int ML = NBATCH * SEQ, MC = NBATCH * CTXL, MT = ML + MC;
constexpr int DFF = 5632, DFF2 = 2 * DFF;
constexpr int NHEAD = 16;
constexpr int MLA_IN = 1088, MLA_INP = 1280, MLA_QN = 3072, MLA_KVN = 4096;
constexpr int SGU_N = 4096;
constexpr float EPS = 1e-6f;
constexpr int MODS_ROW = 6 * DM, MODS_LAYER = 5 * MODS_ROW;

enum { I_X = 0, I_C, I_CTX, I_CCTX, I_ADAW, I_ADAB, I_NORMG, I_FINALG, I_AQKV, I_AWO, I_ARPB, I_BWIN, I_BQN, I_BKVN, I_BUQ, I_BUKV, I_BWO,
       I_CWIN, I_CBIN, I_CLNG, I_CLNB, I_CWS, I_CBS, I_CWO, I_FWIN, I_FCW, I_FCB, I_FWOUT, N_IN };

constexpr size_t al256(size_t x) { return (x + 255) & ~(size_t)255; }
constexpr size_t WS_CTL = 0, CTL_ZERO_BYTES = 4u << 20;
constexpr size_t WS_MODS = 1u << 20;
static_assert(WS_MODS + (size_t)DEPTH * MODS_LAYER * 4 <= (2u << 20), "mods inside the zeroed region");
constexpr int B2_QKV = 0, B2_BIN = 2 * 5 * 6144, B2_CIN = B2_BIN + 5 * MLA_INP, B2_F1 = B2_CIN + 5 * SGU_N, B2_END = B2_F1 + 4 * 5 * DFF2;
constexpr size_t WS_BIAS2 = 2u << 20, WS_ROWSS = WS_BIAS2 + al256((size_t)B2_END * 4);
constexpr size_t WS_SGST = WS_ROWSS + al256((size_t)8 * MT * 4);
constexpr size_t WS_MLSS = WS_SGST + al256((size_t)MT * 2 * 4);
constexpr size_t WS_ZEROS = 262144;
static_assert(WS_MLSS + (size_t)2 * MT * 4 <= CTL_ZERO_BYTES && WS_ZEROS + 5 * 4096 * 4 <= WS_MODS, "zeroed-region map");
constexpr size_t WS_WT_QKV = CTL_ZERO_BYTES;
constexpr size_t WS_WT_AO  = WS_WT_QKV + al256((size_t)2 * 6144 * 2048 * 2);
constexpr size_t WS_WT_BIN = WS_WT_AO + al256((size_t)2 * 2048 * 2048 * 2);
constexpr size_t WS_WT_UQ  = WS_WT_BIN + al256((size_t)MLA_INP * 2048 * 2);
constexpr size_t WS_WT_UKV = WS_WT_UQ + al256((size_t)3072 * 512 * 2);
constexpr size_t WS_WT_BO  = WS_WT_UKV + al256((size_t)4096 * 512 * 2);
constexpr size_t WS_WT_CIN = WS_WT_BO + al256((size_t)2048 * 2048 * 2);
constexpr size_t WS_WT_CO  = WS_WT_CIN + al256((size_t)4096 * 2048 * 2);
constexpr size_t WS_WT_F1  = WS_WT_CO + al256((size_t)2048 * 2048 * 2);
constexpr size_t WS_WT_F2  = WS_WT_F1 + al256((size_t)4 * DFF2 * 2048 * 2);
constexpr size_t WS_WSB    = WS_WT_F2 + al256((size_t)4 * 2048 * DFF * 2);
constexpr size_t WS_X      = WS_WSB + al256((size_t)16 * 128 * 128 * 2);
constexpr size_t WS_H      = WS_X + al256((size_t)MT * DM * 4);
constexpr size_t WS_QKV    = WS_H + al256((size_t)MT * DM * 2);
constexpr size_t WS_KV     = WS_QKV + al256((size_t)MT * MLA_QN * 2);
constexpr size_t WS_CW     = WS_QKV + al256((size_t)MT * (MLA_QN + MLA_KVN) * 2);
constexpr size_t WS_CQN    = WS_CW + al256((size_t)MT * MLA_INP * 4);
constexpr size_t WS_CKVN   = WS_CQN + al256((size_t)MT * 512 * 2);
constexpr size_t WS_KPE    = WS_CKVN + al256((size_t)MT * 512 * 2);
constexpr size_t WS_STATS  = WS_KPE + al256((size_t)MT * 64 * 2);
constexpr size_t WS_O      = WS_STATS + al256((size_t)MT * 2 * 4);
constexpr size_t WS_U      = WS_O + al256((size_t)MT * DM * 2);
constexpr size_t WS_ACT    = WS_U + al256((size_t)MT * DFF2 * 2);
constexpr size_t WS_UE     = WS_ACT + al256((size_t)MT * DFF * 2);
constexpr size_t WS_SLAB   = WS_UE + al256((size_t)(MT / 64) * 4 * DFF2 * 2);
constexpr size_t WS_END    = WS_SLAB + al256((size_t)8 * MC * DM * 4);
static_assert((size_t)MT * 6144 * 2 <= (size_t)MT * (MLA_QN + MLA_KVN) * 2, "NA QKV fits the shared region");
constexpr int CW_BAR = 4096;

constexpr int NWAVES = 8, NTHREADS = 512;
constexpr int RING_BYTES = 131072, LDSCTL_OFF = RING_BYTES, MISC_OFF = LDSCTL_OFF + 320, LDS_BYTES = 147456;
static_assert(att::L_END <= RING_BYTES && pg8::STAGE_BYTES <= RING_BYTES, "phase scratch fits");

constexpr int STEPS_PER_LAYER = 11, STEP_L0 = 2, STEP_FINAL = STEP_L0 + DEPTH * STEPS_PER_LAYER, N_STEPS = STEP_FINAL + 1;
__host__ __device__ constexpr bool step_used(int kind, int s) { return kind == 0 ? (s != 3 && s != 4 && s != 5) : (kind == 2 ? (s != 2 && s != 4 && s != 5) : (s != 2 && s != 4)); }

struct Args { const float* in[N_IN]; float* out; unsigned char* ws; int step_lo, step_hi; };
static_assert(sizeof(Args) == N_IN * 8 + 8 + 8 + 8, "Args has no padding");

struct Frame {
    LAS unsigned char* lds;
    int tid, lane, wave, G, gw, NGW;
};

typedef LAS unsigned long long* ArgTab;
__device__ __forceinline__ const float* inp(ArgTab ap, int i) { const unsigned long long v = ap[i]; const unsigned lo = __builtin_amdgcn_readfirstlane((unsigned)v), hi = __builtin_amdgcn_readfirstlane((unsigned)(v >> 32)); return (const float*)(const GAS float*)(((unsigned long long)hi << 32) | lo); }
constexpr int AP_OUT = N_IN, AP_WS = N_IN + 1;
__device__ __forceinline__ unsigned char* wsp(ArgTab ap) { return (unsigned char*)inp(ap, AP_WS); }
__device__ __forceinline__ float shfl_xor_l(float v, int mask, int lane) { return __builtin_bit_cast(float, __builtin_amdgcn_ds_bpermute((lane ^ mask) << 2, __builtin_bit_cast(int, v))); }
__device__ __forceinline__ float wave_sum(float v, int lane) {
#pragma unroll
    for (int o = 1; o < 64; o <<= 1) v += shfl_xor_l(v, o, lane);
    return v;
}
__device__ __forceinline__ unsigned cvt_pk(float lo, float hi) { unsigned r; asm volatile("v_cvt_pk_bf16_f32 %0, %1, %2" : "=v"(r) : "v"(lo), "v"(hi)); return r; }
__device__ __forceinline__ float bf_lo(unsigned w) { return __uint_as_float(w << 16); }
__device__ __forceinline__ float bf_hi(unsigned w) { return __uint_as_float(w & 0xffff0000u); }

__device__ __forceinline__ void transpose_item(const float* W, int K, int N, bf16* WT, LAS unsigned* scr, int item, int lane, const LAS float* sh, float (&bs)[5], bool perm) {
    const int nblk = N / 64, kb = item / nblk, nb = item % nblk, k0 = 64 * kb, n0 = 64 * nb;
    const int nbg = nb >= 88 ? nb - 88 : nb, d0 = perm ? (nbg >> 1) * 256 + (nb >= 88 ? 128 : 0) + (nbg & 1) * 64 : n0;
    const float* src = W + (size_t)k0 * N + n0 + lane;
    float v[64];
#pragma unroll
    for (int i = 0; i < 64; ++i) v[i] = __builtin_nontemporal_load(src + (size_t)i * N);
    if (sh) {
#pragma unroll
        for (int b = 0; b < 5; ++b) { const LAS f32x4* sp = (const LAS f32x4*)(sh + b * 2048 + k0); float a = 0.f;
#pragma unroll
            for (int i = 0; i < 16; ++i) { const f32x4 q = sp[i]; a = fmaf(v[4 * i], q.x, a); a = fmaf(v[4 * i + 1], q.y, a); a = fmaf(v[4 * i + 2], q.z, a); a = fmaf(v[4 * i + 3], q.w, a); }
            bs[b] = a; }
    }
#pragma unroll
    for (int i = 0; i < 32; ++i) scr[i * 64 + (lane ^ i)] = cvt_pk(v[2 * i], v[2 * i + 1]);
    LDS_WAIT(); asm volatile("" ::: "memory");
    const int c = lane & 7;
#pragma unroll
    for (int j = 0; j < 8; ++j) { const int n = (lane >> 3) + 8 * j;
        v4u o; o.x = scr[(4 * c + 0) * 64 + (n ^ (4 * c + 0))]; o.y = scr[(4 * c + 1) * 64 + (n ^ (4 * c + 1))]; o.z = scr[(4 * c + 2) * 64 + (n ^ (4 * c + 2))]; o.w = scr[(4 * c + 3) * 64 + (n ^ (4 * c + 3))];
        *(v4u*)(WT + (size_t)(d0 + n) * K + k0 + 8 * c) = o; }
    LDS_WAIT(); asm volatile("" ::: "memory");
}
__device__ __forceinline__ void transpose_matrix(Frame& F, const float* W, int K, int N, bf16* WT, LAS unsigned* scr, int& it, const float* sh, float* b2, int ldb, int nranks, bool perm) {
    const int KG = K / 512, NB = N / 64, nsup = KG * NB;
    LAS float* red = (LAS float*)(F.lds + 65536);
    LAS float* shl = (LAS float*)(F.lds + 81920);
    if (sh) { for (int i = F.tid; i < 5 * 2048; i += NTHREADS) shl[i] = sh[(size_t)(i >> 11) * MODS_ROW + (i & 2047)]; __syncthreads(); }
    for (; it < nsup; it += nranks) { const int nb = it / KG, kg = (it % KG + nb) % KG; float bs[5] = {0.f, 0.f, 0.f, 0.f, 0.f};
        transpose_item(W, K, N, WT, scr, (kg * 8 + F.wave) * NB + nb, F.lane, sh ? shl : (const LAS float*)nullptr, bs, perm);
        if (sh) {
#pragma unroll
            for (int b = 0; b < 5; ++b) red[(F.wave * 5 + b) * 64 + F.lane] = bs[b];
            __syncthreads();
            if (F.tid < 320) { const int b = F.tid >> 6, l = F.tid & 63; float a = 0.f;
#pragma unroll
                for (int w = 0; w < 8; ++w) a += red[(w * 5 + b) * 64 + l];
                atomicAdd(b2 + (size_t)b * ldb + nb * 64 + l, pg8::qgrid<pg8::QG_BIAS2>(a)); }
            __syncthreads();
        } }
    it -= nsup;
}

__device__ __forceinline__ void helper_ada(Frame& F, ArgTab a, int rank, int nranks) {
    unsigned char* ws = wsp(a);
    LAS float* S = (LAS float*)F.lds;
    for (int i = F.tid; i < 5 * DM; i += NTHREADS) { const float v = i < 4 * DM ? inp(a, I_C)[i] : inp(a, I_CCTX)[i - 4 * DM]; S[i] = v / (1.f + __expf(-v)); }
    __syncthreads();
    float* mods = (float*)(ws + WS_MODS);
    constexpr int NCB = MODS_ROW / 256, NKC = DM / 128, NTASK = DEPTH * NCB * NKC;
    for (int tk = rank * NWAVES + F.wave; tk < NTASK; tk += nranks * NWAVES) {
        const int kc = tk % NKC, cb = (tk / NKC) % NCB, l = tk / (NKC * NCB);
        const int n = cb * 256 + F.lane * 4, k0 = kc * 128;
        const float* wp = inp(a, I_ADAW) + ((size_t)l * DM + k0) * MODS_ROW + n;
        f32x4 acc[5];
#pragma unroll
        for (int r = 0; r < 5; ++r) acc[r] = (f32x4){0.f, 0.f, 0.f, 0.f};
        for (int kb = 0; kb < 128; kb += 32) { f32x4 w[32];
#pragma unroll
          for (int k = 0; k < 32; ++k) w[k] = __builtin_nontemporal_load((const f32x4*)(wp + (size_t)(kb + k) * MODS_ROW));
#pragma unroll
          for (int k = 0; k < 32; ++k)
#pragma unroll
            for (int r = 0; r < 5; ++r) acc[r] = acc[r] + w[k] * S[r * DM + k0 + kb + k]; }
        if (kc == 0) { const f32x4 bv = *(const f32x4*)(inp(a, I_ADAB) + (size_t)l * MODS_ROW + n);
#pragma unroll
          for (int r = 0; r < 5; ++r) acc[r] = acc[r] + bv; }
#pragma unroll
        for (int r = 0; r < 5; ++r) { float* mp = mods + ((size_t)l * 5 + r) * MODS_ROW + n;
          atomicAdd(mp + 0, pg8::qgrid<pg8::QG_MODS>(acc[r].x)); atomicAdd(mp + 1, pg8::qgrid<pg8::QG_MODS>(acc[r].y)); atomicAdd(mp + 2, pg8::qgrid<pg8::QG_MODS>(acc[r].z)); atomicAdd(mp + 3, pg8::qgrid<pg8::QG_MODS>(acc[r].w)); }
    }
    __syncthreads();
}
__device__ __forceinline__ void helper_wsb(Frame& F, ArgTab a) {
    const int gt = F.gw * 64 + F.lane, NGT = F.NGW * 64;
    const float* wsf = inp(a, I_CWS); bf16* wsb = (bf16*)(wsp(a) + WS_WSB);
    for (int i = gt; i < 16 * 128 * 128 / 4; i += NGT) { const f32x4 v = *(const f32x4*)(wsf + (size_t)i * 4); uint2 o; o.x = cvt_pk(v.x, v.y); o.y = cvt_pk(v.z, v.w); *(uint2*)(wsb + (size_t)i * 4) = o; }
}
__device__ __forceinline__ void build_job_table(LAS unsigned char* lds, ArgTab a) {
    unsigned char* ws = wsp(a);
    LAS unsigned long long* tab = (LAS unsigned long long*)(lds + LDSCTL_OFF + 2048);
    { int e = 0; const float* md = (const float*)(ws + WS_MODS); float* b2 = (float*)(ws + WS_BIAS2);
#define TJOB(SRC, DST, KK, NN, SH, B2, LDB) do { tab[8 * e] = (unsigned long long)(SRC); tab[8 * e + 1] = (unsigned long long)(DST); tab[8 * e + 2] = (unsigned long long)(KK); tab[8 * e + 3] = (unsigned long long)(NN); \
        tab[8 * e + 4] = (unsigned long long)(SH); tab[8 * e + 5] = (unsigned long long)(B2); tab[8 * e + 6] = (unsigned long long)(LDB); ++e; } while (0)
        TJOB(inp(a, I_AQKV), ws + WS_WT_QKV, 2048, 6144, md, b2 + B2_QKV, 6144);
        TJOB(inp(a, I_AWO), ws + WS_WT_AO, 2048, 2048, 0, 0, 0);
        TJOB(inp(a, I_FWIN), ws + WS_WT_F1, 2048, DFF2, md + 3 * DM, b2 + B2_F1, DFF2);
        TJOB(inp(a, I_FWOUT), ws + WS_WT_F2, DFF, 2048, 0, 0, 0);
        TJOB(inp(a, I_BWIN), ws + WS_WT_BIN, 2048, MLA_IN, md + (size_t)1 * MODS_LAYER, b2 + B2_BIN, MLA_INP);
        TJOB(inp(a, I_BUQ), ws + WS_WT_UQ, 512, 3072, 0, 0, 0);
        TJOB(inp(a, I_BUKV), ws + WS_WT_UKV, 512, 4096, 0, 0, 0);
        TJOB(inp(a, I_BWO), ws + WS_WT_BO, 2048, 2048, 0, 0, 0);
        TJOB(inp(a, I_FWIN) + (size_t)1 * 2048 * DFF2, (bf16*)(ws + WS_WT_F1) + (size_t)1 * DFF2 * 2048, 2048, DFF2, md + (size_t)1 * MODS_LAYER + 3 * DM, b2 + B2_F1 + 1 * 5 * DFF2, DFF2);
        TJOB(inp(a, I_FWOUT) + (size_t)1 * DFF * 2048, (bf16*)(ws + WS_WT_F2) + (size_t)1 * 2048 * DFF, DFF, 2048, 0, 0, 0);
        TJOB(inp(a, I_CWIN), ws + WS_WT_CIN, 2048, 4096, md + (size_t)2 * MODS_LAYER, b2 + B2_CIN, SGU_N);
        TJOB(inp(a, I_CWO), ws + WS_WT_CO, 2048, 2048, 0, 0, 0);
        TJOB(inp(a, I_FWIN) + (size_t)2 * 2048 * DFF2, (bf16*)(ws + WS_WT_F1) + (size_t)2 * DFF2 * 2048, 2048, DFF2, md + (size_t)2 * MODS_LAYER + 3 * DM, b2 + B2_F1 + 2 * 5 * DFF2, DFF2);
        TJOB(inp(a, I_FWOUT) + (size_t)2 * DFF * 2048, (bf16*)(ws + WS_WT_F2) + (size_t)2 * 2048 * DFF, DFF, 2048, 0, 0, 0);
        TJOB(inp(a, I_AQKV) + (size_t)2048 * 6144, (bf16*)(ws + WS_WT_QKV) + (size_t)6144 * 2048, 2048, 6144, md + (size_t)3 * MODS_LAYER, b2 + B2_QKV + 5 * 6144, 6144);
        TJOB(inp(a, I_AWO) + (size_t)2048 * 2048, (bf16*)(ws + WS_WT_AO) + (size_t)2048 * 2048, 2048, 2048, 0, 0, 0);
        TJOB(inp(a, I_FWIN) + (size_t)3 * 2048 * DFF2, (bf16*)(ws + WS_WT_F1) + (size_t)3 * DFF2 * 2048, 2048, DFF2, md + (size_t)3 * MODS_LAYER + 3 * DM, b2 + B2_F1 + 3 * 5 * DFF2, DFF2);
        TJOB(inp(a, I_FWOUT) + (size_t)3 * DFF * 2048, (bf16*)(ws + WS_WT_F2) + (size_t)3 * 2048 * DFF, DFF, 2048, 0, 0, 0);
#undef TJOB
    }
}
__device__ __forceinline__ void helper_transposes(Frame& F, ArgTab a, unsigned mask, int rank, int nranks) {
    LAS unsigned long long* tab = (LAS unsigned long long*)(F.lds + LDSCTL_OFF + 2048);
    __syncthreads();
    LAS unsigned* scr = (LAS unsigned*)(F.lds + F.wave * 8192); int it = rank;
    for (int m = 0; m < 18; ++m) {
        if (!((mask >> m) & 1u)) continue;
        const float* src = inp((ArgTab)tab, 8 * m); bf16* dst = (bf16*)inp((ArgTab)tab, 8 * m + 1);
        const int KK = __builtin_amdgcn_readfirstlane((int)tab[8 * m + 2]), NN = __builtin_amdgcn_readfirstlane((int)tab[8 * m + 3]), LDB = __builtin_amdgcn_readfirstlane((int)tab[8 * m + 6]);
        const float* sh = inp((ArgTab)tab, 8 * m + 4); float* b2p = (float*)inp((ArgTab)tab, 8 * m + 5);
        transpose_matrix(F, src, KK, NN, dst, scr, it, sh, b2p, LDB, nranks, NN == DFF2); }
    __syncthreads();
}

__device__ __forceinline__ void phase_prep(Frame& F, ArgTab a, int layer, int which, int r0, int r1, const float* slab_gate) {
    bf16* X = (bf16*)(wsp(a) + WS_X); bf16* H = (bf16*)(wsp(a) + WS_H); const bf16* SL = (const bf16*)(wsp(a) + WS_SLAB);
    float* rowss = (float*)(wsp(a) + WS_ROWSS) + (size_t)(layer * 2 + which) * MT;
    const float* g = inp(a, I_NORMG) + ((size_t)layer * 2 + which) * DM;
    const float* md = (const float*)(wsp(a) + WS_MODS) + (size_t)layer * MODS_LAYER;
    const bool first = (layer == 0 && which == 0);
    for (int row = r0 + F.gw; row < r1; row += F.NGW) {
        const int bidx = row < ML ? (row >> 11) : 4;
        const float* scale = md + (size_t)bidx * MODS_ROW + (which * 3 + 1) * DM;
        bf16* xr = X + (size_t)row * DM + F.lane * 4;
        f32x4 v[8]; float ss = 0.f;
        if (first) {
            const float* ir = (row < ML ? inp(a, I_X) + (size_t)row * DM : inp(a, I_CTX) + (size_t)(row - ML) * DM) + F.lane * 4;
#pragma unroll
            for (int j = 0; j < 8; ++j) { v[j] = *(const f32x4*)(ir + 256 * j); uint2 o; o.x = pg8::pack_h2(v[j].x, v[j].y); o.y = pg8::pack_h2(v[j].z, v[j].w); *(uint2*)(xr + 256 * j) = o; }
        } else {
#pragma unroll
            for (int j = 0; j < 8; ++j) { const uint2 w = *(const uint2*)(xr + 256 * j); v[j] = (f32x4){pg8::h2_lo(w.x), pg8::h2_hi(w.x), pg8::h2_lo(w.y), pg8::h2_hi(w.y)}; }
        }
        if (slab_gate && row >= ML) {
            const bf16* sr = SL + (size_t)(row - ML) * DM + F.lane * 4;
#pragma unroll
            for (int j = 0; j < 8; ++j) { f32x4 t = (f32x4){0.f, 0.f, 0.f, 0.f};
#pragma unroll
                for (int s8 = 0; s8 < 8; ++s8) { const uint2 w = *(const uint2*)(sr + (size_t)s8 * MC * DM + 256 * j); t = t + (f32x4){bf_lo(w.x), bf_hi(w.x), bf_lo(w.y), bf_hi(w.y)}; }
                v[j] = v[j] + *(const f32x4*)(slab_gate + 256 * j + F.lane * 4) * t; { uint2 o; o.x = pg8::pack_h2(v[j].x, v[j].y); o.y = pg8::pack_h2(v[j].z, v[j].w); *(uint2*)(xr + 256 * j) = o; } }
        }
#pragma unroll
        for (int j = 0; j < 8; ++j) ss += (v[j].x * v[j].x + v[j].y * v[j].y) + (v[j].z * v[j].z + v[j].w * v[j].w);
        ss = wave_sum(ss, F.lane);
        if (F.lane == 0) rowss[row] = ss;
        bf16* hr = H + (size_t)row * DM + F.lane * 4;
#pragma unroll
        for (int j = 0; j < 8; ++j) { const int c = 256 * j + F.lane * 4;
            const f32x4 gg = *(const f32x4*)(g + c), sc = *(const f32x4*)(scale + c);
            const f32x4 h = v[j] * (gg * (sc + 1.f));
            uint2 o; o.x = cvt_pk(h.x, h.y); o.y = cvt_pk(h.z, h.w); *(uint2*)(hr + 256 * j) = o; }
    }
}
__device__ __forceinline__ void phase_prep_ctx(Frame& F, ArgTab a, int layer, int which, const float* slab_gate) {
    bf16* X = (bf16*)(wsp(a) + WS_X); bf16* H = (bf16*)(wsp(a) + WS_H); const bf16* SL = (const bf16*)(wsp(a) + WS_SLAB);
    float* rowss = (float*)(wsp(a) + WS_ROWSS) + (size_t)(layer * 2 + which) * MT;
    const float* g = inp(a, I_NORMG) + ((size_t)layer * 2 + which) * DM;
    const float* scale = (const float*)(wsp(a) + WS_MODS) + (size_t)layer * MODS_LAYER + (size_t)4 * MODS_ROW + (which * 3 + 1) * DM;
    for (int tk = F.gw; tk < 2 * MC; tk += F.NGW) {
        const int row = ML + (tk >> 1), c0 = (tk & 1) * 1024 + F.lane * 4;
        bf16* xr = X + (size_t)row * DM + c0; const bf16* sr = SL + (size_t)(row - ML) * DM + c0;
        f32x4 v[4]; float ss = 0.f;
#pragma unroll
        for (int j = 0; j < 4; ++j) { const uint2 w = *(const uint2*)(xr + 256 * j); v[j] = (f32x4){pg8::h2_lo(w.x), pg8::h2_hi(w.x), pg8::h2_lo(w.y), pg8::h2_hi(w.y)}; }
#pragma unroll
        for (int j = 0; j < 4; ++j) { f32x4 t = (f32x4){0.f, 0.f, 0.f, 0.f};
#pragma unroll
            for (int s8 = 0; s8 < 8; ++s8) { const uint2 w = *(const uint2*)(sr + (size_t)s8 * MC * DM + 256 * j); t = t + (f32x4){bf_lo(w.x), bf_hi(w.x), bf_lo(w.y), bf_hi(w.y)}; }
            v[j] = v[j] + *(const f32x4*)(slab_gate + c0 + 256 * j) * t; { uint2 o; o.x = pg8::pack_h2(v[j].x, v[j].y); o.y = pg8::pack_h2(v[j].z, v[j].w); *(uint2*)(xr + 256 * j) = o; }
            ss += (v[j].x * v[j].x + v[j].y * v[j].y) + (v[j].z * v[j].z + v[j].w * v[j].w); }
        ss = wave_sum(ss, F.lane);
        if (F.lane == 0) atomicAdd(rowss + row, pg8::qgrid<pg8::QG_ROWSS>(ss));
        bf16* hr = H + (size_t)row * DM + c0;
#pragma unroll
        for (int j = 0; j < 4; ++j) { const f32x4 gg = *(const f32x4*)(g + c0 + 256 * j), sc = *(const f32x4*)(scale + c0 + 256 * j);
            const f32x4 h = v[j] * (gg * (sc + 1.f));
            uint2 o; o.x = cvt_pk(h.x, h.y); o.y = cvt_pk(h.z, h.w); *(uint2*)(hr + 256 * j) = o; }
    }
}
__device__ __forceinline__ void phase_final(Frame& F, ArgTab a) {
    const bf16* X = (const bf16*)(wsp(a) + WS_X); const float* g = inp(a, I_FINALG); float* out = (float*)inp(a, AP_OUT);
    for (int base = F.gw; base < ML; base += 4 * F.NGW) {
        f32x4 v[4][8];
#pragma unroll
        for (int k = 0; k < 4; ++k) { const int row = base + k * F.NGW; const bf16* xr = X + (size_t)(row < ML ? row : base) * DM + F.lane * 4;
#pragma unroll
            for (int j = 0; j < 8; ++j) { const uint2 w = *(const uint2*)(xr + 256 * j); v[k][j] = (f32x4){pg8::h2_lo(w.x), pg8::h2_hi(w.x), pg8::h2_lo(w.y), pg8::h2_hi(w.y)}; } }
#pragma unroll
        for (int k = 0; k < 4; ++k) { const int row = base + k * F.NGW; float ss = 0.f;
#pragma unroll
            for (int j = 0; j < 8; ++j) ss += (v[k][j].x * v[k][j].x + v[k][j].y * v[k][j].y) + (v[k][j].z * v[k][j].z + v[k][j].w * v[k][j].w);
            const float rstd = 1.f / sqrtf(wave_sum(ss, F.lane) * (1.f / DM) + EPS);
            if (row < ML) { float* orow = out + (size_t)row * DM + F.lane * 4;
#pragma unroll
                for (int j = 0; j < 8; ++j) { const f32x4 gg = *(const f32x4*)(g + 256 * j + F.lane * 4); *(f32x4*)(orow + 256 * j) = (v[k][j] * rstd) * gg; } } }
    }
}
__device__ __forceinline__ void phase_mla_norm(Frame& F, ArgTab a) {
    const float* CW = (const float*)(wsp(a) + WS_CW); bf16* CQN = (bf16*)(wsp(a) + WS_CQN); bf16* CKVN = (bf16*)(wsp(a) + WS_CKVN); bf16* KPE = (bf16*)(wsp(a) + WS_KPE);
    const float* qn = inp(a, I_BQN); const float* kn = inp(a, I_BKVN);
    for (int row = F.gw; row < MT; row += F.NGW) {
        const float* r = CW + (size_t)row * MLA_INP;
        const f32x4 q0 = *(const f32x4*)(r + F.lane * 8), q1 = *(const f32x4*)(r + F.lane * 8 + 4), k0 = *(const f32x4*)(r + 512 + F.lane * 8), k1 = *(const f32x4*)(r + 512 + F.lane * 8 + 4);
        const float pe = r[1024 + F.lane];
        float sq = (q0.x * q0.x + q0.y * q0.y) + (q0.z * q0.z + q0.w * q0.w) + (q1.x * q1.x + q1.y * q1.y) + (q1.z * q1.z + q1.w * q1.w);
        float sk = (k0.x * k0.x + k0.y * k0.y) + (k0.z * k0.z + k0.w * k0.w) + (k1.x * k1.x + k1.y * k1.y) + (k1.z * k1.z + k1.w * k1.w);
        const float rq = 1.f / sqrtf(wave_sum(sq, F.lane) * (1.f / 512.f) + EPS), rk = 1.f / sqrtf(wave_sum(sk, F.lane) * (1.f / 512.f) + EPS);
        const f32x4 gq0 = *(const f32x4*)(qn + F.lane * 8), gq1 = *(const f32x4*)(qn + F.lane * 8 + 4), gk0 = *(const f32x4*)(kn + F.lane * 8), gk1 = *(const f32x4*)(kn + F.lane * 8 + 4);
        const f32x4 a0 = (q0 * rq) * gq0, a1 = (q1 * rq) * gq1, b0 = (k0 * rk) * gk0, b1 = (k1 * rk) * gk1;
        v4u o; o.x = cvt_pk(a0.x, a0.y); o.y = cvt_pk(a0.z, a0.w); o.z = cvt_pk(a1.x, a1.y); o.w = cvt_pk(a1.z, a1.w);
        *(v4u*)(CQN + (size_t)row * 512 + F.lane * 8) = o;
        o.x = cvt_pk(b0.x, b0.y); o.y = cvt_pk(b0.z, b0.w); o.z = cvt_pk(b1.x, b1.y); o.w = cvt_pk(b1.z, b1.w);
        *(v4u*)(CKVN + (size_t)row * 512 + F.lane * 8) = o;
        float outv = pe;
        const float partner = shfl_xor_l(pe, 16, F.lane);
        if (row < ML) { const int t = row & (SEQ - 1), pos = (F.lane >> 5) ? (t & 63) : (t >> 6), j = F.lane & 15;
            const float cs = att::g_rope.c[pos * 16 + j], sn = att::g_rope.s[pos * 16 + j];
            outv = ((F.lane >> 4) & 1) ? (partner * sn + pe * cs) : (pe * cs - partner * sn); }
        KPE[(size_t)row * 64 + F.lane] = (bf16)(cvt_pk(outv, 0.f) & 0xffffu);
    }
}
__device__ __forceinline__ void phase_sgu_stats(Frame& F, ArgTab a) {
    const bf16* UV = (const bf16*)(wsp(a) + WS_QKV); float* st = (float*)(wsp(a) + WS_STATS);
    for (int row = F.gw; row < MT; row += F.NGW) {
        const bf16* r = UV + (size_t)row * SGU_N + 2048 + F.lane * 8;
        float v[32]; float s = 0.f;
#pragma unroll
        for (int j = 0; j < 4; ++j) { const v4u w = *(const v4u*)(r + 512 * j);
            v[8 * j + 0] = bf_lo(w.x); v[8 * j + 1] = bf_hi(w.x); v[8 * j + 2] = bf_lo(w.y); v[8 * j + 3] = bf_hi(w.y); v[8 * j + 4] = bf_lo(w.z); v[8 * j + 5] = bf_hi(w.z); v[8 * j + 6] = bf_lo(w.w); v[8 * j + 7] = bf_hi(w.w); }
#pragma unroll
        for (int i = 0; i < 32; ++i) s += v[i];
        const float mean = wave_sum(s, F.lane) * (1.f / 2048.f); float q = 0.f;
#pragma unroll
        for (int i = 0; i < 32; ++i) { const float d = v[i] - mean; q += d * d; }
        const float rstd = 1.f / sqrtf(wave_sum(q, F.lane) * (1.f / 2048.f) + EPS);
        if (F.lane == 0) { st[row * 2] = mean; st[row * 2 + 1] = rstd; }
    }
}
__device__ __forceinline__ void phase_conv_fix(Frame& F, ArgTab a, int layer, int nrows) {
    const bf16* UE = (const bf16*)(wsp(a) + WS_UE); bf16* ACT = (bf16*)(wsp(a) + WS_ACT);
    const float* cw = inp(a, I_FCW) + (size_t)layer * 3 * DFF2; const float* cb = inp(a, I_FCB) + (size_t)layer * DFF2;
    const int ntask = (nrows / 64) * 2 * 11;
    for (int tk = F.gw; tk < ntask; tk += F.NGW) {
        const int cbk = tk % 11, er = tk / 11, blk = er >> 1, which = er & 1, t = 64 * blk + (which ? 63 : 0), j0 = cbk * 512 + F.lane * 8;
        const bool first = t < ML ? ((t & (SEQ - 1)) == 0) : (((t - ML) & (CTXL - 1)) == 0), lastr = t < ML ? ((t & (SEQ - 1)) == SEQ - 1) : (((t - ML) & (CTXL - 1)) == CTXL - 1);
        const v4u zero = {0u, 0u, 0u, 0u};
        const bf16* pc = UE + ((size_t)blk * 4 + (which ? 3 : 0)) * DFF2 + j0;
        const v4u ca = *(const v4u*)pc, cg = *(const v4u*)(pc + DFF);
        v4u pa = zero, pg = zero, na = zero, ng = zero;
        if (which) { const bf16* pp = UE + ((size_t)blk * 4 + 2) * DFF2 + j0; pa = *(const v4u*)pp; pg = *(const v4u*)(pp + DFF);
                     if (!lastr) { const bf16* pn = UE + ((size_t)(blk + 1) * 4 + 0) * DFF2 + j0; na = *(const v4u*)pn; ng = *(const v4u*)(pn + DFF); } }
        else       { const bf16* pn = UE + ((size_t)blk * 4 + 1) * DFF2 + j0; na = *(const v4u*)pn; ng = *(const v4u*)(pn + DFF);
                     if (!first) { const bf16* pp = UE + ((size_t)(blk - 1) * 4 + 3) * DFF2 + j0; pa = *(const v4u*)pp; pg = *(const v4u*)(pp + DFF); } }
        const unsigned pav[4] = {pa.x, pa.y, pa.z, pa.w}, cav[4] = {ca.x, ca.y, ca.z, ca.w}, nav[4] = {na.x, na.y, na.z, na.w};
        const unsigned pgv[4] = {pg.x, pg.y, pg.z, pg.w}, cgv[4] = {cg.x, cg.y, cg.z, cg.w}, ngv[4] = {ng.x, ng.y, ng.z, ng.w};
        float wa[3][8], wg[3][8], ba[8], bg[8];
#pragma unroll
        for (int k = 0; k < 3; ++k)
#pragma unroll
            for (int h = 0; h < 2; ++h) { const f32x4 x = *(const f32x4*)(cw + (size_t)k * DFF2 + j0 + 4 * h), y = *(const f32x4*)(cw + (size_t)k * DFF2 + DFF + j0 + 4 * h);
                wa[k][4 * h] = x.x; wa[k][4 * h + 1] = x.y; wa[k][4 * h + 2] = x.z; wa[k][4 * h + 3] = x.w; wg[k][4 * h] = y.x; wg[k][4 * h + 1] = y.y; wg[k][4 * h + 2] = y.z; wg[k][4 * h + 3] = y.w; }
#pragma unroll
        for (int h = 0; h < 2; ++h) { const f32x4 x = *(const f32x4*)(cb + j0 + 4 * h), y = *(const f32x4*)(cb + DFF + j0 + 4 * h);
            ba[4 * h] = x.x; ba[4 * h + 1] = x.y; ba[4 * h + 2] = x.z; ba[4 * h + 3] = x.w; bg[4 * h] = y.x; bg[4 * h + 1] = y.y; bg[4 * h + 2] = y.z; bg[4 * h + 3] = y.w; }
        unsigned ow[4];
#pragma unroll
        for (int e = 0; e < 4; ++e) {
            const float a0 = wa[0][2 * e] * bf_lo(pav[e]) + wa[1][2 * e] * bf_lo(cav[e]) + wa[2][2 * e] * bf_lo(nav[e]) + ba[2 * e];
            const float a1 = wa[0][2 * e + 1] * bf_hi(pav[e]) + wa[1][2 * e + 1] * bf_hi(cav[e]) + wa[2][2 * e + 1] * bf_hi(nav[e]) + ba[2 * e + 1];
            const float g0 = wg[0][2 * e] * bf_lo(pgv[e]) + wg[1][2 * e] * bf_lo(cgv[e]) + wg[2][2 * e] * bf_lo(ngv[e]) + bg[2 * e];
            const float g1 = wg[0][2 * e + 1] * bf_hi(pgv[e]) + wg[1][2 * e + 1] * bf_hi(cgv[e]) + wg[2][2 * e + 1] * bf_hi(ngv[e]) + bg[2 * e + 1];
            const float s0 = g0 * __builtin_amdgcn_rcpf(1.f + __builtin_amdgcn_exp2f(-1.4426950408889634f * g0));
            const float s1 = g1 * __builtin_amdgcn_rcpf(1.f + __builtin_amdgcn_exp2f(-1.4426950408889634f * g1));
            ow[e] = cvt_pk(a0 * s0, a1 * s1); }
        v4u o = {ow[0], ow[1], ow[2], ow[3]};
        *(v4u*)(ACT + (size_t)t * DFF + j0) = o;
    }
}

__global__ void __launch_bounds__(NTHREADS, 2) fwd_kernel(Args args) {
    extern __shared__ __attribute__((aligned(16))) unsigned char lds_raw[];
#define MKFRAME() Frame F; { int t_ = threadIdx.x; asm volatile("" : "+v"(t_)); F.lds = (LAS unsigned char*)lds_raw; F.tid = t_; F.lane = t_ & 63; F.wave = __builtin_amdgcn_readfirstlane(t_ >> 6); \
      F.G = gridDim.x; F.gw = blockIdx.x * NWAVES + F.wave; F.NGW = F.G * NWAVES; }
    LAS unsigned char* const lds0 = (LAS unsigned char*)lds_raw; const int G = gridDim.x;
    volatile LAS unsigned* MISC = (volatile LAS unsigned*)(lds0 + MISC_OFF);
    for (int u = threadIdx.x; u < (LDS_BYTES - LDSCTL_OFF) / 4; u += NTHREADS) ((LAS unsigned*)(lds0 + LDSCTL_OFF))[u] = 0u;
    __syncthreads();
    const int lo = args.step_lo, hi = args.step_hi;
    const ArgTab AP = (ArgTab)(lds0 + LDSCTL_OFF + 1024);
    if (threadIdx.x == 0) {
#pragma unroll
        for (int i = 0; i < N_IN; ++i) AP[i] = (unsigned long long)args.in[i];
        AP[AP_OUT] = (unsigned long long)args.out; AP[AP_WS] = (unsigned long long)args.ws; }
    __syncthreads();
    if (threadIdx.x == 0) build_job_table(lds0, AP);
    __syncthreads();
    const bool multi = (hi - lo) > 1;
    if (multi) { const XcdBarrier b0 = xcd_barrier_post((unsigned*)(wsp(AP) + WS_CTL) + CW_BAR, MISC + 8); if (threadIdx.x == 0) MISC[10] = b0.x; }
#define IN(k) (lo <= (k) && (k) < hi)
#define SEAM(k) do { if ((k) + 1 < hi) { XcdBarrier bar_; bar_.bar = (unsigned*)(wsp(AP) + WS_CTL) + CW_BAR; bar_.x = MISC[10]; bar_.st = MISC + 8; xcd_barrier(bar_); } } while (0)
#define SITE_WS() unsigned char* const ws = wsp(AP)
#define SPLIT_BEGIN(UNITS, DO_HELP, ADA_L, MASK) \
        const int rnd_ = ((UNITS) + G - 1) / G, need_ = ((UNITS) + rnd_ - 1) / rnd_; const bool spare_ = (DO_HELP) && need_ < G; const int NACT_ = spare_ ? need_ : G; \
        if ((DO_HELP) && (!spare_ || (int)blockIdx.x >= NACT_)) { MKFRAME(); helper_transposes(F, AP, (MASK), spare_ ? (int)blockIdx.x - NACT_ : (int)blockIdx.x, spare_ ? G - NACT_ : G); } \
        if ((int)blockIdx.x < NACT_)
#define H ((bf16*)(ws + WS_H))
#define QKV ((bf16*)(ws + WS_QKV))
#define OB ((bf16*)(ws + WS_O))
#define UB ((bf16*)(ws + WS_U))
#define ACT ((bf16*)(ws + WS_ACT))
#define X ((bf16*)(ws + WS_X))
#define mods ((const float*)(ws + WS_MODS) + (size_t)layer * MODS_LAYER)
#define RSS(w) ((const float*)(ws + WS_ROWSS) + (size_t)(layer * 2 + (w)) * MT)
    LAS unsigned char* const ring = lds0;

    if (EN(0) && IN(0)) { MKFRAME(); helper_wsb(F, AP); helper_ada(F, AP, (int)blockIdx.x, G); SEAM(0); }
    if (EN(0) && IN(1)) { MKFRAME(); helper_transposes(F, AP, 0xFu, (int)blockIdx.x, G); phase_prep(F, AP, 0, 0, 0, MT, nullptr); SEAM(1); }

    for (int layer = 0; layer < DEPTH; ++layer) {
        const int kind = layer % 3, jm = layer / 3, sb = STEP_L0 + layer * STEPS_PER_LAYER;
        const bool last = layer == DEPTH - 1;
#ifdef PROBE_SLEEP_TICKS
        { const unsigned long long t0_ = __builtin_amdgcn_s_memrealtime(); while (__builtin_amdgcn_s_memrealtime() - t0_ < PROBE_SLEEP_TICKS) __builtin_amdgcn_s_sleep(32); }
#endif
        const int mrows = last ? ML : MT;
        if (EN(1) && layer > 0 && IN(sb + 0)) { MKFRAME(); phase_prep_ctx(F, AP, layer, 0, (const float*)(wsp(AP) + WS_MODS) + (size_t)(layer - 1) * MODS_LAYER + 4 * MODS_ROW + 5 * DM); SEAM(sb + 0); }
        if (kind == 0) {
            if (EN(2) && IN(sb + 1)) { for (int rep_ = 0; rep_ < REPS(2); ++rep_) { SITE_WS(); SPLIT_BEGIN((MT / 256) * (6144 / 256), !last, -1, 0x2F0u) {
                pg8::Gemm g{H, (const bf16*)(ws + WS_WT_QKV) + (size_t)jm * 6144 * 2048, MT, 6144, 2048}; pg8::StaticOrder S; S.init(MT, 6144, NACT_, (int)blockIdx.x);
                pg8::EpiNormBf16<0> E{QKV, 6144, nullptr, RSS(0), (const float*)(ws + WS_BIAS2) + B2_QKV + jm * 5 * 6144, 6144};
                pg8::gemm_phase<pg8::EpiNormBf16<0>, pg8::StaticOrder, true, true>(ring, g, S, E); } SEAM(sb + 1); } }
            if (EN(3) && IN(sb + 2)) { for (int rep_ = 0; rep_ < REPS(3); ++rep_) { SITE_WS(); att::AttnP P{QKV, QKV + 2048, QKV + 4096, nullptr, OB, inp(AP, I_ARPB) + (size_t)jm * 16 * 465};
                const int nun = last ? 512 : 576;
                for (int u = blockIdx.x; u < nun; u += G) { if (u < 512) { const int x_ = u & 7, s_ = u >> 3, bh_ = x_ + 8 * (s_ >> 3); att::attn_unit<0>((LAS char*)ring, P, bh_ >> 4, bh_ & 15, s_ & 7, false); } else att::attn_unit<0>((LAS char*)ring, P, (u - 512) >> 4, (u - 512) & 15, 0, true); }
                SEAM(sb + 2); } }
        } else if (kind == 1) {
            if (EN(4) && IN(sb + 1)) { for (int rep_ = 0; rep_ < REPS(4); ++rep_) { SITE_WS(); SPLIT_BEGIN((MT / 256) * (MLA_INP / 256), true, -1, 0xC00u) {
                pg8::Gemm g{H, (const bf16*)(ws + WS_WT_BIN), MT, MLA_INP, 2048}; pg8::StaticOrder S; S.init(MT, MLA_INP, NACT_, (int)blockIdx.x);
                pg8::EpiMlaIn E{RSS(0), (const float*)(ws + WS_BIAS2) + B2_BIN, MLA_INP, inp(AP, I_BQN), inp(AP, I_BKVN), (bf16*)(ws + WS_CQN), (bf16*)(ws + WS_CKVN), (bf16*)(ws + WS_KPE),
                                (float*)(ws + WS_MLSS), (float*)(ws + WS_MLSS) + MT, att::g_rope.c, att::g_rope.s};
                pg8::gemm_phase<pg8::EpiMlaIn, pg8::StaticOrder, true, true>(ring, g, S, E); } SEAM(sb + 1); } }
            if (EN(6) && IN(sb + 3)) { for (int rep_ = 0; rep_ < REPS(6); ++rep_) { SITE_WS();
                pg8::Gemm g{(const bf16*)(ws + WS_CQN), (const bf16*)(ws + WS_WT_UQ), MT, MLA_QN, 512, (const bf16*)(ws + WS_CKVN), (const bf16*)(ws + WS_WT_UKV)};
                pg8::DualOrder S; S.init(MT, MLA_QN, MLA_KVN, G, (int)blockIdx.x);
                pg8::EpiMlaUp E{QKV, MLA_QN, (const float*)(ws + WS_MLSS), (bf16*)(ws + WS_KV), MLA_KVN, (const float*)(ws + WS_MLSS) + MT};
                pg8::gemm_phase<pg8::EpiMlaUp, pg8::DualOrder, true, true>(ring, g, S, E);
                SEAM(sb + 3); } }
            if (EN(7) && IN(sb + 5)) { for (int rep_ = 0; rep_ < REPS(7); ++rep_) { SITE_WS(); const bf16* KV = (const bf16*)(ws + WS_KV);
                att::AttnP P{QKV, KV, KV + 128, (const bf16*)(ws + WS_KPE), OB, nullptr};
                for (int u = blockIdx.x; u < 576; u += G) { if (u < 512) { const int x_ = u & 7, s_ = u >> 3, bh_ = x_ + 8 * (s_ >> 3); att::attn_unit<1>((LAS char*)ring, P, bh_ >> 4, bh_ & 15, s_ & 7, false); } else att::attn_unit<1>((LAS char*)ring, P, (u - 512) >> 4, (u - 512) & 15, 0, true); }
                SEAM(sb + 5); } }
        } else {
            if (EN(8) && IN(sb + 1)) { for (int rep_ = 0; rep_ < REPS(8); ++rep_) { SITE_WS(); SPLIT_BEGIN((MT / 256) * (SGU_N / 256), true, -1, 0x2C000u) {
                pg8::Gemm g{H, (const bf16*)(ws + WS_WT_CIN), MT, SGU_N, 2048}; pg8::StaticOrder S; S.init(MT, SGU_N, NACT_, (int)blockIdx.x);
                pg8::EpiSguIn E{QKV, SGU_N, inp(AP, I_CBIN), RSS(0), (const float*)(ws + WS_BIAS2) + B2_CIN, SGU_N, (float*)(ws + WS_SGST), 2048};
                pg8::gemm_phase<pg8::EpiSguIn, pg8::StaticOrder, true, true>(ring, g, S, E); } SEAM(sb + 1); } }
            if (EN(10) && IN(sb + 3)) { for (int rep_ = 0; rep_ < REPS(10); ++rep_) { SITE_WS(); for (int u = blockIdx.x; u < 72 * 16; u += G)
                    att::sgu_mix_unit((LAS char*)ring, QKV, (const float*)(ws + WS_SGST), inp(AP, I_CLNG), inp(AP, I_CLNB), (const bf16*)(ws + WS_WSB), inp(AP, I_CBS), OB, u >> 4, u & 15);
                SEAM(sb + 3); } }
        }
        if (EN(11) && IN(sb + 6)) { for (int rep_ = 0; rep_ < REPS(11); ++rep_) { SITE_WS(); const bf16* wt = kind == 0 ? (const bf16*)(ws + WS_WT_AO) + (size_t)jm * 2048 * 2048 : (kind == 1 ? (const bf16*)(ws + WS_WT_BO) : (const bf16*)(ws + WS_WT_CO));
            pg8::Gemm g{OB, wt, mrows, DM, DM}; pg8::ResOrder S; S.init(mrows, DM, DM, G, (int)blockIdx.x);
            pg8::EpiResN E{X, DM, mods, 2 * DM, (bf16*)(ws + WS_SLAB), H, inp(AP, I_NORMG) + ((size_t)layer * 2 + 1) * DM, mods + 4 * DM, (float*)(ws + WS_ROWSS) + (size_t)(layer * 2 + 1) * MT};
            pg8::gemm_phase<pg8::EpiResN, pg8::ResOrder, true, true>(ring, g, S, E); SEAM(sb + 6); } }
        if (EN(1) && !last && IN(sb + 7)) { MKFRAME(); phase_prep_ctx(F, AP, layer, 1, (const float*)(wsp(AP) + WS_MODS) + (size_t)layer * MODS_LAYER + 4 * MODS_ROW + 2 * DM); SEAM(sb + 7); }
        if (EN(12) && IN(sb + 8)) { for (int rep_ = 0; rep_ < REPS(12); ++rep_) { SITE_WS(); SPLIT_BEGIN((mrows / 256) * (DFF2 / 256), !last, -1, layer == 0 ? 0x100u : (layer == 1 ? 0x3000u : 0x10000u)) {
            pg8::Gemm g{H, (const bf16*)(ws + WS_WT_F1) + (size_t)layer * DFF2 * 2048, mrows, DFF2, 2048}; pg8::StaticOrder S; S.init(mrows, DFF2, NACT_, (int)blockIdx.x);
            pg8::EpiConvF1 E{ACT, RSS(1), (const float*)(ws + WS_BIAS2) + B2_F1 + layer * 5 * DFF2, inp(AP, I_FCW) + (size_t)layer * 3 * DFF2, inp(AP, I_FCB) + (size_t)layer * DFF2, (bf16*)(ws + WS_UE)};
            pg8::gemm_phase<pg8::EpiConvF1, pg8::StaticOrder, true, true>(ring, g, S, E); } SEAM(sb + 8); } }
        if (EN(13) && IN(sb + 9)) { for (int rep_ = 0; rep_ < REPS(13); ++rep_) { MKFRAME(); phase_conv_fix(F, AP, layer, mrows); SEAM(sb + 9); } }
        if (EN(14) && IN(sb + 10)) { for (int rep_ = 0; rep_ < REPS(14); ++rep_) { SITE_WS(); pg8::Gemm g{ACT, (const bf16*)(ws + WS_WT_F2) + (size_t)layer * 2048 * DFF, mrows, DM, DFF}; pg8::ResOrder S; S.init(mrows, DM, DFF, G, (int)blockIdx.x);
            pg8::EpiResN E{X, DM, mods, 5 * DM, (bf16*)(ws + WS_SLAB), last ? (bf16*)nullptr : H, inp(AP, I_NORMG) + ((size_t)(last ? layer : layer + 1) * 2) * DM, mods + (last ? 0 : MODS_LAYER) + 1 * DM, (float*)(ws + WS_ROWSS) + (size_t)((last ? layer : layer + 1) * 2) * MT};
            pg8::gemm_phase<pg8::EpiResN, pg8::ResOrder, true, true>(ring, g, S, E); SEAM(sb + 10); } }
    }
    if (EN(15) && IN(STEP_FINAL)) {
#ifdef PROBE_BARRIERS
        for (int pb_ = 0; pb_ < PROBE_BARRIERS; ++pb_) { XcdBarrier bar_; bar_.bar = (unsigned*)(wsp(AP) + WS_CTL) + CW_BAR; bar_.x = MISC[10]; bar_.st = MISC + 8; xcd_barrier(bar_); }
#endif
        MKFRAME(); phase_final(F, AP); }
#undef IN
#undef SEAM
#undef SITE_WS
#undef SPLIT_BEGIN
#undef H
#undef QKV
#undef OB
#undef UB
#undef ACT
#undef X
#undef mods
#undef RSS
}

#ifndef MK_ONE_LAUNCH
#define MK_ONE_LAUNCH 1
#endif
extern "C" void kernel_launch(void* const* d_in, const int* in_sizes, int n_in, void* d_out, int out_size, void* d_ws, size_t ws_size, hipStream_t stream) {
    static int grid = 0;
    if (grid == 0) {
        if (n_in != N_IN || out_size != ML * DM || ws_size < WS_END) { fprintf(stderr, "kernel_launch: unexpected shapes: n_in %d out %d ws %zu (need %zu)\n", n_in, out_size, ws_size, (size_t)WS_END); grid = -1; return; }
        int dev = 0, cus = 0, per_cu = 0;
        if (hipGetDevice(&dev) != hipSuccess || hipDeviceGetAttribute(&cus, hipDeviceAttributeMultiprocessorCount, dev) != hipSuccess) { grid = -1; return; }
        if (hipFuncSetAttribute((const void*)fwd_kernel, hipFuncAttributeMaxDynamicSharedMemorySize, LDS_BYTES) != hipSuccess) { fprintf(stderr, "kernel_launch: hipFuncSetAttribute failed\n"); grid = -1; return; }
        if (hipOccupancyMaxActiveBlocksPerMultiprocessor(&per_cu, (const void*)fwd_kernel, NTHREADS, LDS_BYTES) != hipSuccess || per_cu < 1) { fprintf(stderr, "kernel_launch: occupancy query says %d\n", per_cu); }
        (void)hipGetLastError();
        grid = cus;
    }
    if (grid < 0) return;
    if (hipMemsetAsync((char*)d_ws + WS_CTL, 0, CTL_ZERO_BYTES, stream) != hipSuccess) return;
    Args ka{};
    for (int i = 0; i < N_IN; ++i) ka.in[i] = (const float*)d_in[i];
    ka.out = (float*)d_out; ka.ws = (unsigned char*)d_ws;
#if MK_ONE_LAUNCH
    ka.step_lo = 0; ka.step_hi = N_STEPS;
    hipLaunchKernelGGL(fwd_kernel, dim3(grid), dim3(NTHREADS), LDS_BYTES, stream, ka);
#else
    for (int s = 0; s < N_STEPS; ++s) {
        if (s >= STEP_L0 && s < STEP_FINAL) { const int layer = (s - STEP_L0) / STEPS_PER_LAYER, slot = (s - STEP_L0) % STEPS_PER_LAYER; if (!step_used(layer % 3, slot) || (slot == 7 && layer == DEPTH - 1) || (slot == 0 && layer == 0)) continue; }
        ka.step_lo = s; ka.step_hi = s + 1;
        hipLaunchKernelGGL(fwd_kernel, dim3(grid), dim3(NTHREADS), LDS_BYTES, stream, ka);
    }
#endif
    const hipError_t le = hipPeekAtLastError();
    if (le != hipSuccess) fprintf(stderr, "kernel_launch: launch failed: %s\n", hipGetErrorName(le));
}
```
